# Optimizing an MI355X kernel written in HIP

```python
import math
import jax, jax.numpy as jnp
from jax import lax
import numpy as np

D_MODEL = 1024
BATCH = 16
SEQ = 2048
DEPTH = 4

N_MIXERS = 4
N_LAYERS_CONV = (DEPTH + 3) // N_MIXERS
N_LAYERS_RWKV = (DEPTH + 2) // N_MIXERS
N_LAYERS_SGU = (DEPTH + 1) // N_MIXERS
N_LAYERS_RET = DEPTH // N_MIXERS

N_MEM = 256
XA_HEADS = 4
XA_HEAD_DIM = D_MODEL // XA_HEADS

CONV_WIDTH = 31

RWKV_HEAD_DIM = 64
RWKV_HEADS = D_MODEL // RWKV_HEAD_DIM
RWKV_DECAY_LORA = 64
RWKV_AAA_LORA = 64
RWKV_GATE_LORA = 160
RWKV_GN_EPS = RWKV_HEAD_DIM * 1e-5

SGU_CHUNK = 128
SGU_WIDTH = 2 * D_MODEL
SGU_GROUPS = 8
SGU_GROUP_DIM = SGU_WIDTH // SGU_GROUPS

RET_HEADS = 4
RET_QK_DIM = D_MODEL // RET_HEADS
RET_V_DIM = 2 * RET_QK_DIM
RET_CHUNK = 128

D_FF = 256 * math.ceil(8 * D_MODEL / 3 / 256)
NORM_EPS = 1e-6
LN_EPS = 1e-5

kernel_name = 'hybrid_conv_rwkv7_sgu_retention_trunk'


def rmsnorm(x, g, eps=NORM_EPS):
    x32 = x.astype(jnp.float32)
    y = x32 * lax.rsqrt(jnp.mean(x32 * x32, axis=-1, keepdims=True) + eps)
    return (y * g.astype(jnp.float32)).astype(x.dtype)


def layernorm(x, g, b, eps=LN_EPS):
    x32 = x.astype(jnp.float32)
    mu = jnp.mean(x32, axis=-1, keepdims=True)
    var = jnp.mean(jnp.square(x32 - mu), axis=-1, keepdims=True)
    y = (x32 - mu) * lax.rsqrt(var + eps)
    return (y * g.astype(jnp.float32) + b.astype(jnp.float32)).astype(x.dtype)


def conv_module(h, w_in, b_in, dw, dw_b, ln_g, ln_b, w_out, b_out):
    z = h @ w_in + b_in
    a, gate = jnp.split(z, 2, axis=-1)
    z = a * jax.nn.sigmoid(gate)
    z = lax.conv_general_dilated(
        z, dw[:, None, :].astype(z.dtype), window_strides=(1,),
        padding=[(CONV_WIDTH - 1, 0)],
        dimension_numbers=('NWC', 'WIO', 'NWC'),
        feature_group_count=D_MODEL) + dw_b
    z = jax.nn.silu(layernorm(z, ln_g, ln_b))
    return z @ w_out + b_out


def rwkv7_time_mix(h, mix, w_rkv, w0, w1, w2, a0, a1, a2, g1, g2, k_k, k_a, r_k, gn_g, gn_b, w_o):
    B, T, D = h.shape
    H, N = RWKV_HEADS, RWKV_HEAD_DIM
    h_prev = jnp.pad(h, ((0, 0), (1, 0), (0, 0)))[:, :T]
    xs = h[None] + (h_prev - h)[None] * mix[:, None, None, :]
    r = xs[0] @ w_rkv[0]
    k = xs[2] @ w_rkv[1]
    v = xs[3] @ w_rkv[2]
    w = -jax.nn.softplus(-(w0 + jnp.tanh(xs[1] @ w1) @ w2)) - 0.5
    decay = jnp.exp(-jnp.exp(w.astype(jnp.float32)))
    a = jax.nn.sigmoid(a0 + (xs[4] @ a1) @ a2)
    g = jax.nn.sigmoid(xs[5] @ g1) @ g2

    def heads(t):
        return t.astype(jnp.float32).reshape(B, T, H, N)

    kk = heads(k * k_k)
    kk = kk / jnp.maximum(jnp.sqrt(jnp.sum(kk * kk, axis=-1, keepdims=True)), 1e-12)
    k = k * (1.0 + (a - 1.0) * k_a)
    r_h, k_h, v_h, a_h, w_h = heads(r), heads(k), heads(v), heads(a), heads(decay)

    def step(S, inp):
        r_t, w_t, k_t, v_t, a_t, b_t = inp
        sa = jnp.einsum('bhij,bhj->bhi', S, a_t)
        S = S * w_t[:, :, None, :] + sa[..., None] * b_t[:, :, None, :] + v_t[..., None] * k_t[:, :, None, :]
        return S, jnp.einsum('bhij,bhj->bhi', S, r_t)

    def tmajor(t):
        return jnp.swapaxes(t, 0, 1)

    S0 = jnp.zeros((B, H, N, N), jnp.float32)
    _, y = lax.scan(step, S0, (tmajor(r_h), tmajor(w_h), tmajor(k_h), tmajor(v_h),
                               tmajor(-kk), tmajor(kk * a_h)))
    y = tmajor(y)
    y = layernorm(y, gn_g.reshape(H, N), gn_b.reshape(H, N), RWKV_GN_EPS)
    y = y + jnp.sum(r_h * k_h * r_k, axis=-1, keepdims=True) * v_h
    return (y.reshape(B, T, D) * g) @ w_o


def spatial_gating_mixer(h, w_in, b_in, ln_g, ln_b, ws, bs, w_out):
    B, T, _ = h.shape
    z = jax.nn.gelu(h @ w_in + b_in, approximate=False)
    u, v = jnp.split(z, 2, axis=-1)
    v = layernorm(v, ln_g, ln_b)
    n_chunks = T // SGU_CHUNK
    v = v.reshape(B, n_chunks, SGU_CHUNK, SGU_GROUPS, SGU_GROUP_DIM)
    causal = jnp.tril(jnp.ones((SGU_CHUNK, SGU_CHUNK), dtype=bool))
    ws_c = jnp.where(causal[None], ws, jnp.zeros((), ws.dtype))
    v = jnp.einsum('gts,bcsge->bctge', ws_c, v) + jnp.transpose(bs)[None, None, :, :, None]
    return (u * v.reshape(B, T, SGU_WIDTH)) @ w_out


def rotate_every_two(x):
    x1 = x[..., ::2]
    x2 = x[..., 1::2]
    return jnp.stack((-x2, x1), axis=-1).reshape(x.shape)


def retention_mixer(h, w_in, w_out):
    B, T, D = h.shape
    H, dk, dv, C = RET_HEADS, RET_QK_DIM, RET_V_DIM, RET_CHUNK
    q, k, v, g = jnp.split(h @ w_in, [D, 2 * D, 4 * D], axis=-1)
    q = q.reshape(B, T, H, dk)
    k = k.reshape(B, T, H, dk) * (dk ** -0.5)
    v = v.reshape(B, T, H, dv).astype(jnp.float32)
    angle = jnp.repeat(1.0 / (10000.0 ** jnp.linspace(0.0, 1.0, dk // 2, dtype=jnp.float32)), 2)
    theta = jnp.arange(T, dtype=jnp.float32)[:, None] * angle[None]
    sin, cos = jnp.sin(theta)[:, None, :], jnp.cos(theta)[:, None, :]
    q = q * cos + rotate_every_two(q) * sin
    k = k * cos + rotate_every_two(k) * sin

    log_gamma = jnp.log(1.0 - 2.0 ** (-5.0 - jnp.arange(H, dtype=jnp.float32)))
    n_chunks = T // C

    def chunked(t):
        return t.reshape(B, n_chunks, C, H, t.shape[-1]).transpose(0, 3, 1, 2, 4)

    q, k, v = chunked(q), chunked(k), chunked(v)
    idx = jnp.arange(C, dtype=jnp.float32)
    diff = idx[:, None] - idx[None, :]
    decay_mask = jnp.where(diff[None] >= 0,
                           jnp.exp(log_gamma[:, None, None] * jnp.maximum(diff, 0.0)[None]), 0.0)
    scores = jnp.einsum('bhncd,bhnsd->bhncs', q, k) * decay_mask[:, None]
    inner = jnp.einsum('bhncs,bhnse->bhnce', scores, v)

    q_decay = jnp.exp(log_gamma[:, None] * (idx + 1.0))
    k_decay = jnp.exp(log_gamma[:, None] * (C - 1.0 - idx))
    chunk_decay = jnp.exp(log_gamma * C)
    qs = q * q_decay[:, None, :, None]
    ks = k * k_decay[:, None, :, None]

    def step(R, inp):
        qc, kc, vc = inp
        cross = jnp.einsum('bhcd,bhde->bhce', qc, R)
        R = R * chunk_decay[None, :, None, None] + jnp.einsum('bhcd,bhce->bhde', kc, vc)
        return R, cross

    def nmajor(t):
        return jnp.moveaxis(t, 2, 0)

    R0 = jnp.zeros((B, H, dk, dv), jnp.float32)
    _, cross = lax.scan(step, R0, (nmajor(qs), nmajor(ks), nmajor(v)))
    o = inner + jnp.moveaxis(cross, 0, 2)
    o = o.transpose(0, 2, 3, 1, 4).reshape(B, T, H, dv)
    o = o * lax.rsqrt(jnp.mean(o * o, axis=-1, keepdims=True) + NORM_EPS)
    return (jax.nn.silu(g) * o.reshape(B, T, H * dv)) @ w_out


def memory_cross_attention(h, mem_n, wq, wkv, wo):
    B, T, D = h.shape
    M = mem_n.shape[1]
    q = (h @ wq).reshape(B, T, XA_HEADS, XA_HEAD_DIM)
    k, v = jnp.split(mem_n @ wkv, 2, axis=-1)
    k = k.reshape(B, M, XA_HEADS, XA_HEAD_DIM)
    v = v.reshape(B, M, XA_HEADS, XA_HEAD_DIM)
    s = jnp.einsum('bthd,bmhd->bhtm', q, k).astype(jnp.float32) * (XA_HEAD_DIM ** -0.5)
    p = jax.nn.softmax(s, axis=-1).astype(v.dtype)
    o = jnp.einsum('bhtm,bmhd->bthd', p, v).reshape(B, T, D)
    return o @ wo


def swiglu(h, w_gate_up, w_down):
    gt, up = jnp.split(h @ w_gate_up, 2, axis=-1)
    return (jax.nn.silu(gt) * up) @ w_down


def setup_inputs(seed: int = 0) -> dict:
    key = jax.random.key(seed)
    ks = iter(jax.random.split(key, 64))
    D, F, E = D_MODEL, D_FF, SGU_WIDTH
    nA, nB, nC, nD = N_LAYERS_CONV, N_LAYERS_RWKV, N_LAYERS_SGU, N_LAYERS_RET

    def normal(shape, scale):
        return scale * jax.random.normal(next(ks), shape, jnp.float32)

    def gain(shape):
        return 1.0 + normal(shape, 0.02)

    def uniform(shape, lo, hi):
        return jax.random.uniform(next(ks), shape, jnp.float32, lo, hi)

    return {
        'x': normal((BATCH, SEQ, D), 1.0),
        'mem': normal((BATCH, N_MEM, D), 1.0),
        'mix_norm_g': gain((DEPTH, D)),
        'xattn_norm_g': gain((DEPTH, D)),
        'mem_norm_g': gain((DEPTH, D)),
        'xattn_wq': normal((DEPTH, D, D), D ** -0.5),
        'xattn_wkv': normal((DEPTH, D, 2 * D), D ** -0.5),
        'xattn_wo': normal((DEPTH, D, D), D ** -0.5),
        'ffn_norm_g': gain((DEPTH, D)),
        'ffn_w_gate_up': normal((DEPTH, D, 2 * F), D ** -0.5),
        'ffn_w_down': normal((DEPTH, F, D), F ** -0.5),
        'conv_w_in': normal((nA, D, 2 * D), D ** -0.5),
        'conv_b_in': normal((nA, 2 * D), 0.02),
        'conv_dw': normal((nA, CONV_WIDTH, D), CONV_WIDTH ** -0.5),
        'conv_dw_b': normal((nA, D), 0.02),
        'conv_ln_g': gain((nA, D)),
        'conv_ln_b': normal((nA, D), 0.02),
        'conv_w_out': normal((nA, D, D), D ** -0.5),
        'conv_b_out': normal((nA, D), 0.02),
        'rwkv_mix': uniform((nB, 6, D), 0.0, 1.0),
        'rwkv_w_rkv': normal((nB, 3, D, D), D ** -0.5),
        'rwkv_w0': uniform((nB, D), -6.0, 1.0),
        'rwkv_w1': normal((nB, D, RWKV_DECAY_LORA), D ** -0.5),
        'rwkv_w2': normal((nB, RWKV_DECAY_LORA, D), 0.1 * RWKV_DECAY_LORA ** -0.5),
        'rwkv_a0': normal((nB, D), 0.5),
        'rwkv_a1': normal((nB, D, RWKV_AAA_LORA), D ** -0.5),
        'rwkv_a2': normal((nB, RWKV_AAA_LORA, D), 0.1 * RWKV_AAA_LORA ** -0.5),
        'rwkv_g1': normal((nB, D, RWKV_GATE_LORA), D ** -0.5),
        'rwkv_g2': normal((nB, RWKV_GATE_LORA, D), RWKV_GATE_LORA ** -0.5),
        'rwkv_k_k': 0.85 + normal((nB, D), 0.02),
        'rwkv_k_a': gain((nB, D)),
        'rwkv_r_k': normal((nB, RWKV_HEADS, RWKV_HEAD_DIM), 0.1),
        'rwkv_gn_g': gain((nB, D)),
        'rwkv_gn_b': normal((nB, D), 0.02),
        'rwkv_w_o': normal((nB, D, D), D ** -0.5),
        'sgu_w_in': normal((nC, D, 2 * E), D ** -0.5),
        'sgu_b_in': normal((nC, 2 * E), 0.02),
        'sgu_ln_g': gain((nC, E)),
        'sgu_ln_b': normal((nC, E), 0.02),
        'sgu_ws': normal((nC, SGU_GROUPS, SGU_CHUNK, SGU_CHUNK), 0.5 * SGU_CHUNK ** -0.5),
        'sgu_bs': gain((nC, SGU_GROUPS, SGU_CHUNK)),
        'sgu_w_out': normal((nC, E, D), E ** -0.5),
        'ret_w_in': normal((nD, D, 6 * D), D ** -0.5),
        'ret_w_out': normal((nD, 2 * D, D), (2 * D) ** -0.5),
        'final_norm_g': gain((D,)),
    }


def reference(x, mem, mix_norm_g, xattn_norm_g, mem_norm_g, xattn_wq, xattn_wkv, xattn_wo,
              ffn_norm_g, ffn_w_gate_up, ffn_w_down,
              conv_w_in, conv_b_in, conv_dw, conv_dw_b, conv_ln_g, conv_ln_b, conv_w_out, conv_b_out,
              rwkv_mix, rwkv_w_rkv, rwkv_w0, rwkv_w1, rwkv_w2, rwkv_a0, rwkv_a1, rwkv_a2,
              rwkv_g1, rwkv_g2, rwkv_k_k, rwkv_k_a, rwkv_r_k, rwkv_gn_g, rwkv_gn_b, rwkv_w_o,
              sgu_w_in, sgu_b_in, sgu_ln_g, sgu_ln_b, sgu_ws, sgu_bs, sgu_w_out,
              ret_w_in, ret_w_out, final_norm_g):
    for i in range(DEPTH):
        m, j = i % N_MIXERS, i // N_MIXERS
        hn = rmsnorm(x, mix_norm_g[i])
        if m == 0:
            y = conv_module(hn, conv_w_in[j], conv_b_in[j], conv_dw[j], conv_dw_b[j],
                            conv_ln_g[j], conv_ln_b[j], conv_w_out[j], conv_b_out[j])
        elif m == 1:
            y = rwkv7_time_mix(hn, rwkv_mix[j], rwkv_w_rkv[j], rwkv_w0[j], rwkv_w1[j], rwkv_w2[j],
                               rwkv_a0[j], rwkv_a1[j], rwkv_a2[j], rwkv_g1[j], rwkv_g2[j],
                               rwkv_k_k[j], rwkv_k_a[j], rwkv_r_k[j], rwkv_gn_g[j], rwkv_gn_b[j],
                               rwkv_w_o[j])
        elif m == 2:
            y = spatial_gating_mixer(hn, sgu_w_in[j], sgu_b_in[j], sgu_ln_g[j], sgu_ln_b[j],
                                     sgu_ws[j], sgu_bs[j], sgu_w_out[j])
        else:
            y = retention_mixer(hn, ret_w_in[j], ret_w_out[j])
        x = x + y
        x = x + memory_cross_attention(rmsnorm(x, xattn_norm_g[i]), rmsnorm(mem, mem_norm_g[i]),
                                       xattn_wq[i], xattn_wkv[i], xattn_wo[i])
        x = x + swiglu(rmsnorm(x, ffn_norm_g[i]), ffn_w_gate_up[i], ffn_w_down[i])
    return rmsnorm(x, final_norm_g)
```

```cpp
#include <hip/hip_runtime.h>
#include <cstdio>
#include <cstdint>
#define ONE_LAUNCH 1
namespace fp {
#define LAS __attribute__((address_space(3)))
#define GAS __attribute__((address_space(1)))
typedef unsigned short bf16_t;
typedef short bf16x8 __attribute__((ext_vector_type(8)));
typedef short s16x4 __attribute__((ext_vector_type(4)));
typedef float f32x2 __attribute__((ext_vector_type(2)));
typedef float f32x4 __attribute__((ext_vector_type(4)));
typedef float f32x16 __attribute__((ext_vector_type(16)));
typedef unsigned u32x2 __attribute__((ext_vector_type(2)));
typedef unsigned u32x4 __attribute__((ext_vector_type(4)));
typedef __bf16 bf16x2_t __attribute__((ext_vector_type(2)));
typedef unsigned long long u64;
typedef long long i64;

constexpr int T = 2048, D = 1024, NMEM = 256, FF = 2816, NWAVES = 8, NTHREADS = 512;
constexpr float SSQ_SCALE = 16777216.0f, SSQ_INV = 1.0f / 16777216.0f;

__device__ __forceinline__ unsigned pk2(float a, float b) { f32x2 v = {a, b}; bf16x2_t r = __builtin_convertvector(v, bf16x2_t); return __builtin_bit_cast(unsigned, r); }
__device__ __forceinline__ float bf_lo(unsigned u) { return __uint_as_float(u << 16); }
__device__ __forceinline__ float bf_hi(unsigned u) { return __uint_as_float(u & 0xffff0000u); }
__device__ __forceinline__ float bf2f(bf16_t b) { return __uint_as_float(((unsigned)b) << 16); }
__device__ __forceinline__ float fast_sigmoid(float x) { return __builtin_amdgcn_rcpf(1.0f + __builtin_amdgcn_exp2f(-1.4426950408889634f * x)); }
__device__ __forceinline__ float fast_silu(float x) { return x * fast_sigmoid(x); }
__device__ __forceinline__ int opaque_tid() { int t = threadIdx.x; asm volatile("" : "+v"(t)); return t; }
__device__ __forceinline__ float wave_sum(float v) {
#pragma unroll
    for (int o = 1; o < 64; o <<= 1) v += __shfl_xor(v, o);
    return v;
}
#define RLX_AGENT __ATOMIC_RELAXED, __HIP_MEMORY_SCOPE_AGENT
__device__ __forceinline__ void atomic_add_i64(i64* p, i64 v) { (void)__hip_atomic_fetch_add((u64*)p, (u64)v, RLX_AGENT); }
__device__ __forceinline__ float rstd_from_ssq(i64 s, float inv_n, float eps) { return rsqrtf((float)s * SSQ_INV * inv_n + eps); }

#define XB_TMO      128
#define XB_XCNT(j)  (256  + 64 * (j))
#define XB_XSUB(j)  (1280 + 64 * (j))
#define XB_XGEN(j)  (2304 + 64 * (j))
#define XB_TOP      3328
#define XB_TOPGEN   3392
#define XCD_BAR_WORDS 3456
#define XB_SPIN_CAP (1u << 22)
__device__ __forceinline__ unsigned xb_ld(unsigned* p)              { return __hip_atomic_load(p, __ATOMIC_RELAXED, __HIP_MEMORY_SCOPE_AGENT); }
__device__ __forceinline__ unsigned xb_add(unsigned* p, unsigned v) { return __hip_atomic_fetch_add(p, v, __ATOMIC_RELAXED, __HIP_MEMORY_SCOPE_AGENT); }
__device__ __forceinline__ unsigned xb_xcc_id() { return (unsigned)__builtin_amdgcn_s_getreg((3 << 11) | 20) & 0xFu; }
#define XB_SPIN(cond, bar) do { unsigned _sp = 0; while (cond) { __builtin_amdgcn_s_sleep(1); \
    if ((++_sp & 255u) == 0u) { if (xb_ld(&(bar)[XB_TMO])) break; if (_sp > XB_SPIN_CAP) { atomicAdd(&(bar)[XB_TMO], 1u); break; } } } } while (0)
struct XcdBarrier { unsigned* bar; unsigned x; volatile LAS unsigned* st; };
__device__ __forceinline__ XcdBarrier xcd_barrier_post(unsigned* bar, volatile LAS unsigned* st) {
    XcdBarrier b; b.bar = bar; b.x = xb_xcc_id(); b.st = st;
    if (threadIdx.x == 0) (void)xb_add(&bar[XB_XCNT(b.x)], 1u);
    return b;
}
__device__ __forceinline__ void xcd_barrier_complete(unsigned* bar, unsigned x, unsigned& nloc, unsigned& nx) {
    const unsigned G = gridDim.x * gridDim.y * gridDim.z;
    unsigned sum, cnt, mine, sp = 0u;
    for (;;) {
        sum = 0u; cnt = 0u; mine = 0u;
#pragma unroll
        for (unsigned j = 0; j < 16; ++j) { const unsigned c = xb_ld(&bar[XB_XCNT(j)]); sum += c; cnt += (c > 0u) ? 1u : 0u; mine = (j == x) ? c : mine; }
        if (sum == G) break;
        __builtin_amdgcn_s_sleep(1);
        if ((++sp & 255u) == 0u) { if (xb_ld(&bar[XB_TMO])) break; if (sp > XB_SPIN_CAP) { atomicAdd(&bar[XB_TMO], 1u); break; } }
    }
    nloc = mine > 0u ? mine : 1u; nx = cnt > 0u ? cnt : 1u;
}
__device__ __forceinline__ void xcd_barrier(const XcdBarrier& b) {
    asm volatile("s_waitcnt vmcnt(0)" ::: "memory");
    __syncthreads();
    if (threadIdx.x == 0) {
        unsigned* bar = b.bar;
        __builtin_amdgcn_s_waitcnt(0);
        unsigned nloc = b.st[0], nx = b.st[1];
        if (nloc == 0u) { xcd_barrier_complete(bar, b.x, nloc, nx); b.st[0] = nloc; b.st[1] = nx; }
        const unsigned old = xb_add(&bar[XB_XSUB(b.x)], 1u);
        const unsigned gen = old / nloc;
        if (old + 1u == (gen + 1u) * nloc) {
            __builtin_amdgcn_fence(__ATOMIC_RELEASE, "agent");
            asm volatile("s_waitcnt vmcnt(0)" ::: "memory");
            const unsigned og = xb_add(&bar[XB_TOP], 1u);
            const unsigned tg = og / nx;
            if (og + 1u == (tg + 1u) * nx) xb_add(&bar[XB_TOPGEN], 1u);
            else XB_SPIN(xb_ld(&bar[XB_TOPGEN]) == tg, bar);
            __builtin_amdgcn_fence(__ATOMIC_ACQUIRE, "agent");
            xb_add(&bar[XB_XGEN(b.x)], 1u);
            asm volatile("s_waitcnt vmcnt(0)" ::: "memory");
        } else {
            XB_SPIN(xb_ld(&bar[XB_XGEN(b.x)]) == gen, bar);
            __builtin_amdgcn_fence(__ATOMIC_ACQUIRE, "agent");
            asm volatile("s_waitcnt vmcnt(0)" ::: "memory");
        }
    }
    __syncthreads();
}

namespace pg8 {
constexpr int BM = 256, BK = 64, HALF = 128, HTB = HALF * BK * 2, STAGE_BYTES = 8 * HTB, NXCD = 8, WGM = 8;
__host__ __device__ __forceinline__ int lds_byte(int r, int c) { const int st = (r >> 4) * 2 + (c >> 5), rr = r & 15, cc = c & 31, ob = rr * 64 + cc * 2; return st * 1024 + (ob ^ (((ob >> 9) & 1) << 5)); }
__host__ __device__ __forceinline__ void stage_rc(int b, int& R, int& C) { const int st = b / 1024, sb = b % 1024, swz = sb ^ (((sb >> 9) & 1) << 5); R = (st >> 1) * 16 + swz / 64; C = (st & 1) * 32 + (swz % 64) / 2; }
__host__ __device__ __forceinline__ int perm32(int rho) { const int n = rho >> 4, i = rho & 15; return 8 * (i >> 2) + 4 * n + (i & 3); }

struct Unit { int pm, pn; };
struct Gemm { const bf16_t* A; const bf16_t* Bt; int M, N, K, lda, ldb, ksplit, ajump, seq_pad; };
__device__ __forceinline__ Gemm make_gemm(const bf16_t* A, int lda, const bf16_t* Bt, int ldb, int M, int N, int K) { Gemm g; g.A = A; g.Bt = Bt; g.M = M; g.N = N; g.K = K; g.lda = lda; g.ldb = ldb; g.ksplit = 1 << 20; g.ajump = 0; g.seq_pad = 0; return g; }

struct StaticOrder {
    int nM, nN, nwg, G, c;
    __device__ void init(int M, int N, int G_, int c_) { nM = M / BM; nN = N / BM; nwg = nM * nN; G = G_; c = c_; }
    __device__ bool next(int i, Unit& u) const {
        const long L = (long)i * G + c; if (L >= nwg) return false;
        int wgid = (int)L; { const int q = nwg / NXCD, r = nwg % NXCD, xcd = wgid % NXCD, off = wgid / NXCD; wgid = (xcd < r ? xcd * (q + 1) : r * (q + 1) + (xcd - r) * q) + off; }
        const int nig = WGM * nN, gid = wgid / nig, fm = gid * WGM, gsz = (nM - fm) < WGM ? (nM - fm) : WGM;
        u.pm = fm + ((wgid % nig) % gsz); u.pn = (wgid % nig) / gsz; return true;
    }
};

template <class Epi>
__device__ __forceinline__ void gemm_phase(LAS unsigned char* lds, const Gemm g, const StaticOrder& S, const Epi& E) {
    int tid_ = threadIdx.x; asm volatile("" : "+v"(tid_));
    const int tid = tid_, wid = __builtin_amdgcn_readfirstlane(tid >> 6), lane = tid & 63, wr = wid >> 2, wc = wid & 3, fr = lane & 15, fq = lane >> 4;
    const int K = g.K, nt = K / BK;
    unsigned voffA[2], voffB[2];
#pragma unroll
    for (int i = 0; i < 2; ++i) { int R, C; stage_rc(tid * 16 + i * 8192, R, C); const int Rb = Epi::PERM ? ((R & ~31) + perm32(R & 31)) : R;
        voffA[i] = (unsigned)(R * g.lda + C) * 2u; voffB[i] = (unsigned)(Rb * g.ldb + C) * 2u; }
    const long kstep = (long)(BK * 2);
    const long hstepA = (long)HALF * g.lda * 2, hstepB = (long)HALF * g.ldb * 2;
    const long rowA = (long)g.lda * 2;
    const int ksplit = g.ksplit; const long ajump = g.ajump;
    const unsigned ldsw = (unsigned)wid * 1024u;
    const int aoff = lds_byte(wr * 64 + fr, fq * 8), boff = lds_byte(wc * 32 + fr, fq * 8);
#define PG8_SA(b, h) (((b) * 2 + (h)) * HTB)
#define PG8_SB(b, h) ((4 + (b) * 2 + (h)) * HTB)
#define PG8_STAGE(bufoff, gbase, voff) do { _Pragma("unroll") for (int _i = 0; _i < 2; ++_i) \
        __builtin_amdgcn_global_load_lds((const unsigned*)((const char*)(gbase) + (voff)[_i]), (LAS unsigned*)(lds + (bufoff) + ldsw + _i * 8192), 16, 0, 0); } while (0)
#define PG8_LDA(dst, b, h) do { _Pragma("unroll") for (int m = 0; m < 4; ++m) _Pragma("unroll") for (int k = 0; k < 2; ++k) dst[m][k] = *(const LAS bf16x8*)(lds + PG8_SA(b, h) + aoff + m * 2048 + k * 1024); } while (0)
#define PG8_LDB(dst, b, h) do { _Pragma("unroll") for (int n = 0; n < 2; ++n) _Pragma("unroll") for (int k = 0; k < 2; ++k) dst[n][k] = *(const LAS bf16x8*)(lds + PG8_SB(b, h) + boff + n * 2048 + k * 1024); } while (0)
#define PG8_MMA(ai, bj, At, Bt) do { __builtin_amdgcn_s_setprio(1); _Pragma("unroll") for (int m = 0; m < 4; ++m) _Pragma("unroll") for (int n = 0; n < 2; ++n) _Pragma("unroll") for (int k = 0; k < 2; ++k) \
        acc[ai][bj][m][n] = __builtin_amdgcn_mfma_f32_16x16x32_bf16(Bt[n][k], At[m][k], acc[ai][bj][m][n], 0, 0, 0); __builtin_amdgcn_s_setprio(0); } while (0)
#define PG8_WAIT_V(n) asm volatile("s_waitcnt vmcnt(" #n ")" ::: "memory")
#define PG8_WAIT_L(n) asm volatile("s_waitcnt lgkmcnt(" #n ")" ::: "memory")
#define PG8_BAR __builtin_amdgcn_s_barrier()
#define PG8_SCHED __builtin_amdgcn_sched_barrier(0)
#define PG8_ABASE(u) ((const char*)g.A + ((long)(u).pm * BM + (g.seq_pad ? (((u).pm >> 3) + 1) : 0)) * rowA)
#define PG8_BBASE(u) ((const char*)g.Bt + (long)(u).pn * 2 * hstepB)
#define PG8_AK(base, kt) ((base) + (long)(kt) * kstep + ((kt) >= ksplit ? ajump : 0L))
    Unit cur, nxt; int ui = 0;
    if (!S.next(0, cur)) return;
    f32x4 acc[2][2][4][2];
#pragma unroll
    for (int a = 0; a < 2; ++a)
#pragma unroll
        for (int b = 0; b < 2; ++b)
#pragma unroll
            for (int m = 0; m < 4; ++m)
#pragma unroll
                for (int n = 0; n < 2; ++n) acc[a][b][m][n] = (f32x4){0.f, 0.f, 0.f, 0.f};
    bf16x8 At[4][2], B0[2][2], B1[2][2];
    const char* cA = PG8_ABASE(cur); const char* cB = PG8_BBASE(cur);
    PG8_STAGE(PG8_SB(0, 0), cB, voffB); PG8_STAGE(PG8_SB(0, 1), cB + hstepB, voffB); PG8_STAGE(PG8_SA(0, 0), cA, voffA); PG8_STAGE(PG8_SA(0, 1), cA + hstepA, voffA);
    if (wr == 1) PG8_BAR;
    PG8_WAIT_V(2); PG8_BAR;
    { const char* a1p = PG8_AK(cA, 1);
      PG8_STAGE(PG8_SB(1, 0), cB + kstep, voffB); PG8_STAGE(PG8_SA(1, 0), a1p, voffA); PG8_STAGE(PG8_SB(1, 1), cB + hstepB + kstep, voffB); }
    PG8_WAIT_V(6); PG8_BAR;
    for (;;) {
        const bool has_next = S.next(ui + 1, nxt);
        const char* nA = has_next ? PG8_ABASE(nxt) : cA; const char* nB = has_next ? PG8_BBASE(nxt) : cB;
        for (int t = 0; t < nt; t += 2) {
            const bool last = (t == nt - 2);
            const char* a1 = PG8_AK(cA, t + 1);
            const char* a2 = last ? nA : PG8_AK(cA, t + 2); const char* b2 = last ? nB : cB + (long)(t + 2) * kstep;
            const char* a3 = last ? PG8_AK(nA, 1) : PG8_AK(cA, t + 3); const char* b3 = b2 + kstep;
            PG8_LDB(B0, 0, 0); PG8_LDB(B1, 0, 1); PG8_SCHED; PG8_LDA(At, 0, 0); PG8_STAGE(PG8_SA(1, 1), a1 + hstepA, voffA);
            PG8_WAIT_V(8); PG8_WAIT_L(0); PG8_BAR; PG8_MMA(0, 0, At, B0); PG8_MMA(0, 1, At, B1); PG8_BAR; PG8_SCHED;
            PG8_LDA(At, 0, 1); PG8_STAGE(PG8_SB(0, 0), b2, voffB); PG8_STAGE(PG8_SB(0, 1), b2 + hstepB, voffB); PG8_STAGE(PG8_SA(0, 0), a2, voffA);
            PG8_WAIT_V(8); PG8_WAIT_L(0); PG8_BAR; PG8_MMA(1, 0, At, B0); PG8_MMA(1, 1, At, B1); PG8_BAR; PG8_SCHED;
            PG8_LDB(B0, 1, 0); PG8_LDB(B1, 1, 1); PG8_SCHED; PG8_LDA(At, 1, 0); PG8_STAGE(PG8_SA(0, 1), a2 + hstepA, voffA);
            PG8_WAIT_V(8); PG8_WAIT_L(0); PG8_BAR; PG8_MMA(0, 0, At, B0); PG8_MMA(0, 1, At, B1); PG8_BAR; PG8_SCHED;
            PG8_LDA(At, 1, 1); PG8_STAGE(PG8_SB(1, 0), b3, voffB); PG8_STAGE(PG8_SB(1, 1), b3 + hstepB, voffB); PG8_STAGE(PG8_SA(1, 0), a3, voffA);
            PG8_WAIT_V(8); PG8_WAIT_L(0); PG8_BAR; PG8_MMA(1, 0, At, B0); PG8_MMA(1, 1, At, B1); PG8_BAR; PG8_SCHED;
        }
        if (wr == 0) PG8_BAR;
        E(acc, cur, wr, wc, fr, fq);
        if (!has_next) break;
#pragma unroll
        for (int a = 0; a < 2; ++a)
#pragma unroll
            for (int b = 0; b < 2; ++b)
#pragma unroll
                for (int m = 0; m < 4; ++m)
#pragma unroll
                    for (int n = 0; n < 2; ++n) acc[a][b][m][n] = (f32x4){0.f, 0.f, 0.f, 0.f};
        cur = nxt; cA = nA; cB = nB; ++ui;
        if (wr == 1) PG8_BAR;
    }
    PG8_WAIT_V(0);
    PG8_BAR;
#undef PG8_SA
#undef PG8_SB
#undef PG8_STAGE
#undef PG8_LDA
#undef PG8_LDB
#undef PG8_MMA
#undef PG8_WAIT_V
#undef PG8_WAIT_L
#undef PG8_BAR
#undef PG8_SCHED
#undef PG8_ABASE
#undef PG8_BBASE
#undef PG8_AK
}

typedef f32x4 Acc[2][2][4][2];
#define EPI_ROWS(u, wr, fr, ai, m) ((u).pm * BM + (ai) * HALF + (wr) * 64 + (m) * 16 + (fr))

struct EpiBf16 {
    static constexpr bool PERM = true;
    bf16_t* O; int ldc; const i64* ssq; const float* rowscale; const float* bias; int row_off;
    __device__ __forceinline__ void operator()(const Acc& acc, const Unit& u, int wr, int wc, int fr, int fq) const {
        const int col0 = u.pn * BM + wc * 32 + 8 * fq;
#pragma unroll
        for (int ai = 0; ai < 2; ++ai)
#pragma unroll
            for (int m = 0; m < 4; ++m) {
                const int row = EPI_ROWS(u, wr, fr, ai, m);
                float rs = 1.0f;
                if (ssq) rs = rstd_from_ssq(ssq[row + row_off], 1.0f / 1024.0f, 1e-6f);
                else if (rowscale) rs = rowscale[row + row_off];
                bf16_t* rowp = O + (size_t)row * ldc + col0;
#pragma unroll
                for (int bj = 0; bj < 2; ++bj) {
                    f32x4 v0 = acc[ai][bj][m][0] * rs, v1 = acc[ai][bj][m][1] * rs;
                    if (bias) { v0 += *(const f32x4*)(bias + col0 + bj * HALF); v1 += *(const f32x4*)(bias + col0 + bj * HALF + 4); }
                    u32x4 w; w.x = pk2(v0[0], v0[1]); w.y = pk2(v0[2], v0[3]); w.z = pk2(v1[0], v1[1]); w.w = pk2(v1[2], v1[3]);
                    *(u32x4*)(rowp + bj * HALF) = w;
                }
            }
    }
};
struct EpiBf16ColScale {
    static constexpr bool PERM = true;
    bf16_t* O; int ldc; const float* colscale;
    __device__ __forceinline__ void operator()(const Acc& acc, const Unit& u, int wr, int wc, int fr, int fq) const {
        const int col0 = u.pn * BM + wc * 32 + 8 * fq;
        f32x4 cs[2][2];
#pragma unroll
        for (int bj = 0; bj < 2; ++bj) { cs[bj][0] = *(const f32x4*)(colscale + col0 + bj * HALF); cs[bj][1] = *(const f32x4*)(colscale + col0 + bj * HALF + 4); }
#pragma unroll
        for (int ai = 0; ai < 2; ++ai)
#pragma unroll
            for (int m = 0; m < 4; ++m) {
                const int row = EPI_ROWS(u, wr, fr, ai, m);
                bf16_t* rowp = O + (size_t)row * ldc + col0;
#pragma unroll
                for (int bj = 0; bj < 2; ++bj) {
                    const f32x4 v0 = acc[ai][bj][m][0] * cs[bj][0], v1 = acc[ai][bj][m][1] * cs[bj][1];
                    u32x4 w; w.x = pk2(v0[0], v0[1]); w.y = pk2(v0[2], v0[3]); w.z = pk2(v1[0], v1[1]); w.w = pk2(v1[2], v1[3]);
                    *(u32x4*)(rowp + bj * HALF) = w;
                }
            }
    }
};
template <int MODE> struct EpiGated {
    static constexpr bool PERM = true;
    bf16_t* O; int ldc; const i64* ssq; const float* biasA; const float* biasB;
    __device__ __forceinline__ void operator()(const Acc& acc, const Unit& u, int wr, int wc, int fr, int fq) const {
        const int col0 = u.pn * HALF + wc * 32 + 8 * fq;
        f32x4 ba[2], bb[2];
        if (MODE == 1) { ba[0] = *(const f32x4*)(biasA + col0); ba[1] = *(const f32x4*)(biasA + col0 + 4); bb[0] = *(const f32x4*)(biasB + col0); bb[1] = *(const f32x4*)(biasB + col0 + 4); }
#pragma unroll
        for (int ai = 0; ai < 2; ++ai)
#pragma unroll
            for (int m = 0; m < 4; ++m) {
                const int row = EPI_ROWS(u, wr, fr, ai, m);
                const float rs = rstd_from_ssq(ssq[row], 1.0f / 1024.0f, 1e-6f);
                float o[8];
#pragma unroll
                for (int n = 0; n < 2; ++n)
#pragma unroll
                    for (int j = 0; j < 4; ++j) {
                        float a = acc[ai][0][m][n][j] * rs, b = acc[ai][1][m][n][j] * rs;
                        if (MODE == 0) o[n * 4 + j] = fast_silu(a) * b;
                        else o[n * 4 + j] = (a + ba[n][j]) * fast_sigmoid(b + bb[n][j]);
                    }
                u32x4 w; w.x = pk2(o[0], o[1]); w.y = pk2(o[2], o[3]); w.z = pk2(o[4], o[5]); w.w = pk2(o[6], o[7]);
                *(u32x4*)(O + (size_t)row * ldc + col0) = w;
            }
    }
};
struct EpiResid {
    static constexpr bool PERM = false;
    float* X; bf16_t* Xb; i64* ssq_out; const float* bias; int row_off;
    __device__ __forceinline__ void operator()(const Acc& acc, const Unit& u, int wr, int wc, int fr, int fq) const {
        const int col0 = u.pn * BM + wc * 32 + 4 * fq;
#pragma unroll
        for (int ai = 0; ai < 2; ++ai)
#pragma unroll
            for (int m = 0; m < 4; ++m) {
                const int row = EPI_ROWS(u, wr, fr, ai, m) + row_off;
                float* xr = X + (size_t)row * D + col0; bf16_t* xb = Xb + (size_t)row * D + col0;
                float ss = 0.f;
#pragma unroll
                for (int bj = 0; bj < 2; ++bj)
#pragma unroll
                    for (int n = 0; n < 2; ++n) {
                        f32x4 v = *(const f32x4*)(xr + bj * HALF + n * 16) + acc[ai][bj][m][n];
                        if (bias) v += *(const f32x4*)(bias + col0 + bj * HALF + n * 16);
                        *(f32x4*)(xr + bj * HALF + n * 16) = v;
                        u32x2 w; w.x = pk2(v[0], v[1]); w.y = pk2(v[2], v[3]);
                        *(u32x2*)(xb + bj * HALF + n * 16) = w;
                        ss += (v[0] * v[0] + v[1] * v[1]) + (v[2] * v[2] + v[3] * v[3]);
                    }
                ss += __shfl_xor(ss, 16); ss += __shfl_xor(ss, 32);
                if (fq == 0) atomic_add_i64(ssq_out + row, (i64)(ss * SSQ_SCALE + 0.5f));
            }
    }
};
}
constexpr size_t MiB = 1u << 20;
constexpr int LDS_BYTES = 163840, RING_BYTES = 131072, LDSCTL_OFF = LDS_BYTES - 1024;

struct Inputs {
    const float *x, *mem, *mix_norm_g, *xattn_norm_g, *mem_norm_g, *xattn_wq, *xattn_wkv, *xattn_wo, *ffn_norm_g, *ffn_w_gate_up, *ffn_w_down,
        *conv_w_in, *conv_b_in, *conv_dw, *conv_dw_b, *conv_ln_g, *conv_ln_b, *conv_w_out, *conv_b_out,
        *rwkv_mix, *rwkv_w_rkv, *rwkv_w0, *rwkv_w1, *rwkv_w2, *rwkv_a0, *rwkv_a1, *rwkv_a2, *rwkv_g1, *rwkv_g2, *rwkv_k_k, *rwkv_k_a, *rwkv_r_k, *rwkv_gn_g, *rwkv_gn_b, *rwkv_w_o,
        *sgu_w_in, *sgu_b_in, *sgu_ln_g, *sgu_ln_b, *sgu_ws, *sgu_bs, *sgu_w_out, *ret_w_in, *ret_w_out, *final_norm_g;
};
struct WsMap {
    size_t ctl, ssq, lns, oss, rope, wstril, rstd_mem, wk_all, wv_all, mem_b, kall, vtall, wb0, wb1, xb, act, end;
};
__host__ __device__ inline WsMap make_wsmap(int NB) {
    WsMap w; const size_t M = (size_t)NB * T; size_t o = 0;
    w.ctl = o; o += 1 * MiB;
    w.ssq = o; o += 2 * M * 8;
    w.lns = o; o += M * 2 * 8;
    w.oss = o; o += M * 4 * 8;
    o = (o + MiB - 1) / MiB * MiB;
    w.rope = o; o += (size_t)T * 128 * 8;
    w.wstril = o; o += 8 * 128 * 128 * 2;
    w.rstd_mem = o; o += (size_t)NB * NMEM * 4; o = (o + MiB - 1) / MiB * MiB;
    w.wk_all = o; o += 8 * MiB; w.wv_all = o; o += 8 * MiB;
    w.mem_b = o; o += (size_t)NB * NMEM * D * 2; o = (o + MiB - 1) / MiB * MiB;
    w.kall = o; o += (size_t)NB * NMEM * 4096 * 2; w.vtall = o; o += (size_t)NB * NMEM * 4096 * 2; o = (o + MiB - 1) / MiB * MiB;
    w.wb0 = o; o += 37 * MiB; w.wb1 = o; o += 37 * MiB;
    w.xb = o; o += M * D * 2;
    w.act = o; o += (size_t)NB * 2048 * 8704 + 4 * MiB;
    w.end = o; return w;
}
constexpr size_t ZERO_BYTES_PER_SEQ = (size_t)T * 8 * 8;
constexpr size_t WB_WQ = 0, WB_WO = 2 * MiB, WB_GU = 4 * MiB, WB_DOWN = 15 * MiB, WB_MIX = 21 * MiB;
constexpr size_t WB_CONV_IN = WB_MIX, WB_CONV_OUT = WB_MIX + 4 * MiB;
constexpr size_t WB_RW_RKV = WB_MIX, WB_RW_L1 = WB_MIX + 6 * MiB, WB_RW_W2 = WB_MIX + 8 * MiB, WB_RW_A2 = WB_RW_W2 + MiB / 2, WB_RW_G2 = WB_RW_W2 + MiB, WB_RW_WO = WB_MIX + 10 * MiB;
constexpr size_t WB_SGU_IN = WB_MIX, WB_SGU_OUT = WB_MIX + 8 * MiB;
constexpr size_t WB_RET_QKV = WB_MIX, WB_RET_G = WB_MIX + 8 * MiB, WB_RET_OUT = WB_MIX + 12 * MiB;

struct Args { Inputs in; float* out; unsigned char* ws; const float* load_src; int NB, ph_lo, ph_hi, use_bar, load_slot, conv_layer_p1; };

struct Frame {
    LAS unsigned char* lds;
    int wave, vcu, G, gw, NGW;
    int NB, M;
    unsigned char* ws; WsMap wm;
    float* X; bf16_t* Xb; i64* ssq; i64* lns; i64* oss;
};

struct WConv { const float* src; int src_ld, Ksrc, koff, Kdst, kd0, kd1; bf16_t* dst; int nrows, nvalid, map_blk, map_halfoff, col0; const float* kvec; float sa, sb, cscale; };
__device__ __forceinline__ WConv wconv(const float* src, int src_ld, int Ksrc, bf16_t* dst, int nrows, int Kdst) {
    WConv w; w.src = src; w.src_ld = src_ld; w.Ksrc = Ksrc; w.koff = 0; w.Kdst = Kdst; w.kd0 = 0; w.kd1 = Kdst; w.dst = dst; w.nrows = nrows; w.nvalid = nrows; w.map_blk = 0; w.map_halfoff = 0; w.col0 = 0;
    w.kvec = nullptr; w.sa = 1.f; w.sb = 0.f; w.cscale = 1.f; return w;
}
__device__ __forceinline__ void convert_w(const Frame& F, const WConv& w) {
    LAS float* scr = (LAS float*)(F.lds + F.wave * 16384);
    const int nblk = w.nrows / 32, kblk = (w.kd1 - w.kd0) / 64, nitems = nblk * kblk, lane = opaque_tid() & 63;
    for (int it = F.gw; it < nitems; it += F.NGW) {
        const int kb = it / nblk, nb = it % nblk, k0 = w.kd0 + 64 * kb, n0 = 32 * nb;
        const int n = n0 + (lane & 31);
        int col = w.col0 + n;
        if (w.map_blk) { const int b2 = 2 * w.map_blk; col = w.col0 + ((n % b2) / w.map_blk) * w.map_halfoff + (n / b2) * w.map_blk + n % w.map_blk; }
#pragma unroll 8
        for (int i = 0; i < 32; ++i) {
            const int kk = 2 * i + (lane >> 5), k = k0 + kk - w.koff; float v = 0.f;
            if (k >= 0 && k < w.Ksrc && n < w.nvalid) { v = w.src[(size_t)k * w.src_ld + col] * w.cscale; if (w.kvec) v *= (w.sa + w.sb * w.kvec[k]); }
            scr[kk * 33 + (lane & 31)] = v;
        }
        asm volatile("s_waitcnt lgkmcnt(0)" ::: "memory");
        const int c = lane & 7;
#pragma unroll
        for (int j = 0; j < 4; ++j) { const int nn = (lane >> 3) + 8 * j; const LAS float* s = scr + (8 * c) * 33 + nn;
            u32x4 o; o.x = pk2(s[0 * 33], s[1 * 33]); o.y = pk2(s[2 * 33], s[3 * 33]); o.z = pk2(s[4 * 33], s[5 * 33]); o.w = pk2(s[6 * 33], s[7 * 33]);
            *(u32x4*)(w.dst + (size_t)(n0 + nn) * w.Kdst + k0 + 8 * c) = o; }
        asm volatile("s_waitcnt lgkmcnt(0)" ::: "memory");
    }
}
__device__ __forceinline__ void convert_layer_weights(const Frame& F, const Inputs& I, int L, unsigned char* wb) {
    const size_t DD = (size_t)D * D;
    { WConv w = wconv(I.xattn_wq + L * DD, D, D, (bf16_t*)(wb + WB_WQ), D, D); w.kvec = I.xattn_norm_g + L * D; w.sa = 0.f; w.sb = 1.f; w.cscale = 0.0625f * 1.4426950408889634f; convert_w(F, w); }
    { WConv w = wconv(I.xattn_wo + L * DD, D, D, (bf16_t*)(wb + WB_WO), D, D); convert_w(F, w); }
    { WConv w = wconv(I.ffn_w_gate_up + (size_t)L * D * 2 * FF, 2 * FF, D, (bf16_t*)(wb + WB_GU), 2 * FF, D); w.kvec = I.ffn_norm_g + L * D; w.sa = 0.f; w.sb = 1.f; w.map_blk = 128; w.map_halfoff = FF; convert_w(F, w); }
    { WConv w = wconv(I.ffn_w_down + (size_t)L * FF * D, D, FF, (bf16_t*)(wb + WB_DOWN), D, FF); convert_w(F, w); }
    if (L == 0) {
        { WConv w = wconv(I.conv_w_in, 2 * D, D, (bf16_t*)(wb + WB_CONV_IN), 2 * D, D); w.kvec = I.mix_norm_g; w.sa = 0.f; w.sb = 1.f; w.map_blk = 128; w.map_halfoff = D; convert_w(F, w); }
        { WConv w = wconv(I.conv_w_out, D, D, (bf16_t*)(wb + WB_CONV_OUT), D, D); convert_w(F, w); }
    } else if (L == 1) {
        for (int i = 0; i < 3; ++i) { WConv w = wconv(I.rwkv_w_rkv + i * DD, D, D, (bf16_t*)(wb + WB_RW_RKV) + i * DD, D, D); convert_w(F, w); }
        bf16_t* l1 = (bf16_t*)(wb + WB_RW_L1);
        for (int part = 0; part < 2; ++part) {
            const float sa = part ? 0.f : 1.f, sb = part ? 1.f : -1.f; const int kd0 = part * D, kd1 = kd0 + D;
            { WConv w = wconv(I.rwkv_w1, 64, D, l1, 64, 2 * D); w.kvec = I.rwkv_mix + 1 * D; w.sa = sa; w.sb = sb; w.koff = kd0; w.kd0 = kd0; w.kd1 = kd1; convert_w(F, w); }
            { WConv w = wconv(I.rwkv_a1, 64, D, l1 + 64 * 2 * D, 64, 2 * D); w.kvec = I.rwkv_mix + 4 * D; w.sa = sa; w.sb = sb; w.koff = kd0; w.kd0 = kd0; w.kd1 = kd1; convert_w(F, w); }
            { WConv w = wconv(I.rwkv_g1, 160, D, l1 + 128 * 2 * D, 384, 2 * D); w.nvalid = 160; w.kvec = I.rwkv_mix + 5 * D; w.sa = sa; w.sb = sb; w.koff = kd0; w.kd0 = kd0; w.kd1 = kd1; convert_w(F, w); }
        }
        { WConv w = wconv(I.rwkv_w2, D, 64, (bf16_t*)(wb + WB_RW_W2), D, 256); convert_w(F, w); }
        { WConv w = wconv(I.rwkv_a2, D, 64, (bf16_t*)(wb + WB_RW_A2), D, 256); w.koff = 64; convert_w(F, w); }
        { WConv w = wconv(I.rwkv_g2, D, 160, (bf16_t*)(wb + WB_RW_G2), D, 256); convert_w(F, w); }
        { WConv w = wconv(I.rwkv_w_o, D, D, (bf16_t*)(wb + WB_RW_WO), D, D); convert_w(F, w); }
    } else if (L == 2) {
        { WConv w = wconv(I.sgu_w_in, 4096, D, (bf16_t*)(wb + WB_SGU_IN), 4096, D); w.kvec = I.mix_norm_g + 2 * D; w.sa = 0.f; w.sb = 1.f; convert_w(F, w); }
        { WConv w = wconv(I.sgu_w_out, D, 2048, (bf16_t*)(wb + WB_SGU_OUT), D, 2048); convert_w(F, w); }
    } else {
        for (int part = 0; part < 3; ++part) {
            const int c0 = part == 0 ? 0 : (part == 1 ? 1024 : 2048), nr = part == 2 ? 2048 : 1024;
            WConv w = wconv(I.ret_w_in, 6144, D, (bf16_t*)(wb + WB_RET_QKV) + (size_t)c0 * D, nr, D); w.col0 = c0; w.kvec = I.mix_norm_g + 3 * D; w.sa = 0.f; w.sb = 1.f; w.cscale = part == 1 ? 0.0625f : 1.f; convert_w(F, w);
        }
        { WConv w = wconv(I.ret_w_in, 6144, D, (bf16_t*)(wb + WB_RET_G), 2048, D); w.col0 = 4096; w.kvec = I.mix_norm_g + 3 * D; w.sa = 0.f; w.sb = 1.f; convert_w(F, w); }
        { WConv w = wconv(I.ret_w_out, D, 2048, (bf16_t*)(wb + WB_RET_OUT), D, 2048); convert_w(F, w); }
    }
}

__device__ __forceinline__ void load_rows(const Frame& F, const float* src, float* X, bf16_t* Xb, i64* ssq_slot, int nrows) {
    const int lane = opaque_tid() & 63;
    for (int r = F.gw; r < nrows; r += F.NGW) {
        const f32x4* s = (const f32x4*)(src + (size_t)r * D) + lane; f32x4 v[4]; float ss = 0.f;
#pragma unroll
        for (int j = 0; j < 4; ++j) { v[j] = s[64 * j]; ss += (v[j][0] * v[j][0] + v[j][1] * v[j][1]) + (v[j][2] * v[j][2] + v[j][3] * v[j][3]); }
        ss = wave_sum(ss);
        if (X) { f32x4* d = (f32x4*)(X + (size_t)r * D) + lane;
#pragma unroll
            for (int j = 0; j < 4; ++j) d[64 * j] = v[j]; }
        u32x2* db = (u32x2*)(Xb + (size_t)r * D) + lane;
#pragma unroll
        for (int j = 0; j < 4; ++j) { u32x2 w; w.x = pk2(v[j][0], v[j][1]); w.y = pk2(v[j][2], v[j][3]); db[64 * j] = w; }
        if (lane == 0) ssq_slot[r] = (i64)(ss * SSQ_SCALE + 0.5f);
    }
}
__device__ __forceinline__ void load_mem_rows(const Frame& F, const float* src, bf16_t* mb, float* rstd, int nrows) {
    const int lane = opaque_tid() & 63;
    for (int r = F.gw; r < nrows; r += F.NGW) {
        const f32x4* s = (const f32x4*)(src + (size_t)r * D) + lane; f32x4 v[4]; float ss = 0.f;
#pragma unroll
        for (int j = 0; j < 4; ++j) { v[j] = s[64 * j]; ss += (v[j][0] * v[j][0] + v[j][1] * v[j][1]) + (v[j][2] * v[j][2] + v[j][3] * v[j][3]); }
        ss = wave_sum(ss);
        u32x2* db = (u32x2*)(mb + (size_t)r * D) + lane;
#pragma unroll
        for (int j = 0; j < 4; ++j) { u32x2 w; w.x = pk2(v[j][0], v[j][1]); w.y = pk2(v[j][2], v[j][3]); db[64 * j] = w; }
        if (lane == 0) rstd[r] = rsqrtf(ss * (1.0f / D) + 1e-6f);
    }
}
__device__ __forceinline__ void zero_i64(const Frame& F, i64* p, size_t n) {
    const int lane = opaque_tid() & 63;
    for (size_t i = (size_t)F.gw * 64 + lane; i < n; i += (size_t)F.NGW * 64) p[i] = 0;
}
__device__ __forceinline__ void final_norm(const Frame& F, float* X, const i64* ssq_slot, const float* g, int nrows) {
    const int lane = opaque_tid() & 63;
    f32x4 gv[4];
#pragma unroll
    for (int j = 0; j < 4; ++j) gv[j] = ((const f32x4*)g)[lane + 64 * j];
    for (int r = F.gw; r < nrows; r += F.NGW) {
        const float rs = rstd_from_ssq(ssq_slot[r], 1.0f / D, 1e-6f);
        f32x4* s = (f32x4*)(X + (size_t)r * D) + lane;
#pragma unroll
        for (int j = 0; j < 4; ++j) s[64 * j] = s[64 * j] * rs * gv[j];
    }
}
__device__ __forceinline__ void make_tables(const Frame& F, const Inputs& I) {
    const int lane = opaque_tid() & 63;
    f32x2* rope = (f32x2*)(F.ws + F.wm.rope);
    for (int i = F.gw * 64 + lane; i < T * 128; i += F.NGW * 64) { const int t = i >> 7, p = i & 127; const float ang = powf(10000.0f, -(float)p / 127.0f), th = (float)t * ang; rope[i] = (f32x2){cosf(th), sinf(th)}; }
    bf16_t* wt = (bf16_t*)(F.ws + F.wm.wstril);
    for (int i = F.gw * 64 + lane; i < 8 * 128 * 128; i += F.NGW * 64) { const int t = (i >> 7) & 127, s = i & 127; wt[i] = (s <= t) ? (bf16_t)(pk2(I.sgu_ws[i], 0.f) & 0xffffu) : (bf16_t)0; }
}
__device__ __forceinline__ void attn_phase(const Frame& F, bf16_t* Q, const bf16_t* Kall, const bf16_t* Vtall, int L) {
    int tid_ = threadIdx.x; asm volatile("" : "+v"(tid_));
    const int tid = tid_, lane = tid & 63, wave = F.wave;
    const int q = lane & 31, hh = lane >> 5;
    const int nunits = F.NB * 4 * (T / 256);
    const int ldv = F.NB * NMEM;
    LAS unsigned char* lds = F.lds;
    for (int u = F.vcu; u < nunits; u += F.G) {
        const int qb = u % (T / 256), h = (u / (T / 256)) % 4, b = u / (4 * (T / 256));
        {
            const bf16_t* kg = Kall + (size_t)(b * NMEM) * 4096 + L * 1024 + h * 256;
#pragma unroll 4
            for (int i = 0; i < 16; ++i) { const int cid = tid + 512 * i, row = cid >> 5, ch = cid & 31;
                const u32x4 v = *(const u32x4*)(kg + (size_t)row * 4096 + ch * 8);
                *(LAS u32x4*)(lds + row * 528 + ch * 16) = v; }
        }
        bf16_t* qrow = Q + (size_t)(b * T + qb * 256 + wave * 32 + q) * D + h * 256;
        __syncthreads();
        f32x16 sacc[8];
#pragma unroll
        for (int kb = 0; kb < 8; ++kb)
#pragma unroll
            for (int i = 0; i < 16; ++i) sacc[kb][i] = 0.f;
#pragma unroll 4
        for (int s = 0; s < 16; ++s) {
            const bf16x8 qf = *(const bf16x8*)(qrow + 16 * s + 8 * hh);
#pragma unroll
            for (int kb = 0; kb < 8; ++kb) {
                const bf16x8 kf = *(const LAS bf16x8*)(lds + (32 * kb + q) * 528 + (16 * s + 8 * hh) * 2);
                sacc[kb] = __builtin_amdgcn_mfma_f32_32x32x16_bf16(kf, qf, sacc[kb], 0, 0, 0);
            }
        }
        float mx = -3.0e38f;
#pragma unroll
        for (int kb = 0; kb < 8; ++kb)
#pragma unroll
            for (int i = 0; i < 16; ++i) mx = fmaxf(mx, sacc[kb][i]);
        mx = fmaxf(mx, __shfl_xor(mx, 32));
        float sum = 0.f;
        bf16x8 pf[8][2];
#pragma unroll
        for (int kb = 0; kb < 8; ++kb) {
            float p[16];
#pragma unroll
            for (int i = 0; i < 16; ++i) { p[i] = __builtin_amdgcn_exp2f(sacc[kb][i] - mx); sum += p[i]; }
#pragma unroll
            for (int s = 0; s < 2; ++s) { u32x4 w; w.x = pk2(p[8 * s + 0], p[8 * s + 1]); w.y = pk2(p[8 * s + 2], p[8 * s + 3]); w.z = pk2(p[8 * s + 4], p[8 * s + 5]); w.w = pk2(p[8 * s + 6], p[8 * s + 7]);
                pf[kb][s] = __builtin_bit_cast(bf16x8, w); }
        }
        sum += __shfl_xor(sum, 32);
        const float inv = 1.0f / sum;
        __syncthreads();
        {
            const bf16_t* vg = Vtall + (size_t)(L * 1024 + h * 256) * ldv + b * NMEM;
#pragma unroll 4
            for (int i = 0; i < 16; ++i) { const int cid = tid + 512 * i, row = cid >> 5, ch = cid & 31;
                const u32x4 v = *(const u32x4*)(vg + (size_t)row * ldv + ch * 8);
                LAS u32x2* d = (LAS u32x2*)(lds + row * 520 + ch * 16);
                d[0] = (u32x2){v.x, v.y}; d[1] = (u32x2){v.z, v.w}; }
        }
        __syncthreads();
#pragma unroll
        for (int db = 0; db < 8; ++db) {
            f32x16 o;
#pragma unroll
            for (int i = 0; i < 16; ++i) o[i] = 0.f;
#pragma unroll
            for (int kb = 0; kb < 8; ++kb)
#pragma unroll
                for (int s = 0; s < 2; ++s) {
                    const LAS unsigned char* vp = lds + (32 * db + q) * 520 + (32 * kb + 16 * s + 4 * hh) * 2;
                    const s16x4 lo = *(const LAS s16x4*)(vp), hi = *(const LAS s16x4*)(vp + 16);
                    const bf16x8 vf = __builtin_shufflevector(lo, hi, 0, 1, 2, 3, 4, 5, 6, 7);
                    o = __builtin_amdgcn_mfma_f32_32x32x16_bf16(vf, pf[kb][s], o, 0, 0, 0);
                }
#pragma unroll
            for (int g = 0; g < 4; ++g) { u32x2 w; w.x = pk2(o[4 * g + 0] * inv, o[4 * g + 1] * inv); w.y = pk2(o[4 * g + 2] * inv, o[4 * g + 3] * inv);
                *(u32x2*)(qrow + 32 * db + 8 * g + 4 * hh) = w; }
        }
        __syncthreads();
    }
}
__device__ __forceinline__ void conv_ln_phase(const Frame& F, const Inputs& I, const bf16_t* U, bf16_t* S) {
    int tid_ = threadIdx.x; asm volatile("" : "+v"(tid_));
    const int tid = tid_, lane = tid & 63, wave = F.wave;
    LAS float* red = (LAS float*)F.lds;
    const int c0 = 2 * tid;
    float w0[31], w1[31];
#pragma unroll
    for (int j = 0; j < 31; ++j) { const f32x2 w = *(const f32x2*)(I.conv_dw + j * D + c0); w0[j] = w[0]; w1[j] = w[1]; }
    const f32x2 bias = *(const f32x2*)(I.conv_dw_b + c0), lg = *(const f32x2*)(I.conv_ln_g + c0), lb = *(const f32x2*)(I.conv_ln_b + c0);
    const int nunits = F.NB * (T / 64);
    for (int u = F.vcu; u < nunits; u += F.G) {
        const int b = u / (T / 64), tc = (u % (T / 64)) * 64;
#pragma unroll 1
        for (int sb = 0; sb < 4; ++sb) {
            const int t0 = tc + 16 * sb;
            unsigned in[46];
#pragma unroll
            for (int s = 0; s < 46; ++s) { const int tt = t0 - 30 + s; in[s] = (tt >= 0) ? *(const unsigned*)(U + ((size_t)(b * T + tt)) * D + c0) : 0u; }
            float a0[16], a1[16];
#pragma unroll
            for (int t = 0; t < 16; ++t) { a0[t] = bias[0]; a1[t] = bias[1]; }
#pragma unroll
            for (int s = 0; s < 46; ++s) {
                const float x0 = bf_lo(in[s]), x1 = bf_hi(in[s]);
#pragma unroll
                for (int t = 0; t < 16; ++t) { const int j = s - t; if (j >= 0 && j <= 30) { a0[t] = fmaf(w0[j], x0, a0[t]); a1[t] = fmaf(w1[j], x1, a1[t]); } }
            }
#pragma unroll
            for (int t = 0; t < 16; ++t) {
                float s1 = a0[t] + a1[t], s2 = a0[t] * a0[t] + a1[t] * a1[t];
                s1 = wave_sum(s1); s2 = wave_sum(s2);
                if (lane == 0) { red[wave * 32 + t] = s1; red[wave * 32 + 16 + t] = s2; }
            }
            __syncthreads();
            if (tid < 32) { float s = 0.f;
#pragma unroll
                for (int w = 0; w < 8; ++w) s += red[w * 32 + tid];
                red[256 + tid] = s; }
            __syncthreads();
#pragma unroll
            for (int t = 0; t < 16; ++t) {
                const float mean = red[256 + t] * (1.0f / D), var = red[256 + 16 + t] * (1.0f / D) - mean * mean, rstd = rsqrtf(var + 1e-5f);
                const float y0 = (a0[t] - mean) * rstd * lg[0] + lb[0], y1 = (a1[t] - mean) * rstd * lg[1] + lb[1];
                *(unsigned*)(S + ((size_t)(b * T + t0 + t)) * D + c0) = pk2(fast_silu(y0), fast_silu(y1));
            }
            __syncthreads();
        }
    }
}
namespace pg8 {
__device__ __forceinline__ f32x2 gelu_pk(f32x2 v) {
    const f32x2 av = __builtin_elementwise_abs(v), d = av * 0.2316418882f + 1.0f;
    f32x2 t; t.x = __builtin_amdgcn_rcpf(d.x); t.y = __builtin_amdgcn_rcpf(d.y);
    f32x2 q = t * 0.5307027145f + (-0.7265760135f); q = q * t + 0.7107068705f; q = q * t + (-0.142248368f); q = q * t + 0.127414796f; q = q * t;
    const f32x2 s = (v * v) * (-0.72134752044f);
    f32x2 e; e.x = __builtin_amdgcn_exp2f(s.x); e.y = __builtin_amdgcn_exp2f(s.y);
    const f32x2 m = v * (q * e), r = v - m;
    f32x2 o; o.x = v.x < 0.f ? m.x : r.x; o.y = v.y < 0.f ? m.y : r.y; return o;
}
struct EpiGeluStats {
    static constexpr bool PERM = true;
    bf16_t* O; int ldc; const i64* ssq; const float* bias; i64* lns; int stat_pn0;
    __device__ __forceinline__ void operator()(const Acc& acc, const Unit& u, int wr, int wc, int fr, int fq) const {
        const int col0 = u.pn * BM + wc * 32 + 8 * fq;
        f32x4 bv[2][2];
#pragma unroll
        for (int bj = 0; bj < 2; ++bj) { bv[bj][0] = *(const f32x4*)(bias + col0 + bj * HALF); bv[bj][1] = *(const f32x4*)(bias + col0 + bj * HALF + 4); }
        const bool stats = u.pn >= stat_pn0;
#pragma unroll
        for (int ai = 0; ai < 2; ++ai)
#pragma unroll
            for (int m = 0; m < 4; ++m) {
                const int row = EPI_ROWS(u, wr, fr, ai, m);
                const float rs = rstd_from_ssq(ssq[row], 1.0f / 1024.0f, 1e-6f);
                bf16_t* rowp = O + (size_t)row * ldc + col0;
                float s1 = 0.f, s2 = 0.f;
#pragma unroll
                for (int bj = 0; bj < 2; ++bj) {
                    const f32x4 v0 = acc[ai][bj][m][0] * rs + bv[bj][0], v1 = acc[ai][bj][m][1] * rs + bv[bj][1];
                    const f32x2 a = gelu_pk((f32x2){v0[0], v0[1]}), b = gelu_pk((f32x2){v0[2], v0[3]}), c = gelu_pk((f32x2){v1[0], v1[1]}), d = gelu_pk((f32x2){v1[2], v1[3]});
                    u32x4 w; w.x = pk2(a.x, a.y); w.y = pk2(b.x, b.y); w.z = pk2(c.x, c.y); w.w = pk2(d.x, d.y);
                    *(u32x4*)(rowp + bj * HALF) = w;
                    s1 += ((a.x + a.y) + (b.x + b.y)) + ((c.x + c.y) + (d.x + d.y));
                    s2 += ((a.x * a.x + a.y * a.y) + (b.x * b.x + b.y * b.y)) + ((c.x * c.x + c.y * c.y) + (d.x * d.x + d.y * d.y));
                }
                if (stats) {
                    s1 += __shfl_xor(s1, 16); s1 += __shfl_xor(s1, 32); s2 += __shfl_xor(s2, 16); s2 += __shfl_xor(s2, 32);
                    if (fq == 0) { atomic_add_i64(lns + 2 * (size_t)row, (i64)(s1 * SSQ_SCALE)); atomic_add_i64(lns + 2 * (size_t)row + 1, (i64)(s2 * SSQ_SCALE + 0.5f)); }
                }
            }
    }
};
}

__device__ __forceinline__ void sgu_spatial_phase(const Frame& F, const Inputs& I, bf16_t* Z) {
    int tid_ = threadIdx.x; asm volatile("" : "+v"(tid_));
    const int tid = tid_, lane = tid & 63, wave = F.wave, wr = wave >> 2, wc = wave & 3, fr = lane & 15, g4 = lane >> 4;
    const bf16_t* wt = (const bf16_t*)(F.ws + F.wm.wstril);
    LAS unsigned char* lds = F.lds;
    const unsigned lds_base = (unsigned)(size_t)lds;
    const int nunits = F.NB * 16 * 8;
    const int ech = tid & 31, rg = tid >> 5, e0 = 8 * ech;
    const unsigned tr_base = lds_base + (unsigned)((8 * g4 + (fr >> 2)) * 528 + (64 * wc + 4 * (fr & 3)) * 2);
    for (int u = F.vcu; u < nunits; u += F.G) {
        const int c = u >> 3, g = u & 7, row0 = c * 128;
        {
            f32x4 lg0 = *(const f32x4*)(I.sgu_ln_g + g * 256 + e0), lg1 = *(const f32x4*)(I.sgu_ln_g + g * 256 + e0 + 4);
            f32x4 lb0 = *(const f32x4*)(I.sgu_ln_b + g * 256 + e0), lb1 = *(const f32x4*)(I.sgu_ln_b + g * 256 + e0 + 4);
#pragma unroll 4
            for (int i = 0; i < 8; ++i) {
                const int s = rg + 16 * i, row = row0 + s;
                const u32x4 v = *(const u32x4*)(Z + (size_t)row * 4096 + 2048 + g * 256 + e0);
                const float mean = (float)F.lns[2 * (size_t)row] * SSQ_INV * (1.0f / 2048.0f);
                const float var = (float)F.lns[2 * (size_t)row + 1] * SSQ_INV * (1.0f / 2048.0f) - mean * mean, rstd = rsqrtf(var + 1e-5f);
                f32x4 y0 = {bf_lo(v.x), bf_hi(v.x), bf_lo(v.y), bf_hi(v.y)}, y1 = {bf_lo(v.z), bf_hi(v.z), bf_lo(v.w), bf_hi(v.w)};
                y0 = (y0 - mean) * rstd * lg0 + lb0; y1 = (y1 - mean) * rstd * lg1 + lb1;
                u32x4 w; w.x = pk2(y0[0], y0[1]); w.y = pk2(y0[2], y0[3]); w.z = pk2(y1[0], y1[1]); w.w = pk2(y1[2], y1[3]);
                *(LAS u32x4*)(lds + s * 528 + e0 * 2) = w;
            }
        }
        __syncthreads();
        f32x4 acc[4][4];
#pragma unroll
        for (int mt = 0; mt < 4; ++mt)
#pragma unroll
            for (int nt = 0; nt < 4; ++nt) acc[mt][nt] = (f32x4){0.f, 0.f, 0.f, 0.f};
#pragma unroll
        for (int ks = 0; ks < 4; ++ks) {
            if (32 * ks <= 64 * wr + 63) {
                bf16x8 af[4];
#pragma unroll
                for (int mt = 0; mt < 4; ++mt) af[mt] = *(const bf16x8*)(wt + (size_t)g * 16384 + (64 * wr + 16 * mt + fr) * 128 + 32 * ks + 8 * g4);
                s16x4 b0[4], b1[4];
                const unsigned ad = tr_base + (unsigned)(32 * ks * 528);
                asm volatile("ds_read_b64_tr_b16 %0, %8\n\tds_read_b64_tr_b16 %1, %8 offset:2112\n\t"
                             "ds_read_b64_tr_b16 %2, %8 offset:32\n\tds_read_b64_tr_b16 %3, %8 offset:2144\n\t"
                             "ds_read_b64_tr_b16 %4, %8 offset:64\n\tds_read_b64_tr_b16 %5, %8 offset:2176\n\t"
                             "ds_read_b64_tr_b16 %6, %8 offset:96\n\tds_read_b64_tr_b16 %7, %8 offset:2208\n\ts_waitcnt lgkmcnt(0)"
                             : "=&v"(b0[0]), "=&v"(b1[0]), "=&v"(b0[1]), "=&v"(b1[1]), "=&v"(b0[2]), "=&v"(b1[2]), "=&v"(b0[3]), "=&v"(b1[3]) : "v"(ad) : "memory");
#pragma unroll
                for (int nt = 0; nt < 4; ++nt) {
                    const bf16x8 bf = __builtin_shufflevector(b0[nt], b1[nt], 0, 1, 2, 3, 4, 5, 6, 7);
#pragma unroll
                    for (int mt = 0; mt < 4; ++mt) acc[mt][nt] = __builtin_amdgcn_mfma_f32_16x16x32_bf16(bf, af[mt], acc[mt][nt], 0, 0, 0);
                }
            }
        }
#pragma unroll
        for (int mt = 0; mt < 4; ++mt) {
            const int t = 64 * wr + 16 * mt + fr; const float bsv = I.sgu_bs[g * 128 + t];
            bf16_t* zr = Z + (size_t)(row0 + t) * 4096 + g * 256 + 64 * wc + 4 * g4;
#pragma unroll
            for (int nt = 0; nt < 4; ++nt) {
                const u32x2 uv = *(const u32x2*)(zr + 16 * nt);
                u32x2 w; w.x = pk2((acc[mt][nt][0] + bsv) * bf_lo(uv.x), (acc[mt][nt][1] + bsv) * bf_hi(uv.x)); w.y = pk2((acc[mt][nt][2] + bsv) * bf_lo(uv.y), (acc[mt][nt][3] + bsv) * bf_hi(uv.y));
                *(u32x2*)(zr + 16 * nt) = w;
            }
        }
        __syncthreads();
    }
}
namespace pg8 {
struct EpiRope {
    static constexpr bool PERM = true;
    bf16_t* O; int ldc; const i64* ssq; const f32x4* rope; int row_off;
    __device__ __forceinline__ void operator()(const Acc& acc, const Unit& u, int wr, int wc, int fr, int fq) const {
        const int col0 = u.pn * BM + wc * 32 + 8 * fq;
#pragma unroll
        for (int ai = 0; ai < 2; ++ai)
#pragma unroll
            for (int m = 0; m < 4; ++m) {
                const int row = EPI_ROWS(u, wr, fr, ai, m), rg = row + row_off, t = rg & (T - 1);
                const float rs = rstd_from_ssq(ssq[rg], 1.0f / 1024.0f, 1e-6f);
                bf16_t* rowp = O + (size_t)row * ldc + col0;
#pragma unroll
                for (int bj = 0; bj < 2; ++bj) {
                    const int p0 = 64 * bj + 16 * wc + 4 * fq;
                    const f32x4 cs01 = rope[(size_t)t * 64 + (p0 >> 1)], cs23 = rope[(size_t)t * 64 + (p0 >> 1) + 1];
                    const f32x4 v0 = acc[ai][bj][m][0] * rs, v1 = acc[ai][bj][m][1] * rs;
                    u32x4 w;
                    w.x = pk2(v0[0] * cs01[0] - v0[1] * cs01[1], v0[1] * cs01[0] + v0[0] * cs01[1]);
                    w.y = pk2(v0[2] * cs01[2] - v0[3] * cs01[3], v0[3] * cs01[2] + v0[2] * cs01[3]);
                    w.z = pk2(v1[0] * cs23[0] - v1[1] * cs23[1], v1[1] * cs23[0] + v1[0] * cs23[1]);
                    w.w = pk2(v1[2] * cs23[2] - v1[3] * cs23[3], v1[3] * cs23[2] + v1[2] * cs23[3]);
                    *(u32x4*)(rowp + bj * HALF) = w;
                }
            }
    }
};
struct EpiBf16ColRstd {
    static constexpr bool PERM = true;
    bf16_t* O; int ldc; const i64* ssq; int col_off;
    __device__ __forceinline__ void operator()(const Acc& acc, const Unit& u, int wr, int wc, int fr, int fq) const {
        const int col0 = u.pn * BM + wc * 32 + 8 * fq;
        float cs[2][8];
#pragma unroll
        for (int bj = 0; bj < 2; ++bj)
#pragma unroll
            for (int j = 0; j < 8; ++j) cs[bj][j] = rstd_from_ssq(ssq[col_off + col0 + bj * HALF + j], 1.0f / 1024.0f, 1e-6f);
#pragma unroll
        for (int ai = 0; ai < 2; ++ai)
#pragma unroll
            for (int m = 0; m < 4; ++m) {
                const int row = EPI_ROWS(u, wr, fr, ai, m);
                bf16_t* rowp = O + (size_t)row * ldc + col0;
#pragma unroll
                for (int bj = 0; bj < 2; ++bj) {
                    const f32x4 v0 = acc[ai][bj][m][0], v1 = acc[ai][bj][m][1];
                    u32x4 w; w.x = pk2(v0[0] * cs[bj][0], v0[1] * cs[bj][1]); w.y = pk2(v0[2] * cs[bj][2], v0[3] * cs[bj][3]); w.z = pk2(v1[0] * cs[bj][4], v1[1] * cs[bj][5]); w.w = pk2(v1[2] * cs[bj][6], v1[3] * cs[bj][7]);
                    *(u32x4*)(rowp + bj * HALF) = w;
                }
            }
    }
};
struct EpiRetGate {
    static constexpr bool PERM = true;
    bf16_t* O; int ldc; const i64* ssq; const i64* oss; int row_off;
    __device__ __forceinline__ void operator()(const Acc& acc, const Unit& u, int wr, int wc, int fr, int fq) const {
        const int col0 = u.pn * BM + wc * 32 + 8 * fq, head = u.pn >> 1;
#pragma unroll
        for (int ai = 0; ai < 2; ++ai)
#pragma unroll
            for (int m = 0; m < 4; ++m) {
                const int row = EPI_ROWS(u, wr, fr, ai, m), rg = row + row_off;
                const float rs = rstd_from_ssq(ssq[rg], 1.0f / 1024.0f, 1e-6f);
                const float ro = rstd_from_ssq(oss[(size_t)rg * 4 + head], 1.0f / 512.0f, 1e-6f);
                bf16_t* rowp = O + (size_t)row * ldc + col0;
#pragma unroll
                for (int bj = 0; bj < 2; ++bj) {
                    const u32x4 ov = *(const u32x4*)(rowp + bj * HALF);
                    const f32x4 g0 = acc[ai][bj][m][0] * rs, g1 = acc[ai][bj][m][1] * rs;
                    u32x4 w;
                    w.x = pk2(fast_silu(g0[0]) * bf_lo(ov.x) * ro, fast_silu(g0[1]) * bf_hi(ov.x) * ro);
                    w.y = pk2(fast_silu(g0[2]) * bf_lo(ov.y) * ro, fast_silu(g0[3]) * bf_hi(ov.y) * ro);
                    w.z = pk2(fast_silu(g1[0]) * bf_lo(ov.z) * ro, fast_silu(g1[1]) * bf_hi(ov.z) * ro);
                    w.w = pk2(fast_silu(g1[2]) * bf_lo(ov.w) * ro, fast_silu(g1[3]) * bf_hi(ov.w) * ro);
                    *(u32x4*)(rowp + bj * HALF) = w;
                }
            }
    }
};
}

__device__ __forceinline__ void ret_chunk_phase(const Frame& F, const bf16_t* QK, const bf16_t* Vt, bf16_t* O, i64* oss, int Mh, int nseq) {
    int tid_ = threadIdx.x; asm volatile("" : "+v"(tid_));
    const int tid = tid_, lane = tid & 63, w = F.wave, fr = lane & 15, g4 = lane >> 4;
    LAS unsigned char* lds = F.lds;
    constexpr int KIMG = 0, VIMG = 128 * 528, RIMG = VIMG + 64 * 272;
    const unsigned lds_base = (unsigned)(size_t)lds;
    const int nunits = nseq * 4 * 8, tl = 16 * w + fr;
    for (int u = F.vcu; u < nunits; u += F.G) {
        const int sl = u & 7, h = (u >> 3) & 3, b = u >> 5;
        const float lg2u = __builtin_amdgcn_logf(1.0f - __builtin_amdgcn_exp2f(-5.0f - (float)h));
        f32x4 R[2][4];
#pragma unroll
        for (int dt = 0; dt < 2; ++dt)
#pragma unroll
            for (int et = 0; et < 4; ++et) R[dt][et] = (f32x4){0.f, 0.f, 0.f, 0.f};
        for (int i = tid; i < 64 * 528 / 16; i += NTHREADS) *(LAS u32x4*)(lds + RIMG + i * 16) = (u32x4){0u, 0u, 0u, 0u};
        const float cdec = __builtin_amdgcn_exp2f(lg2u * 128.0f), qdec = __builtin_amdgcn_exp2f(lg2u * (float)(tl + 1));
        float gi[8];
#pragma unroll
        for (int j = 0; j < 8; ++j) gi[j] = __uint_as_float(__builtin_amdgcn_readfirstlane(__float_as_uint(__builtin_amdgcn_exp2f(-lg2u * (float)j))));
        const float gi16 = __uint_as_float(__builtin_amdgcn_readfirstlane(__float_as_uint(__builtin_amdgcn_exp2f(-lg2u * 16.0f))));
#pragma unroll 1
        for (int n = 0; n < 16; ++n) {
            const int row_base = b * T + n * 128;
            float lg2 = lg2u; asm volatile("" : "+v"(lg2));
#pragma unroll
            for (int i = 0; i < 8; ++i) { const int cid = tid + 512 * i, row = cid >> 5, ch = cid & 31;
                const u32x4 v = *(const u32x4*)(QK + (size_t)(row_base + row) * 2048 + 1024 + h * 256 + ch * 8);
                *(LAS u32x4*)(lds + KIMG + row * 528 + ch * 16) = v; }
#pragma unroll
            for (int i = 0; i < 2; ++i) { const int cid = tid + 512 * i, row = cid >> 4, ch = cid & 15;
                const u32x4 v = *(const u32x4*)(Vt + (size_t)(h * 512 + 64 * sl + row) * Mh + row_base + ch * 8);
                *(LAS u32x4*)(lds + VIMG + row * 272 + ch * 16) = v; }
            bf16x8 qf[8];
#pragma unroll
            for (int kk = 0; kk < 8; ++kk) qf[kk] = *(const bf16x8*)(QK + (size_t)(row_base + tl) * 2048 + h * 256 + 32 * kk + 8 * g4);
            __syncthreads();
            bf16x8 pf[4];
#pragma unroll
            for (int kk2 = 0; kk2 < 4; ++kk2) {
                f32x4 X0 = {0.f, 0.f, 0.f, 0.f}, X1 = {0.f, 0.f, 0.f, 0.f};
                if (2 * kk2 <= w) {
#pragma unroll
                    for (int kk = 0; kk < 8; ++kk) {
                        const bf16x8 k0 = *(const LAS bf16x8*)(lds + KIMG + (32 * kk2 + fr) * 528 + (32 * kk + 8 * g4) * 2);
                        X0 = __builtin_amdgcn_mfma_f32_16x16x32_bf16(k0, qf[kk], X0, 0, 0, 0);
                    }
                    if (2 * kk2 + 1 <= w) {
#pragma unroll
                        for (int kk = 0; kk < 8; ++kk) {
                            const bf16x8 k1 = *(const LAS bf16x8*)(lds + KIMG + (32 * kk2 + 16 + fr) * 528 + (32 * kk + 8 * g4) * 2);
                            X1 = __builtin_amdgcn_mfma_f32_16x16x32_bf16(k1, qf[kk], X1, 0, 0, 0);
                        }
                    }
                    const float e0 = __builtin_amdgcn_exp2f(lg2 * (float)(tl - 4 * g4 - 32 * kk2)), e1 = e0 * gi16;
#pragma unroll
                    for (int i = 0; i < 4; ++i) {
                        const int s0 = 32 * kk2 + 4 * g4 + i, s1 = s0 + 16;
                        X0[i] = (tl >= s0) ? X0[i] * (e0 * gi[i]) : 0.f;
                        X1[i] = (tl >= s1) ? X1[i] * (e1 * gi[i]) : 0.f;
                    }
                }
                u32x4 pw; pw.x = pk2(X0[0], X0[1]); pw.y = pk2(X0[2], X0[3]); pw.z = pk2(X1[0], X1[1]); pw.w = pk2(X1[2], X1[3]);
                pf[kk2] = __builtin_bit_cast(bf16x8, pw);
                __builtin_amdgcn_sched_barrier(0);
            }
            f32x4 oa[4];
#pragma unroll
            for (int et = 0; et < 4; ++et) {
                oa[et] = (f32x4){0.f, 0.f, 0.f, 0.f};
#pragma unroll
                for (int kk = 0; kk < 8; ++kk) {
                    const bf16x8 rf = *(const LAS bf16x8*)(lds + RIMG + (16 * et + fr) * 528 + (32 * kk + 8 * g4) * 2);
                    oa[et] = __builtin_amdgcn_mfma_f32_16x16x32_bf16(rf, qf[kk], oa[et], 0, 0, 0);
                }
                oa[et] *= qdec;
                __builtin_amdgcn_sched_barrier(0);
            }
#pragma unroll
            for (int kk2 = 0; kk2 < 4; ++kk2) {
                if (2 * kk2 <= w) {
#pragma unroll
                    for (int et = 0; et < 4; ++et) {
                        const LAS unsigned char* vp = lds + VIMG + (16 * et + fr) * 272 + (32 * kk2 + 4 * g4) * 2;
                        const s16x4 lo = *(const LAS s16x4*)(vp), hi = *(const LAS s16x4*)(vp + 32);
                        const bf16x8 vf = __builtin_shufflevector(lo, hi, 0, 1, 2, 3, 4, 5, 6, 7);
                        oa[et] = __builtin_amdgcn_mfma_f32_16x16x32_bf16(vf, pf[kk2], oa[et], 0, 0, 0);
                    }
                }
                __builtin_amdgcn_sched_barrier(0);
            }
            {
                float ss = 0.f;
                bf16_t* op = O + (size_t)(row_base + tl) * 2048 + h * 512 + 64 * sl + 4 * g4;
#pragma unroll
                for (int et = 0; et < 4; ++et) {
                    u32x2 wv; wv.x = pk2(oa[et][0], oa[et][1]); wv.y = pk2(oa[et][2], oa[et][3]);
                    *(u32x2*)(op + 16 * et) = wv;
                    ss += (oa[et][0] * oa[et][0] + oa[et][1] * oa[et][1]) + (oa[et][2] * oa[et][2] + oa[et][3] * oa[et][3]);
                }
                ss += __shfl_xor(ss, 16); ss += __shfl_xor(ss, 32);
                if (g4 == 0) atomic_add_i64(oss + (size_t)(row_base + tl) * 4 + h, (i64)(ss * SSQ_SCALE + 0.5f));
            }
            __builtin_amdgcn_sched_barrier(0);
            bf16x8 kt[2][4];
            {
                s16x4 r0[2][4], r1[2][4];
                const unsigned ad = lds_base + KIMG + (unsigned)((8 * g4 + (fr >> 2)) * 528 + (32 * w + 4 * (fr & 3)) * 2);
                asm volatile(
                    "ds_read_b64_tr_b16 %0, %16 offset:0\n\tds_read_b64_tr_b16 %1, %16 offset:2112\n\t"
                    "ds_read_b64_tr_b16 %2, %16 offset:16896\n\tds_read_b64_tr_b16 %3, %16 offset:19008\n\t"
                    "ds_read_b64_tr_b16 %4, %16 offset:33792\n\tds_read_b64_tr_b16 %5, %16 offset:35904\n\t"
                    "ds_read_b64_tr_b16 %6, %16 offset:50688\n\tds_read_b64_tr_b16 %7, %16 offset:52800\n\t"
                    "ds_read_b64_tr_b16 %8, %16 offset:32\n\tds_read_b64_tr_b16 %9, %16 offset:2144\n\t"
                    "ds_read_b64_tr_b16 %10, %16 offset:16928\n\tds_read_b64_tr_b16 %11, %16 offset:19040\n\t"
                    "ds_read_b64_tr_b16 %12, %16 offset:33824\n\tds_read_b64_tr_b16 %13, %16 offset:35936\n\t"
                    "ds_read_b64_tr_b16 %14, %16 offset:50720\n\tds_read_b64_tr_b16 %15, %16 offset:52832\n\ts_waitcnt lgkmcnt(0)"
                    : "=&v"(r0[0][0]), "=&v"(r1[0][0]), "=&v"(r0[0][1]), "=&v"(r1[0][1]), "=&v"(r0[0][2]), "=&v"(r1[0][2]), "=&v"(r0[0][3]), "=&v"(r1[0][3]),
                      "=&v"(r0[1][0]), "=&v"(r1[1][0]), "=&v"(r0[1][1]), "=&v"(r1[1][1]), "=&v"(r0[1][2]), "=&v"(r1[1][2]), "=&v"(r0[1][3]), "=&v"(r1[1][3])
                    : "v"(ad) : "memory");
#pragma unroll
                for (int kk2 = 0; kk2 < 4; ++kk2) {
                    float f[8];
                    const float fb = __builtin_amdgcn_exp2f(lg2 * (float)(127 - 32 * kk2 - 8 * g4));
#pragma unroll
                    for (int j = 0; j < 8; ++j) f[j] = fb * gi[j];
#pragma unroll
                    for (int dt = 0; dt < 2; ++dt) {
                        const u32x2 a = __builtin_bit_cast(u32x2, r0[dt][kk2]), c = __builtin_bit_cast(u32x2, r1[dt][kk2]);
                        u32x4 o; o.x = pk2(bf_lo(a.x) * f[0], bf_hi(a.x) * f[1]); o.y = pk2(bf_lo(a.y) * f[2], bf_hi(a.y) * f[3]);
                        o.z = pk2(bf_lo(c.x) * f[4], bf_hi(c.x) * f[5]); o.w = pk2(bf_lo(c.y) * f[6], bf_hi(c.y) * f[7]);
                        kt[dt][kk2] = __builtin_bit_cast(bf16x8, o);
                    }
                }
            }
#pragma unroll
            for (int dt = 0; dt < 2; ++dt)
#pragma unroll
                for (int et = 0; et < 4; ++et) R[dt][et] *= cdec;
#pragma unroll
            for (int kk2 = 0; kk2 < 4; ++kk2)
#pragma unroll
                for (int et = 0; et < 4; ++et) {
                    const bf16x8 vf = *(const LAS bf16x8*)(lds + VIMG + (16 * et + fr) * 272 + (32 * kk2 + 8 * g4) * 2);
#pragma unroll
                    for (int dt = 0; dt < 2; ++dt) R[dt][et] = __builtin_amdgcn_mfma_f32_16x16x32_bf16(kt[dt][kk2], vf, R[dt][et], 0, 0, 0);
                    __builtin_amdgcn_sched_barrier(0);
                }
            __syncthreads();
#pragma unroll
            for (int dt = 0; dt < 2; ++dt)
#pragma unroll
                for (int et = 0; et < 4; ++et) { u32x2 wv; wv.x = pk2(R[dt][et][0], R[dt][et][1]); wv.y = pk2(R[dt][et][2], R[dt][et][3]);
                    *(LAS u32x2*)(lds + RIMG + (16 * et + fr) * 528 + (32 * w + 16 * dt + 4 * g4) * 2) = wv; }
        }
        __syncthreads();
    }
}
namespace pg8 {
struct EpiLora1 {
    static constexpr bool PERM = true;
    bf16_t* O; int ldc;
    __device__ __forceinline__ void operator()(const Acc& acc, const Unit& u, int wr, int wc, int fr, int fq) const {
        const int col0 = u.pn * BM + wc * 32 + 8 * fq;
#pragma unroll
        for (int ai = 0; ai < 2; ++ai)
#pragma unroll
            for (int m = 0; m < 4; ++m) {
                const int row = EPI_ROWS(u, wr, fr, ai, m);
                bf16_t* rowp = O + (size_t)row * ldc + col0;
#pragma unroll
                for (int bj = 0; bj < 2; ++bj) {
                    const int grp = (u.pn * BM + bj * HALF + wc * 32) >> 5;
                    float v[8];
#pragma unroll
                    for (int j = 0; j < 4; ++j) { v[j] = acc[ai][bj][m][0][j]; v[4 + j] = acc[ai][bj][m][1][j]; }
                    if (grp < 2) {
#pragma unroll
                        for (int j = 0; j < 8; ++j) { const float x = fminf(fmaxf(v[j], -10.f), 10.f), e = __builtin_amdgcn_exp2f(2.8853900817779268f * x); v[j] = (e - 1.0f) * __builtin_amdgcn_rcpf(e + 1.0f); }
                    } else if (grp >= 4 && grp < 9) {
#pragma unroll
                        for (int j = 0; j < 8; ++j) v[j] = fast_sigmoid(v[j]);
                    }
                    u32x4 w; w.x = pk2(v[0], v[1]); w.y = pk2(v[2], v[3]); w.z = pk2(v[4], v[5]); w.w = pk2(v[6], v[7]);
                    *(u32x4*)(rowp + bj * HALF) = w;
                }
            }
    }
};
}

__device__ __forceinline__ void rwkv_mix_phase(const Frame& F, const Inputs& I, const float* X, const i64* ssq, int rb, int Mh, bf16_t* hn_pad, bf16_t* xs  ) {
    const int lane = opaque_tid() & 63;
    f32x4 g[4], mr[4], mk[4], mv[4];
#pragma unroll
    for (int j = 0; j < 4; ++j) { g[j] = ((const f32x4*)I.mix_norm_g)[256 + lane + 64 * j]; mr[j] = ((const f32x4*)I.rwkv_mix)[lane + 64 * j]; mk[j] = ((const f32x4*)I.rwkv_mix)[512 + lane + 64 * j]; mv[j] = ((const f32x4*)I.rwkv_mix)[768 + lane + 64 * j]; }
    for (int r = F.gw; r < Mh; r += F.NGW) {
        const int rg = rb + r, t = r & (T - 1);
        const float rs = rstd_from_ssq(ssq[rg], 1.0f / D, 1e-6f), rp = t ? rstd_from_ssq(ssq[rg - 1], 1.0f / D, 1e-6f) : 0.f;
        const f32x4* xr = (const f32x4*)(X + (size_t)rg * D) + lane; const f32x4* xp = (const f32x4*)(X + (size_t)(t ? rg - 1 : rg) * D) + lane;
        const size_t prow = (size_t)r + (r >> 11) + 1;
        u32x2* hp = (u32x2*)(hn_pad + prow * D) + lane;
        u32x2* o0 = (u32x2*)(xs + (size_t)r * D) + lane; u32x2* o1 = (u32x2*)(xs + ((size_t)Mh + r) * D) + lane; u32x2* o2 = (u32x2*)(xs + (2 * (size_t)Mh + r) * D) + lane;
#pragma unroll
        for (int j = 0; j < 4; ++j) {
            const f32x4 h = xr[64 * j] * rs * g[j], p = xp[64 * j] * rp * g[j], d = p - h;
            u32x2 w; w.x = pk2(h[0], h[1]); w.y = pk2(h[2], h[3]); hp[64 * j] = w;
            const f32x4 a = h + d * mr[j], b = h + d * mk[j], c = h + d * mv[j];
            w.x = pk2(a[0], a[1]); w.y = pk2(a[2], a[3]); o0[64 * j] = w;
            w.x = pk2(b[0], b[1]); w.y = pk2(b[2], b[3]); o1[64 * j] = w;
            w.x = pk2(c[0], c[1]); w.y = pk2(c[2], c[3]); o2[64 * j] = w;
            if (t == 0) (hp - 256)[64 * j] = (u32x2){0u, 0u};
        }
    }
}

__device__ __forceinline__ float dpp_sum16(float v) {
    v += __int_as_float(__builtin_amdgcn_update_dpp(0, __float_as_int(v), 0xB1, 0xF, 0xF, true));
    v += __int_as_float(__builtin_amdgcn_update_dpp(0, __float_as_int(v), 0x4E, 0xF, 0xF, true));
    v += __int_as_float(__builtin_amdgcn_update_dpp(0, __float_as_int(v), 0x141, 0xF, 0xF, true));
    v += __int_as_float(__builtin_amdgcn_update_dpp(0, __float_as_int(v), 0x140, 0xF, 0xF, true));
    return v;
}
__device__ __forceinline__ void rwkv_scan_phase(const Frame& F, const Inputs& I, const bf16_t* rr, const bf16_t* kk_, const bf16_t* vv, const bf16_t* wraw, const bf16_t* araw, bf16_t* y, int nseq) {
    const int tid = opaque_tid(), lane = tid & 63, w = F.wave, r4 = lane >> 4, cg = lane & 15;
    LAS unsigned char* lds = F.lds;
    constexpr int TS = 32, VEC = TS * 64 * 4, BUF = 5 * VEC + TS * 32 * 4 + TS * 32 * 4;
    const int nitems = nseq * 32;
    const int pt = tid >> 4, pj = 4 * (tid & 15);
    for (int it = F.vcu; it < nitems; it += F.G) {
        const int rh = it & 1, h = (it >> 1) & 15, b = it >> 5;
        const int ch = h * 64;
        const f32x4 w0 = *(const f32x4*)(I.rwkv_w0 + ch + pj), a0 = *(const f32x4*)(I.rwkv_a0 + ch + pj), kkc = *(const f32x4*)(I.rwkv_k_k + ch + pj), kac = *(const f32x4*)(I.rwkv_k_a + ch + pj);
        f32x4 S = {0.f, 0.f, 0.f, 0.f};
        u32x2 nr, nk, nw, na; unsigned nv = 0u;
        {   const size_t o = (size_t)(b * T + pt) * D + ch + pj;
            nr = *(const u32x2*)(rr + o); nk = *(const u32x2*)(kk_ + o); nw = *(const u32x2*)(wraw + o); na = *(const u32x2*)(araw + o);
            nv = *(const unsigned*)(vv + (size_t)(b * T + pt) * D + ch + 32 * rh + 2 * (tid & 15)); }
#pragma unroll 1
        for (int blk = 0; blk < T / TS; ++blk) {
            LAS unsigned char* bufp = lds + (blk & 1) * BUF;
            {
                const f32x4 kr = {bf_lo(nk.x), bf_hi(nk.x), bf_lo(nk.y), bf_hi(nk.y)}, rv = {bf_lo(nr.x), bf_hi(nr.x), bf_lo(nr.y), bf_hi(nr.y)};
                const f32x4 wr_ = {bf_lo(nw.x), bf_hi(nw.x), bf_lo(nw.y), bf_hi(nw.y)}, ar = {bf_lo(na.x), bf_hi(na.x), bf_lo(na.y), bf_hi(na.y)};
                f32x4 dec, av, kkv, km;
                const f32x4 kq = kr * kkc;
                float n2 = (kq[0] * kq[0] + kq[1] * kq[1]) + (kq[2] * kq[2] + kq[3] * kq[3]);
                n2 = dpp_sum16(n2);
                const float inv = 1.0f / fmaxf(sqrtf(n2), 1e-12f);
#pragma unroll
                for (int c = 0; c < 4; ++c) {
                    const float xw = -(w0[c] + wr_[c]);
                    const float sp = xw > 20.f ? xw : 0.6931471805599453f * __builtin_amdgcn_logf(1.0f + __builtin_amdgcn_exp2f(1.4426950408889634f * xw));
                    const float ww = -sp - 0.5f;
                    dec[c] = __builtin_amdgcn_exp2f(-1.4426950408889634f * __builtin_amdgcn_exp2f(1.4426950408889634f * ww));
                    av[c] = fast_sigmoid(a0[c] + ar[c]);
                    kkv[c] = kq[c] * inv;
                    km[c] = kr[c] * (1.0f + (av[c] - 1.0f) * kac[c]);
                }
                *(LAS f32x4*)(bufp + 0 * VEC + (pt * 64 + pj) * 4) = -kkv;
                *(LAS f32x4*)(bufp + 1 * VEC + (pt * 64 + pj) * 4) = dec;
                *(LAS f32x4*)(bufp + 2 * VEC + (pt * 64 + pj) * 4) = kkv * av;
                *(LAS f32x4*)(bufp + 3 * VEC + (pt * 64 + pj) * 4) = km;
                *(LAS f32x4*)(bufp + 4 * VEC + (pt * 64 + pj) * 4) = rv;
                *(LAS f32x2*)(bufp + 5 * VEC + (pt * 32 + 2 * (tid & 15)) * 4) = (f32x2){bf_lo(nv), bf_hi(nv)};
            }
            __syncthreads();
            if (blk > 0) {
                const LAS unsigned char* pb = lds + ((blk - 1) & 1) * BUF + 5 * VEC + TS * 32 * 4;
                const f32x2 yv = *(const LAS f32x2*)(pb + (pt * 32 + 2 * (tid & 15)) * 4);
                *(unsigned*)(y + (size_t)(b * T + (blk - 1) * TS + pt) * D + ch + 32 * rh + 2 * (tid & 15)) = pk2(yv[0], yv[1]);
            }
            if (blk + 1 < T / TS) {
                const size_t o = (size_t)(b * T + (blk + 1) * TS + pt) * D + ch + pj;
                nr = *(const u32x2*)(rr + o); nk = *(const u32x2*)(kk_ + o); nw = *(const u32x2*)(wraw + o); na = *(const u32x2*)(araw + o);
                nv = *(const unsigned*)(vv + (size_t)(b * T + (blk + 1) * TS + pt) * D + ch + 32 * rh + 2 * (tid & 15));
            }
            const LAS unsigned char* va = bufp + 16 * cg;
            LAS float* yb = (LAS float*)(bufp + 5 * VEC + TS * 32 * 4);
#pragma unroll 4
            for (int s = 0; s < TS; ++s) {
                const f32x4 ah = *(const LAS f32x4*)(va + 0 * VEC + s * 256), wd = *(const LAS f32x4*)(va + 1 * VEC + s * 256), bb = *(const LAS f32x4*)(va + 2 * VEC + s * 256);
                const f32x4 kv = *(const LAS f32x4*)(va + 3 * VEC + s * 256), rv = *(const LAS f32x4*)(va + 4 * VEC + s * 256);
                const float vi = *(const LAS float*)(bufp + 5 * VEC + (s * 32 + 4 * w + r4) * 4);
                float sa = (S[0] * ah[0] + S[1] * ah[1]) + (S[2] * ah[2] + S[3] * ah[3]);
                sa = dpp_sum16(sa);
                S = S * wd + sa * bb + vi * kv;
                float yv = (S[0] * rv[0] + S[1] * rv[1]) + (S[2] * rv[2] + S[3] * rv[3]);
                yv = dpp_sum16(yv);
                if (cg == 0) yb[s * 32 + 4 * w + r4] = yv;
            }
        }
        __syncthreads();
        {
            const LAS unsigned char* pb = lds + ((T / TS - 1) & 1) * BUF + 5 * VEC + TS * 32 * 4;
            const f32x2 yv = *(const LAS f32x2*)(pb + (pt * 32 + 2 * (tid & 15)) * 4);
            *(unsigned*)(y + (size_t)(b * T + (T / TS - 1) * TS + pt) * D + ch + 32 * rh + 2 * (tid & 15)) = pk2(yv[0], yv[1]);
        }
        __syncthreads();
    }
}
__device__ __forceinline__ void rwkv_post_phase(const Frame& F, const Inputs& I, const bf16_t* y, const bf16_t* rr, const bf16_t* kk_, const bf16_t* vv, const bf16_t* araw, const bf16_t* gg, bf16_t* out, int Mh) {
    const int lane = opaque_tid() & 63;
    const int ntask = Mh * 4;
    for (int task = F.gw; task < ntask; task += F.NGW) {
        const int row = task >> 2, c0 = (task & 3) * 256 + 4 * lane; const size_t o = (size_t)row * D + c0;
        const u32x2 yu = *(const u32x2*)(y + o), ru = *(const u32x2*)(rr + o), ku = *(const u32x2*)(kk_ + o), vu = *(const u32x2*)(vv + o), au = *(const u32x2*)(araw + o), gu = *(const u32x2*)(gg + o);
        const f32x4 yv = {bf_lo(yu.x), bf_hi(yu.x), bf_lo(yu.y), bf_hi(yu.y)}, rv = {bf_lo(ru.x), bf_hi(ru.x), bf_lo(ru.y), bf_hi(ru.y)}, kv = {bf_lo(ku.x), bf_hi(ku.x), bf_lo(ku.y), bf_hi(ku.y)};
        const f32x4 vv4 = {bf_lo(vu.x), bf_hi(vu.x), bf_lo(vu.y), bf_hi(vu.y)}, av = {bf_lo(au.x), bf_hi(au.x), bf_lo(au.y), bf_hi(au.y)}, gv = {bf_lo(gu.x), bf_hi(gu.x), bf_lo(gu.y), bf_hi(gu.y)};
        const f32x4 a0 = *(const f32x4*)(I.rwkv_a0 + c0), kac = *(const f32x4*)(I.rwkv_k_a + c0), rk = *(const f32x4*)(I.rwkv_r_k + c0), gg4 = *(const f32x4*)(I.rwkv_gn_g + c0), gb4 = *(const f32x4*)(I.rwkv_gn_b + c0);
        const float mean = dpp_sum16((yv[0] + yv[1]) + (yv[2] + yv[3])) * (1.0f / 64.0f);
        const f32x4 d = yv - mean;
        const float var = dpp_sum16((d[0] * d[0] + d[1] * d[1]) + (d[2] * d[2] + d[3] * d[3])) * (1.0f / 64.0f), rstd = rsqrtf(var + 64e-5f);
        f32x4 km;
#pragma unroll
        for (int c = 0; c < 4; ++c) km[c] = kv[c] * (1.0f + (fast_sigmoid(a0[c] + av[c]) - 1.0f) * kac[c]);
        const f32x4 pr = rv * km * rk;
        const float bonus = dpp_sum16((pr[0] + pr[1]) + (pr[2] + pr[3]));
        const f32x4 res = (d * rstd * gg4 + gb4 + bonus * vv4) * gv;
        u32x2 wv; wv.x = pk2(res[0], res[1]); wv.y = pk2(res[2], res[3]);
        *(u32x2*)(out + o) = wv;
    }
}
#define MIXER_CONV \
        if (L == 0) { \
            bf16_t* const Ub = (bf16_t*)act; bf16_t* const Sb = (bf16_t*)act + (size_t)M * D; \
            if (IN(base + 0)) {        \
                zero_i64(F, ssq_m_out, M); \
                pg8::Gemm g = pg8::make_gemm(F.Xb, D, (const bf16_t*)(wb + WB_CONV_IN), D, M, 2 * D, D); \
                pg8::StaticOrder S; S.init(g.M, g.N, F.G, (int)blockIdx.x); \
                pg8::EpiGated<1> E{Ub, D, ssq_m_in, I.conv_b_in, I.conv_b_in + D}; \
                pg8::gemm_phase(F.lds, g, S, E); \
                SEAM(base + 0); \
            } \
            if (IN(base + 1)) { conv_ln_phase(F, I, Ub, Sb); SEAM(base + 1); } \
            if (IN(base + 2)) {        \
                pg8::Gemm g = pg8::make_gemm(Sb, D, (const bf16_t*)(wb + WB_CONV_OUT), D, M, D, D); \
                pg8::StaticOrder S; S.init(g.M, g.N, F.G, (int)blockIdx.x); \
                pg8::EpiResid E{F.X, F.Xb, ssq_m_out, I.conv_b_out, 0}; \
                pg8::gemm_phase(F.lds, g, S, E); \
                SEAM(base + 2); \
            } \
        }
#define MIXER_SGU \
        if (L == 2) { \
            bf16_t* const Zb = (bf16_t*)act; \
            if (IN(base + 0)) {        \
                zero_i64(F, ssq_m_out, M); \
                pg8::Gemm g = pg8::make_gemm(F.Xb, D, (const bf16_t*)(wb + WB_SGU_IN), D, M, 4096, D); \
                pg8::StaticOrder S; S.init(g.M, g.N, F.G, (int)blockIdx.x); \
                pg8::EpiGeluStats E{Zb, 4096, ssq_m_in, I.sgu_b_in, F.lns, 8}; \
                pg8::gemm_phase(F.lds, g, S, E); \
                SEAM(base + 0); \
            } \
            if (IN(base + 1)) { sgu_spatial_phase(F, I, Zb); SEAM(base + 1); } \
            if (IN(base + 2)) {        \
                pg8::Gemm g = pg8::make_gemm(Zb, 4096, (const bf16_t*)(wb + WB_SGU_OUT), 2048, M, D, 2048); \
                pg8::StaticOrder S; S.init(g.M, g.N, F.G, (int)blockIdx.x); \
                pg8::EpiResid E{F.X, F.Xb, ssq_m_out, nullptr, 0}; \
                pg8::gemm_phase(F.lds, g, S, E); \
                SEAM(base + 2); \
            } \
        }
#define MIXER_RET \
        if (L == 3) { \
            const int Mh = M / 2; \
            bf16_t* const QKb = (bf16_t*)act; bf16_t* const Vtb = QKb + (size_t)Mh * 2048; bf16_t* const Ob = Vtb + (size_t)Mh * 2048; \
            for (int hf = 0; hf < 2; ++hf) { \
                const int rb = hf * Mh, pb = base + 4 * hf; \
                if (IN(pb + 0)) {        \
                    if (hf == 0) zero_i64(F, ssq_m_out, M); \
                    { pg8::Gemm g = pg8::make_gemm(F.Xb + (size_t)rb * D, D, (const bf16_t*)(wb + WB_RET_QKV), D, Mh, 2048, D); \
                      pg8::StaticOrder S; S.init(g.M, g.N, F.G, (int)blockIdx.x); \
                      pg8::EpiRope E{QKb, 2048, ssq_m_in, (const f32x4*)(a.ws + F.wm.rope), rb}; \
                      pg8::gemm_phase(F.lds, g, S, E); } \
                    { pg8::Gemm g = pg8::make_gemm((const bf16_t*)(wb + WB_RET_QKV) + (size_t)2048 * D, D, F.Xb + (size_t)rb * D, D, 2048, Mh, D); \
                      pg8::StaticOrder S; S.init(g.M, g.N, F.G, (int)blockIdx.x); \
                      pg8::EpiBf16ColRstd E{Vtb, Mh, ssq_m_in, rb}; \
                      pg8::gemm_phase(F.lds, g, S, E); } \
                    SEAM(pb + 0); \
                } \
                if (IN(pb + 1)) { ret_chunk_phase(F, QKb, Vtb, Ob, F.oss + (size_t)rb * 4, Mh, F.NB / 2); SEAM(pb + 1); } \
                if (IN(pb + 2)) {        \
                    pg8::Gemm g = pg8::make_gemm(F.Xb + (size_t)rb * D, D, (const bf16_t*)(wb + WB_RET_G), D, Mh, 2048, D); \
                    pg8::StaticOrder S; S.init(g.M, g.N, F.G, (int)blockIdx.x); \
                    pg8::EpiRetGate E{Ob, 2048, ssq_m_in, F.oss, rb}; \
                    pg8::gemm_phase(F.lds, g, S, E); \
                    SEAM(pb + 2); \
                } \
                if (IN(pb + 3)) {        \
                    pg8::Gemm g = pg8::make_gemm(Ob, 2048, (const bf16_t*)(wb + WB_RET_OUT), 2048, Mh, D, 2048); \
                    pg8::StaticOrder S; S.init(g.M, g.N, F.G, (int)blockIdx.x); \
                    pg8::EpiResid E{F.X, F.Xb, ssq_m_out, nullptr, rb}; \
                    pg8::gemm_phase(F.lds, g, S, E); \
                    SEAM(pb + 3); \
                } \
            } \
        }
#define MIXER_RWKV \
        if (L == 1) { \
            const int Mh = M / 2; const size_t MD = (size_t)Mh * D; \
            bf16_t* const hnp = (bf16_t*)act; bf16_t* const xsb = hnp + MD + (size_t)64 * D; bf16_t* const rkv = xsb + 3 * MD; bf16_t* const l1b = rkv + 3 * MD; \
            bf16_t* const wagb = xsb; bf16_t* const yb = hnp; bf16_t* const Ob = xsb; \
            for (int hf = 0; hf < 2; ++hf) { \
                const int rb = hf * Mh, pb = base + 6 * hf; \
                if (IN(pb + 0)) { if (hf == 0) zero_i64(F, ssq_m_out, M); rwkv_mix_phase(F, I, F.X, ssq_m_in, rb, Mh, hnp, xsb); SEAM(pb + 0); } \
                if (IN(pb + 1)) {        \
                    { pg8::Gemm g = pg8::make_gemm(hnp, D, (const bf16_t*)(wb + WB_RW_L1), 2 * D, Mh, 512, 2 * D); g.seq_pad = 1; g.ksplit = 16; g.ajump = -(D * 2 + 16 * 128); \
                      pg8::StaticOrder S; S.init(g.M, g.N, F.G, (int)blockIdx.x); \
                      pg8::EpiLora1 E{l1b, 512}; \
                      pg8::gemm_phase(F.lds, g, S, E); } \
                    for (int i = 0; i < 3; ++i) { \
                      pg8::Gemm g = pg8::make_gemm(xsb + i * MD, D, (const bf16_t*)(wb + WB_RW_RKV) + (size_t)i * D * D, D, Mh, D, D); \
                      pg8::StaticOrder S; S.init(g.M, g.N, F.G, (int)blockIdx.x); \
                      pg8::EpiBf16 E{rkv + i * MD, D, nullptr, nullptr, nullptr, 0}; \
                      pg8::gemm_phase(F.lds, g, S, E); } \
                    SEAM(pb + 1); \
                } \
                if (IN(pb + 2)) {        \
                    for (int i = 0; i < 3; ++i) { \
                      pg8::Gemm g = pg8::make_gemm(l1b + (i == 2 ? 128 : 0), 512, (const bf16_t*)(wb + WB_RW_W2) + (size_t)i * D * 256, 256, Mh, D, 256); \
                      pg8::StaticOrder S; S.init(g.M, g.N, F.G, (int)blockIdx.x); \
                      pg8::EpiBf16 E{wagb + i * MD, D, nullptr, nullptr, nullptr, 0}; \
                      pg8::gemm_phase(F.lds, g, S, E); } \
                    SEAM(pb + 2); \
                } \
                if (IN(pb + 3)) { rwkv_scan_phase(F, I, rkv, rkv + MD, rkv + 2 * MD, wagb, wagb + MD, yb, F.NB / 2); SEAM(pb + 3); } \
                if (IN(pb + 4)) { rwkv_post_phase(F, I, yb, rkv, rkv + MD, rkv + 2 * MD, wagb + MD, wagb + 2 * MD, Ob, Mh); SEAM(pb + 4); } \
                if (IN(pb + 5)) {        \
                    pg8::Gemm g = pg8::make_gemm(Ob, D, (const bf16_t*)(wb + WB_RW_WO), D, Mh, D, D); \
                    pg8::StaticOrder S; S.init(g.M, g.N, F.G, (int)blockIdx.x); \
                    pg8::EpiResid E{F.X, F.Xb, ssq_m_out, nullptr, rb}; \
                    pg8::gemm_phase(F.lds, g, S, E); \
                    SEAM(pb + 5); \
                } \
            } \
        }
#define MIXER_PHASES MIXER_CONV MIXER_RWKV MIXER_SGU MIXER_RET
constexpr int PH_LAYER0 = 2, PH_PER_LAYER = 17, PH_XATTN = 12, PH_FFN = 15, PH_FINAL = PH_LAYER0 + 4 * PH_PER_LAYER, PH_END = PH_FINAL + 1;

__global__ void __launch_bounds__(NTHREADS, 2) mega(Args a) {
    extern __shared__ __attribute__((aligned(16))) unsigned char lds_raw[];
    Frame F;
    F.lds = (LAS unsigned char*)lds_raw;
    F.wave = __builtin_amdgcn_readfirstlane((int)threadIdx.x >> 6);
    F.G = gridDim.x; { const int bx = blockIdx.x; F.vcu = (F.G % 8 == 0) ? (bx % 8) * (F.G / 8) + bx / 8 : bx; }
    F.gw = F.vcu * NWAVES + F.wave; F.NGW = F.G * NWAVES;
    F.NB = a.NB; F.M = a.NB * T; F.ws = a.ws; F.wm = make_wsmap(a.NB);
    F.X = a.out; F.Xb = (bf16_t*)(a.ws + F.wm.xb); F.ssq = (i64*)(a.ws + F.wm.ssq); F.lns = (i64*)(a.ws + F.wm.lns); F.oss = (i64*)(a.ws + F.wm.oss);
    const Inputs& I = a.in;
    const int M = F.M;
    volatile LAS unsigned* lctl = (volatile LAS unsigned*)(F.lds + LDSCTL_OFF);
    if (threadIdx.x < 64) lctl[threadIdx.x] = 0u;
    __syncthreads();
    XcdBarrier bar; bar.bar = (unsigned*)(a.ws + F.wm.ctl) + 4096; bar.x = 0; bar.st = lctl;
    if (a.use_bar) bar = xcd_barrier_post((unsigned*)(a.ws + F.wm.ctl) + 4096, lctl);
    const int lo = a.ph_lo, hi = a.ph_hi;
#define IN(k) (lo <= (k) && (k) < hi)
#define SEAM(k) do { if (a.use_bar && (k) + 1 < hi) xcd_barrier(bar); else __syncthreads(); } while (0)
    unsigned char* const wbuf0 = a.ws + F.wm.wb0; unsigned char* const wbuf1 = a.ws + F.wm.wb1;
#define WBUF(i) (((i) & 1) ? wbuf1 : wbuf0)
    unsigned char* const act = a.ws + F.wm.act;

    if (a.conv_layer_p1) convert_layer_weights(F, I, a.conv_layer_p1 - 1, WBUF(a.conv_layer_p1 - 1));
    if (a.load_src) { load_rows(F, a.load_src, F.X, F.Xb, F.ssq + (size_t)a.load_slot * M, M); zero_i64(F, F.ssq + (size_t)(a.load_slot ^ 1) * M, M); }

    if (IN(0)) {
        load_rows(F, I.x, F.X, F.Xb, F.ssq, M);
        load_mem_rows(F, I.mem, (bf16_t*)(a.ws + F.wm.mem_b), (float*)(a.ws + F.wm.rstd_mem), F.NB * NMEM);
        make_tables(F, I);
        for (int L = 0; L < 4; ++L) {
            { WConv w = wconv(I.xattn_wkv + (size_t)L * D * 2 * D, 2 * D, D, (bf16_t*)(a.ws + F.wm.wk_all) + (size_t)L * D * D, D, D); w.kvec = I.mem_norm_g + L * D; w.sa = 0.f; w.sb = 1.f; convert_w(F, w); }
            { WConv w = wconv(I.xattn_wkv + (size_t)L * D * 2 * D, 2 * D, D, (bf16_t*)(a.ws + F.wm.wv_all) + (size_t)L * D * D, D, D); w.col0 = D; w.kvec = I.mem_norm_g + L * D; w.sa = 0.f; w.sb = 1.f; convert_w(F, w); }
        }
        convert_layer_weights(F, I, 0, wbuf0);
        SEAM(0);
    }
    if (IN(1)) {
        { pg8::Gemm g = pg8::make_gemm((const bf16_t*)(a.ws + F.wm.mem_b), D, (const bf16_t*)(a.ws + F.wm.wk_all), D, F.NB * NMEM, 4096, D);
          pg8::StaticOrder S; S.init(g.M, g.N, F.G, (int)blockIdx.x);
          pg8::EpiBf16 E{(bf16_t*)(a.ws + F.wm.kall), 4096, nullptr, (const float*)(a.ws + F.wm.rstd_mem), nullptr, 0};
          pg8::gemm_phase(F.lds, g, S, E); }
        { pg8::Gemm g = pg8::make_gemm((const bf16_t*)(a.ws + F.wm.wv_all), D, (const bf16_t*)(a.ws + F.wm.mem_b), D, 4096, F.NB * NMEM, D);
          pg8::StaticOrder S; S.init(g.M, g.N, F.G, (int)blockIdx.x);
          pg8::EpiBf16ColScale E{(bf16_t*)(a.ws + F.wm.vtall), F.NB * NMEM, (const float*)(a.ws + F.wm.rstd_mem)};
          pg8::gemm_phase(F.lds, g, S, E); }
        SEAM(1);
    }
    for (int L = 0; L < 4; ++L) {
        const int base = PH_LAYER0 + L * PH_PER_LAYER;
        if (hi <= base || lo >= base + PH_PER_LAYER) continue;
        unsigned char* const wb = WBUF(L);
        i64* const ssq_m_in = F.ssq + (size_t)((3 * L) & 1) * M, * const ssq_m_out = F.ssq + (size_t)((3 * L + 1) & 1) * M;
        i64* const ssq_a_in = ssq_m_out, * const ssq_a_out = ssq_m_in;
        i64* const ssq_f_in = ssq_m_in, * const ssq_f_out = ssq_m_out;
MIXER_PHASES
        if (IN(base + PH_XATTN + 0)) {
            zero_i64(F, ssq_a_out, M);
            pg8::Gemm g = pg8::make_gemm(F.Xb, D, (const bf16_t*)(wb + WB_WQ), D, M, D, D);
            pg8::StaticOrder S; S.init(g.M, g.N, F.G, (int)blockIdx.x);
            pg8::EpiBf16 E{(bf16_t*)act, D, ssq_a_in, nullptr, nullptr, 0};
            pg8::gemm_phase(F.lds, g, S, E);
            SEAM(base + PH_XATTN + 0);
        }
        if (IN(base + PH_XATTN + 1)) {
            attn_phase(F, (bf16_t*)act, (const bf16_t*)(a.ws + F.wm.kall), (const bf16_t*)(a.ws + F.wm.vtall), L);
            SEAM(base + PH_XATTN + 1);
        }
        if (IN(base + PH_XATTN + 2)) {
            pg8::Gemm g = pg8::make_gemm((const bf16_t*)act, D, (const bf16_t*)(wb + WB_WO), D, M, D, D);
            pg8::StaticOrder S; S.init(g.M, g.N, F.G, (int)blockIdx.x);
            pg8::EpiResid E{F.X, F.Xb, ssq_a_out, nullptr, 0};
            pg8::gemm_phase(F.lds, g, S, E);
            SEAM(base + PH_XATTN + 2);
        }
        if (IN(base + PH_FFN + 0)) {
            zero_i64(F, ssq_f_out, M);
            pg8::Gemm g = pg8::make_gemm(F.Xb, D, (const bf16_t*)(wb + WB_GU), D, M, 2 * FF, D);
            pg8::StaticOrder S; S.init(g.M, g.N, F.G, (int)blockIdx.x);
            pg8::EpiGated<0> E{(bf16_t*)act, FF, ssq_f_in, nullptr, nullptr};
            pg8::gemm_phase(F.lds, g, S, E);
            SEAM(base + PH_FFN + 0);
        }
        if (IN(base + PH_FFN + 1)) {
            if (L < 3) { convert_layer_weights(F, I, L + 1, WBUF(L + 1)); __syncthreads(); }
            pg8::Gemm g = pg8::make_gemm((const bf16_t*)act, FF, (const bf16_t*)(wb + WB_DOWN), FF, M, D, FF);
            pg8::StaticOrder S; S.init(g.M, g.N, F.G, (int)blockIdx.x);
            pg8::EpiResid E{F.X, F.Xb, ssq_f_out, nullptr, 0};
            pg8::gemm_phase(F.lds, g, S, E);
            SEAM(base + PH_FFN + 1);
        }
    }
    if (IN(PH_FINAL)) final_norm(F, F.X, F.ssq + (size_t)(12 & 1) * M, I.final_norm_g, M);
#undef IN
#undef SEAM
}

struct Launcher {
    int grid = 0; bool ok = false;
    void init() {
        if (grid) return;
        int dev = 0, cus = 0, per_cu = 0;
        if (hipGetDevice(&dev) != hipSuccess || hipDeviceGetAttribute(&cus, hipDeviceAttributeMultiprocessorCount, dev) != hipSuccess) { grid = -1; return; }
        if (hipFuncSetAttribute((const void*)mega, hipFuncAttributeMaxDynamicSharedMemorySize, LDS_BYTES) != hipSuccess) { fprintf(stderr, "hipFuncSetAttribute failed\n"); grid = -1; return; }
        if (hipOccupancyMaxActiveBlocksPerMultiprocessor(&per_cu, (const void*)mega, NTHREADS, LDS_BYTES) != hipSuccess || per_cu < 1) fprintf(stderr, "occupancy query: %d\n", per_cu);
        (void)hipGetLastError();
        grid = cus; ok = true;
    }
};
static Launcher g_launcher;
static Inputs make_inputs(void* const* d_in) { Inputs I; const float** p = (const float**)&I; for (int i = 0; i < 45; ++i) p[i] = (const float*)d_in[i]; return I; }
static void launch_phases(hipStream_t st, const Inputs& I, float* out, void* ws, int NB, int lo, int hi, int use_bar, const float* load_src, int load_slot, int conv_layer_p1) {
    Args a{}; a.in = I; a.out = out; a.ws = (unsigned char*)ws; a.load_src = load_src; a.NB = NB; a.ph_lo = lo; a.ph_hi = hi; a.use_bar = use_bar; a.load_slot = load_slot; a.conv_layer_p1 = conv_layer_p1;
    hipLaunchKernelGGL(mega, dim3(g_launcher.grid), dim3(NTHREADS), LDS_BYTES, st, a);
}
}
#ifndef ONE_LAUNCH
#define ONE_LAUNCH 1
#endif
extern "C" void kernel_launch(void* const* d_in, const int* in_sizes, int n_in, void* d_out, int out_size, void* d_ws, size_t ws_size, hipStream_t stream) {
    (void)in_sizes; (void)n_in; (void)out_size;
    constexpr int NB = 16;
    const fp::WsMap wm = fp::make_wsmap(NB);
    fp::g_launcher.init();
    if (ws_size < wm.end || fp::g_launcher.grid <= 0) { fprintf(stderr, "kernel_launch: workspace too small (%zu < %zu) or launcher init failed; nothing launched\n", ws_size, wm.end); return; }
    const fp::Inputs I = fp::make_inputs(d_in);
    (void)hipMemsetAsync(d_ws, 0, wm.rope, stream);
    if (ONE_LAUNCH) fp::launch_phases(stream, I, (float*)d_out, d_ws, NB, 0, fp::PH_END, 1, nullptr, 0, 0);
    else for (int p = 0; p < fp::PH_END; ++p) fp::launch_phases(stream, I, (float*)d_out, d_ws, NB, p, p + 1, 0, nullptr, 0, 0);
}
```

```cpp
#include <hip/hip_runtime.h>
#include <cstdio>
#include <cstdint>

namespace fp {
#define LAS __attribute__((address_space(3)))
#define GAS __attribute__((address_space(1)))
typedef unsigned short bf16_t;
typedef short bf16x8 __attribute__((ext_vector_type(8)));
typedef short s16x4 __attribute__((ext_vector_type(4)));
typedef float f32x2 __attribute__((ext_vector_type(2)));
typedef float f32x4 __attribute__((ext_vector_type(4)));
typedef float f32x16 __attribute__((ext_vector_type(16)));
typedef unsigned u32x2 __attribute__((ext_vector_type(2)));
typedef unsigned u32x4 __attribute__((ext_vector_type(4)));
typedef __bf16 bf16x2_t __attribute__((ext_vector_type(2)));
typedef unsigned long long u64;
typedef long long i64;

constexpr int T = 2048, D = 1024, NMEM = 256, FF = 2816, NWAVES = 8, NTHREADS = 512;
constexpr float SSQ_SCALE = 16777216.0f, SSQ_INV = 1.0f / 16777216.0f;

__device__ __forceinline__ unsigned pk2(float a, float b) { f32x2 v = {a, b}; bf16x2_t r = __builtin_convertvector(v, bf16x2_t); return __builtin_bit_cast(unsigned, r); }
__device__ __forceinline__ float bf_lo(unsigned u) { return __uint_as_float(u << 16); }
__device__ __forceinline__ float bf_hi(unsigned u) { return __uint_as_float(u & 0xffff0000u); }
__device__ __forceinline__ float bf2f(bf16_t b) { return __uint_as_float(((unsigned)b) << 16); }
__device__ __forceinline__ float fast_sigmoid(float x) { return __builtin_amdgcn_rcpf(1.0f + __builtin_amdgcn_exp2f(-1.4426950408889634f * x)); }
__device__ __forceinline__ float fast_silu(float x) { return x * fast_sigmoid(x); }
__device__ __forceinline__ int opaque_tid() { int t = threadIdx.x; asm volatile("" : "+v"(t)); return t; }
__device__ __forceinline__ float dpp_sum16(float v) {
    v += __int_as_float(__builtin_amdgcn_update_dpp(0, __float_as_int(v), 0xB1, 0xF, 0xF, true));
    v += __int_as_float(__builtin_amdgcn_update_dpp(0, __float_as_int(v), 0x4E, 0xF, 0xF, true));
    v += __int_as_float(__builtin_amdgcn_update_dpp(0, __float_as_int(v), 0x141, 0xF, 0xF, true));
    v += __int_as_float(__builtin_amdgcn_update_dpp(0, __float_as_int(v), 0x140, 0xF, 0xF, true));
    return v;
}
__device__ __forceinline__ float wave_sum(float v) { v = dpp_sum16(v); v += __shfl_xor(v, 16); v += __shfl_xor(v, 32); return v; }
#define RLX_AGENT __ATOMIC_RELAXED, __HIP_MEMORY_SCOPE_AGENT
__device__ __forceinline__ void atomic_add_i64(i64* p, i64 v) { (void)__hip_atomic_fetch_add((u64*)p, (u64)v, RLX_AGENT); }
__device__ __forceinline__ float rstd_from_ssq(i64 s, float inv_n, float eps) { return rsqrtf((float)s * SSQ_INV * inv_n + eps); }

#define XB_TMO      128
#define XB_XCNT(j)  (256  + 64 * (j))
#define XB_XSUB(j)  (1280 + 64 * (j))
#define XB_XGEN(j)  (2304 + 64 * (j))
#define XB_TOP      3328
#define XB_TOPGEN   3392
#define XCD_BAR_WORDS 3456
#define XB_SPIN_CAP (1u << 22)
__device__ __forceinline__ unsigned xb_ld(unsigned* p)              { return __hip_atomic_load(p, __ATOMIC_RELAXED, __HIP_MEMORY_SCOPE_AGENT); }
__device__ __forceinline__ unsigned xb_add(unsigned* p, unsigned v) { return __hip_atomic_fetch_add(p, v, __ATOMIC_RELAXED, __HIP_MEMORY_SCOPE_AGENT); }
__device__ __forceinline__ unsigned xb_xcc_id() { return (unsigned)__builtin_amdgcn_s_getreg((3 << 11) | 20) & 0xFu; }
#define XB_SPIN(cond, bar) do { unsigned _sp = 0; while (cond) { __builtin_amdgcn_s_sleep(1); \
    if ((++_sp & 255u) == 0u) { if (xb_ld(&(bar)[XB_TMO])) break; if (_sp > XB_SPIN_CAP) { atomicAdd(&(bar)[XB_TMO], 1u); break; } } } } while (0)
struct XcdBarrier { unsigned* bar; unsigned x; volatile LAS unsigned* st; };
__device__ __forceinline__ XcdBarrier xcd_barrier_post(unsigned* bar, volatile LAS unsigned* st) {
    XcdBarrier b; b.bar = bar; b.x = xb_xcc_id(); b.st = st;
    if (threadIdx.x == 0) (void)xb_add(&bar[XB_XCNT(b.x)], 1u);
    return b;
}
__device__ __forceinline__ void xcd_barrier_complete(unsigned* bar, unsigned x, unsigned& nloc, unsigned& nx) {
    const unsigned G = gridDim.x * gridDim.y * gridDim.z;
    unsigned sum, cnt, mine, sp = 0u;
    for (;;) {
        sum = 0u; cnt = 0u; mine = 0u;
        unsigned cv[16];
        {
            const unsigned* cp = &bar[XB_XCNT(0)];
            asm volatile("global_load_dword %0, %16, off sc1\n\tglobal_load_dword %1, %16, off offset:256 sc1\n\tglobal_load_dword %2, %16, off offset:512 sc1\n\t"
                         "global_load_dword %3, %16, off offset:768 sc1\n\tglobal_load_dword %4, %16, off offset:1024 sc1\n\tglobal_load_dword %5, %16, off offset:1280 sc1\n\t"
                         "global_load_dword %6, %16, off offset:1536 sc1\n\tglobal_load_dword %7, %16, off offset:1792 sc1\n\tglobal_load_dword %8, %16, off offset:2048 sc1\n\t"
                         "global_load_dword %9, %16, off offset:2304 sc1\n\tglobal_load_dword %10, %16, off offset:2560 sc1\n\tglobal_load_dword %11, %16, off offset:2816 sc1\n\t"
                         "global_load_dword %12, %16, off offset:3072 sc1\n\tglobal_load_dword %13, %16, off offset:3328 sc1\n\tglobal_load_dword %14, %16, off offset:3584 sc1\n\t"
                         "global_load_dword %15, %16, off offset:3840 sc1\n\ts_waitcnt vmcnt(0)"
                         : "=&v"(cv[0]), "=&v"(cv[1]), "=&v"(cv[2]), "=&v"(cv[3]), "=&v"(cv[4]), "=&v"(cv[5]), "=&v"(cv[6]), "=&v"(cv[7]),
                           "=&v"(cv[8]), "=&v"(cv[9]), "=&v"(cv[10]), "=&v"(cv[11]), "=&v"(cv[12]), "=&v"(cv[13]), "=&v"(cv[14]), "=&v"(cv[15])
                         : "v"(cp) : "memory");
        }
#pragma unroll
        for (unsigned j = 0; j < 16; ++j) { const unsigned c = cv[j]; sum += c; cnt += (c > 0u) ? 1u : 0u; mine = (j == x) ? c : mine; }
        if (sum == G) break;
        __builtin_amdgcn_s_sleep(1);
        if ((++sp & 255u) == 0u) { if (xb_ld(&bar[XB_TMO])) break; if (sp > XB_SPIN_CAP) { atomicAdd(&bar[XB_TMO], 1u); break; } }
    }
    nloc = mine > 0u ? mine : 1u; nx = cnt > 0u ? cnt : 1u;
}
__device__ __forceinline__ void xcd_barrier(const XcdBarrier& b) {
    asm volatile("s_waitcnt vmcnt(0)" ::: "memory");
    __syncthreads();
    if (threadIdx.x == 0) {
        unsigned* bar = b.bar;
        __builtin_amdgcn_s_waitcnt(0);
        unsigned nloc = b.st[0], nx = b.st[1];
        if (nloc == 0u) { xcd_barrier_complete(bar, b.x, nloc, nx); b.st[0] = nloc; b.st[1] = nx; }
        const unsigned old = xb_add(&bar[XB_XSUB(b.x)], 1u);
        const unsigned gen = old / nloc;
        if (old + 1u == (gen + 1u) * nloc) {
            __builtin_amdgcn_fence(__ATOMIC_RELEASE, "agent");
            asm volatile("s_waitcnt vmcnt(0)" ::: "memory");
            const unsigned og = xb_add(&bar[XB_TOP], 1u);
            const unsigned tg = og / nx;
            if (og + 1u == (tg + 1u) * nx) xb_add(&bar[XB_TOPGEN], 1u);
            else XB_SPIN(xb_ld(&bar[XB_TOPGEN]) == tg, bar);
            __builtin_amdgcn_fence(__ATOMIC_ACQUIRE, "agent");
            xb_add(&bar[XB_XGEN(b.x)], 1u);
            asm volatile("s_waitcnt vmcnt(0)" ::: "memory");
        } else {
            XB_SPIN(xb_ld(&bar[XB_XGEN(b.x)]) == gen, bar);
            __builtin_amdgcn_fence(__ATOMIC_ACQUIRE, "agent");
            asm volatile("s_waitcnt vmcnt(0)" ::: "memory");
        }
    }
    __syncthreads();
}

namespace pg8 {
constexpr int BM = 256, BK = 64, HALF = 128, HTB = HALF * BK * 2, STAGE_BYTES = 8 * HTB, NXCD = 8, WGM = 8;
__host__ __device__ __forceinline__ int lds_byte(int r, int c) { const int st = (r >> 4) * 2 + (c >> 5), rr = r & 15, cc = c & 31, ob = rr * 64 + cc * 2; return st * 1024 + (ob ^ (((ob >> 9) & 1) << 5)); }
__host__ __device__ __forceinline__ void stage_rc(int b, int& R, int& C) { const int st = b / 1024, sb = b % 1024, swz = sb ^ (((sb >> 9) & 1) << 5); R = (st >> 1) * 16 + swz / 64; C = (st & 1) * 32 + (swz % 64) / 2; }
__host__ __device__ __forceinline__ int perm32(int rho) { const int n = rho >> 4, i = rho & 15; return 8 * (i >> 2) + 4 * n + (i & 3); }

struct Unit { int pm, pn; };
struct Gemm { const bf16_t* A; const bf16_t* Bt; int M, N, K, lda, ldb, ksplit, ajump, seq_pad; };
__device__ __forceinline__ Gemm make_gemm(const bf16_t* A, int lda, const bf16_t* Bt, int ldb, int M, int N, int K) { Gemm g; g.A = A; g.Bt = Bt; g.M = M; g.N = N; g.K = K; g.lda = lda; g.ldb = ldb; g.ksplit = 1 << 20; g.ajump = 0; g.seq_pad = 0; return g; }

struct StaticOrder {
    int nM, nN, nwg, G, c;
    __device__ void init(int M, int N, int G_, int c_) { nM = M / BM; nN = N / BM; nwg = nM * nN; G = G_; c = c_; }
    __device__ bool next(int i, Unit& u) const {
        const long L = (long)i * G + c; if (L >= nwg) return false;
        int wgid = (int)L; { const int q = nwg / NXCD, r = nwg % NXCD, xcd = wgid % NXCD, off = wgid / NXCD; wgid = (xcd < r ? xcd * (q + 1) : r * (q + 1) + (xcd - r) * q) + off; }
        const int nig = WGM * nN, gid = wgid / nig, fm = gid * WGM, gsz = (nM - fm) < WGM ? (nM - fm) : WGM;
        u.pm = fm + ((wgid % nig) % gsz); u.pn = (wgid % nig) / gsz; return true;
    }
};

template <class Epi>
__device__ __forceinline__ void gemm_phase(LAS unsigned char* lds, const Gemm g, const StaticOrder& S, const Epi& E) {
    int tid_ = threadIdx.x; asm volatile("" : "+v"(tid_));
    const int tid = tid_, wid = __builtin_amdgcn_readfirstlane(tid >> 6), lane = tid & 63, wr = wid >> 2, wc = wid & 3, fr = lane & 15, fq = lane >> 4;
    const int K = g.K, nt = K / BK;
    unsigned voffA[2], voffB[2];
#pragma unroll
    for (int i = 0; i < 2; ++i) { int R, C; stage_rc(tid * 16 + i * 8192, R, C); const int Rb = Epi::PERM ? ((R & ~31) + perm32(R & 31)) : R;
        voffA[i] = (unsigned)(R * g.lda + C) * 2u; voffB[i] = (unsigned)(Rb * g.ldb + C) * 2u; }
    const long kstep = (long)(BK * 2);
    const long hstepA = (long)HALF * g.lda * 2, hstepB = (long)HALF * g.ldb * 2;
    const long rowA = (long)g.lda * 2;
    const int ksplit = g.ksplit; const long ajump = g.ajump;
    const unsigned ldsw = (unsigned)wid * 1024u;
    const int aoff = lds_byte(wr * 64 + fr, fq * 8), boff = lds_byte(wc * 32 + fr, fq * 8);
#define PG8_SA(b, h) (((b) * 2 + (h)) * HTB)
#define PG8_SB(b, h) ((4 + (b) * 2 + (h)) * HTB)
#define PG8_STAGE(bufoff, gbase, voff) do { _Pragma("unroll") for (int _i = 0; _i < 2; ++_i) \
        __builtin_amdgcn_global_load_lds((const unsigned*)((const char*)(gbase) + (voff)[_i]), (LAS unsigned*)(lds + (bufoff) + ldsw + _i * 8192), 16, 0, 0); } while (0)
#define PG8_LDA(dst, b, h) do { _Pragma("unroll") for (int m = 0; m < 4; ++m) _Pragma("unroll") for (int k = 0; k < 2; ++k) dst[m][k] = *(const LAS bf16x8*)(lds + PG8_SA(b, h) + aoff + m * 2048 + k * 1024); } while (0)
#define PG8_LDB(dst, b, h) do { _Pragma("unroll") for (int n = 0; n < 2; ++n) _Pragma("unroll") for (int k = 0; k < 2; ++k) dst[n][k] = *(const LAS bf16x8*)(lds + PG8_SB(b, h) + boff + n * 2048 + k * 1024); } while (0)
#define PG8_MMA(ai, bj, At, Bt) do { __builtin_amdgcn_s_setprio(1); _Pragma("unroll") for (int m = 0; m < 4; ++m) _Pragma("unroll") for (int n = 0; n < 2; ++n) _Pragma("unroll") for (int k = 0; k < 2; ++k) \
        acc[ai][bj][m][n] = __builtin_amdgcn_mfma_f32_16x16x32_bf16(Bt[n][k], At[m][k], acc[ai][bj][m][n], 0, 0, 0); __builtin_amdgcn_s_setprio(0); } while (0)
#define PG8_WAIT_V(n) asm volatile("s_waitcnt vmcnt(" #n ")" ::: "memory")
#define PG8_WAIT_L(n) asm volatile("s_waitcnt lgkmcnt(" #n ")" ::: "memory")
#define PG8_BAR __builtin_amdgcn_s_barrier()
#define PG8_SCHED __builtin_amdgcn_sched_barrier(0)
#define PG8_ABASE(u) ((const char*)g.A + ((long)(u).pm * BM + (g.seq_pad ? (((u).pm >> 3) + 1) : 0)) * rowA)
#define PG8_BBASE(u) ((const char*)g.Bt + (long)(u).pn * 2 * hstepB)
#define PG8_AK(base, kt) ((base) + (long)(kt) * kstep + ((kt) >= ksplit ? ajump : 0L))
    Unit cur, nxt; int ui = 0;
    if (!S.next(0, cur)) return;
    f32x4 acc[2][2][4][2];
#pragma unroll
    for (int a = 0; a < 2; ++a)
#pragma unroll
        for (int b = 0; b < 2; ++b)
#pragma unroll
            for (int m = 0; m < 4; ++m)
#pragma unroll
                for (int n = 0; n < 2; ++n) acc[a][b][m][n] = (f32x4){0.f, 0.f, 0.f, 0.f};
    bf16x8 At[4][2], B0[2][2], B1[2][2];
    const char* cA = PG8_ABASE(cur); const char* cB = PG8_BBASE(cur);
#ifndef PG8_SP2
#define PG8_SP2 1
#endif
#if PG8_SP2
    PG8_STAGE(PG8_SB(0, 0), cB, voffB); PG8_STAGE(PG8_SB(0, 1), cB + hstepB, voffB); PG8_STAGE(PG8_SA(0, 0), cA, voffA); PG8_STAGE(PG8_SA(0, 1), cA + hstepA, voffA);
    if (wr == 1) PG8_BAR;
    PG8_WAIT_V(2); PG8_BAR;
    { const char* a1p = PG8_AK(cA, 1);
      PG8_STAGE(PG8_SB(1, 0), cB + kstep, voffB); PG8_STAGE(PG8_SA(1, 0), a1p, voffA); PG8_STAGE(PG8_SB(1, 1), cB + hstepB + kstep, voffB); }
    PG8_WAIT_V(6); PG8_BAR;
#else
    PG8_STAGE(PG8_SB(0, 0), cB, voffB); PG8_STAGE(PG8_SA(0, 0), cA, voffA); PG8_STAGE(PG8_SB(0, 1), cB + hstepB, voffB); PG8_STAGE(PG8_SA(0, 1), cA + hstepA, voffA);
    if (wr == 1) PG8_BAR;
    PG8_WAIT_V(4); PG8_BAR;
    { const char* a1p = PG8_AK(cA, 1);
      PG8_STAGE(PG8_SB(1, 0), cB + kstep, voffB); PG8_STAGE(PG8_SA(1, 0), a1p, voffA); PG8_STAGE(PG8_SB(1, 1), cB + hstepB + kstep, voffB); }
    PG8_WAIT_V(6); PG8_BAR;
#endif
    for (;;) {
        const bool has_next = S.next(ui + 1, nxt);
        const char* nA = has_next ? PG8_ABASE(nxt) : cA; const char* nB = has_next ? PG8_BBASE(nxt) : cB;
        for (int t = 0; t < nt; t += 2) {
            const bool last = (t == nt - 2);
            const char* a1 = PG8_AK(cA, t + 1);
            const char* a2 = last ? nA : PG8_AK(cA, t + 2); const char* b2 = last ? nB : cB + (long)(t + 2) * kstep;
            const char* a3 = last ? PG8_AK(nA, 1) : PG8_AK(cA, t + 3); const char* b3 = b2 + kstep;
#if PG8_SP2
            PG8_LDB(B0, 0, 0); PG8_LDB(B1, 0, 1); PG8_SCHED; PG8_LDA(At, 0, 0); PG8_STAGE(PG8_SA(1, 1), a1 + hstepA, voffA);
            PG8_WAIT_V(8); PG8_WAIT_L(0); PG8_BAR; PG8_MMA(0, 0, At, B0); PG8_MMA(0, 1, At, B1); PG8_BAR; PG8_SCHED;
            PG8_LDA(At, 0, 1); PG8_STAGE(PG8_SB(0, 0), b2, voffB); PG8_STAGE(PG8_SB(0, 1), b2 + hstepB, voffB); PG8_STAGE(PG8_SA(0, 0), a2, voffA);
            PG8_WAIT_V(8); PG8_WAIT_L(0); PG8_BAR; PG8_MMA(1, 0, At, B0); PG8_MMA(1, 1, At, B1); PG8_BAR; PG8_SCHED;
            PG8_LDB(B0, 1, 0); PG8_LDB(B1, 1, 1); PG8_SCHED; PG8_LDA(At, 1, 0); PG8_STAGE(PG8_SA(0, 1), a2 + hstepA, voffA);
            PG8_WAIT_V(8); PG8_WAIT_L(0); PG8_BAR; PG8_MMA(0, 0, At, B0); PG8_MMA(0, 1, At, B1); PG8_BAR; PG8_SCHED;
            PG8_LDA(At, 1, 1); PG8_STAGE(PG8_SB(1, 0), b3, voffB); PG8_STAGE(PG8_SB(1, 1), b3 + hstepB, voffB); PG8_STAGE(PG8_SA(1, 0), a3, voffA);
            PG8_WAIT_V(8); PG8_WAIT_L(0); PG8_BAR; PG8_MMA(1, 0, At, B0); PG8_MMA(1, 1, At, B1); PG8_BAR; PG8_SCHED;
#else
            PG8_LDB(B0, 0, 0); PG8_SCHED; PG8_LDA(At, 0, 0); PG8_STAGE(PG8_SA(1, 1), a1 + hstepA, voffA);
            PG8_WAIT_L(8); PG8_BAR; PG8_WAIT_L(0); PG8_MMA(0, 0, At, B0); PG8_BAR; PG8_SCHED;
            PG8_LDB(B1, 0, 1); PG8_STAGE(PG8_SB(0, 0), b2, voffB);
            PG8_BAR; PG8_WAIT_L(0); PG8_MMA(0, 1, At, B1); PG8_BAR;
            PG8_LDA(At, 0, 1); PG8_STAGE(PG8_SA(0, 0), a2, voffA);
            PG8_BAR; PG8_WAIT_L(0); PG8_MMA(1, 0, At, B0); PG8_BAR; PG8_SCHED;
            PG8_STAGE(PG8_SB(0, 1), b2 + hstepB, voffB);
            PG8_WAIT_V(6); PG8_BAR; PG8_MMA(1, 1, At, B1); PG8_BAR;
            PG8_LDB(B0, 1, 0); PG8_SCHED; PG8_LDA(At, 1, 0); PG8_STAGE(PG8_SA(0, 1), a2 + hstepA, voffA);
            PG8_WAIT_L(8); PG8_BAR; PG8_WAIT_L(0); PG8_MMA(0, 0, At, B0); PG8_BAR; PG8_SCHED;
            PG8_LDB(B1, 1, 1); PG8_STAGE(PG8_SB(1, 0), b3, voffB);
            PG8_BAR; PG8_WAIT_L(0); PG8_MMA(0, 1, At, B1); PG8_BAR;
            PG8_LDA(At, 1, 1); PG8_STAGE(PG8_SA(1, 0), a3, voffA);
            PG8_BAR; PG8_WAIT_L(0); PG8_MMA(1, 0, At, B0); PG8_BAR; PG8_SCHED;
            PG8_STAGE(PG8_SB(1, 1), b3 + hstepB, voffB);
            PG8_WAIT_V(6); PG8_BAR; PG8_MMA(1, 1, At, B1); PG8_BAR;
#endif
        }
#ifndef PG8_ALIGN
#define PG8_ALIGN 1
#endif
        if (PG8_ALIGN && wr == 0) PG8_BAR;
        E(acc, cur, wr, wc, fr, fq);
        if (!has_next) break;
#pragma unroll
        for (int a = 0; a < 2; ++a)
#pragma unroll
            for (int b = 0; b < 2; ++b)
#pragma unroll
                for (int m = 0; m < 4; ++m)
#pragma unroll
                    for (int n = 0; n < 2; ++n) acc[a][b][m][n] = (f32x4){0.f, 0.f, 0.f, 0.f};
        cur = nxt; cA = nA; cB = nB; ++ui;
        if (PG8_ALIGN && wr == 1) PG8_BAR;
    }
    PG8_WAIT_V(0);
    if (!PG8_ALIGN && wr == 0) PG8_BAR;
    PG8_BAR;
#undef PG8_SA
#undef PG8_SB
#undef PG8_STAGE
#undef PG8_LDA
#undef PG8_LDB
#undef PG8_MMA
#undef PG8_WAIT_V
#undef PG8_WAIT_L
#undef PG8_BAR
#undef PG8_SCHED
#undef PG8_ABASE
#undef PG8_BBASE
#undef PG8_AK
}

typedef f32x4 Acc[2][2][4][2];
#define EPI_ROWS(u, wr, fr, ai, m) ((u).pm * BM + (ai) * HALF + (wr) * 64 + (m) * 16 + (fr))

struct EpiBf16 {
    static constexpr bool PERM = true;
    bf16_t* O; int ldc; const i64* ssq; const float* rowscale; const float* bias; int row_off;
    int mpm = 0, mpn = 0;
    __device__ __forceinline__ void operator()(const Acc& acc, const Unit& u, int wr, int wc, int fr, int fq) const {
        const int col0 = u.pn * BM + wc * 32 + 8 * fq;
#pragma unroll
        for (int ai = 0; ai < 2; ++ai)
#pragma unroll
            for (int m = 0; m < 4; ++m) {
                const int row = EPI_ROWS(u, wr, fr, ai, m);
                float rs = 1.0f;
                if (ssq) rs = rstd_from_ssq(ssq[row + row_off], 1.0f / 1024.0f, 1e-6f);
                else if (rowscale) rs = rowscale[row + row_off];
                bf16_t* rowp = (mpm | mpn) ? O + ((size_t)(u.pm * mpm + u.pn * mpn) << 16) + (row & 255) * 256 + (col0 & 255) : O + (size_t)row * ldc + col0;
#pragma unroll
                for (int bj = 0; bj < 2; ++bj) {
                    f32x4 v0 = acc[ai][bj][m][0] * rs, v1 = acc[ai][bj][m][1] * rs;
                    if (bias) { v0 += *(const f32x4*)(bias + col0 + bj * HALF); v1 += *(const f32x4*)(bias + col0 + bj * HALF + 4); }
                    u32x4 w; w.x = pk2(v0[0], v0[1]); w.y = pk2(v0[2], v0[3]); w.z = pk2(v1[0], v1[1]); w.w = pk2(v1[2], v1[3]);
                    *(u32x4*)(rowp + bj * HALF) = w;
                }
            }
    }
};
struct EpiBf16ColScale {
    static constexpr bool PERM = true;
    bf16_t* O; int ldc; const float* colscale;
    int mpm = 0, mpn = 0;
    __device__ __forceinline__ void operator()(const Acc& acc, const Unit& u, int wr, int wc, int fr, int fq) const {
        const int col0 = u.pn * BM + wc * 32 + 8 * fq;
        f32x4 cs[2][2];
#pragma unroll
        for (int bj = 0; bj < 2; ++bj) { cs[bj][0] = *(const f32x4*)(colscale + col0 + bj * HALF); cs[bj][1] = *(const f32x4*)(colscale + col0 + bj * HALF + 4); }
#pragma unroll
        for (int ai = 0; ai < 2; ++ai)
#pragma unroll
            for (int m = 0; m < 4; ++m) {
                const int row = EPI_ROWS(u, wr, fr, ai, m);
                bf16_t* rowp = (mpm | mpn) ? O + ((size_t)(u.pm * mpm + u.pn * mpn) << 16) + (row & 255) * 256 + (col0 & 255) : O + (size_t)row * ldc + col0;
#pragma unroll
                for (int bj = 0; bj < 2; ++bj) {
                    const f32x4 v0 = acc[ai][bj][m][0] * cs[bj][0], v1 = acc[ai][bj][m][1] * cs[bj][1];
                    u32x4 w; w.x = pk2(v0[0], v0[1]); w.y = pk2(v0[2], v0[3]); w.z = pk2(v1[0], v1[1]); w.w = pk2(v1[2], v1[3]);
                    if (row & 16) { const unsigned t0 = w.x, t1 = w.y; w.x = w.z; w.y = w.w; w.z = t0; w.w = t1; }
                    *(u32x4*)(rowp + bj * HALF) = w;
                }
            }
    }
};
template <int MODE> struct EpiGated {
    static constexpr bool PERM = true;
    bf16_t* O; int ldc; const i64* ssq; const float* biasA; const float* biasB;
    __device__ __forceinline__ void operator()(const Acc& acc, const Unit& u, int wr, int wc, int fr, int fq) const {
        const int col0 = u.pn * HALF + wc * 32 + 8 * fq;
        f32x4 ba[2], bb[2];
        if (MODE == 1) { ba[0] = *(const f32x4*)(biasA + col0); ba[1] = *(const f32x4*)(biasA + col0 + 4); bb[0] = *(const f32x4*)(biasB + col0); bb[1] = *(const f32x4*)(biasB + col0 + 4); }
#pragma unroll
        for (int ai = 0; ai < 2; ++ai)
#pragma unroll
            for (int m = 0; m < 4; ++m) {
                const int row = EPI_ROWS(u, wr, fr, ai, m);
                const float rs = rstd_from_ssq(ssq[row], 1.0f / 1024.0f, 1e-6f);
                float o[8];
                if (MODE == 0) {
                    const float rsl = rs * 1.4426950408889634f, rsi = rs * 0.6931471805599453f;
#pragma unroll
                    for (int n = 0; n < 2; ++n)
#pragma unroll
                        for (int j = 0; j < 4; j += 2) {
                            const f32x2 t = (f32x2){acc[ai][0][m][n][j], acc[ai][0][m][n][j + 1]} * rsl;
                            const f32x2 ub = (f32x2){acc[ai][1][m][n][j], acc[ai][1][m][n][j + 1]} * rsi;
                            const f32x2 d = (f32x2){__builtin_amdgcn_exp2f(-t[0]), __builtin_amdgcn_exp2f(-t[1])} + 1.0f;
                            const f32x2 r = {__builtin_amdgcn_rcpf(d[0]), __builtin_amdgcn_rcpf(d[1])};
                            const f32x2 res = (t * r) * ub;
                            o[n * 4 + j] = res[0]; o[n * 4 + j + 1] = res[1];
                        }
                } else {
#pragma unroll
                    for (int n = 0; n < 2; ++n)
#pragma unroll
                        for (int j = 0; j < 4; ++j) {
                            float a = acc[ai][0][m][n][j] * rs, b = acc[ai][1][m][n][j] * rs;
                            o[n * 4 + j] = (a + ba[n][j]) * fast_sigmoid(b + bb[n][j]);
                        }
                }
                u32x4 w; w.x = pk2(o[0], o[1]); w.y = pk2(o[2], o[3]); w.z = pk2(o[4], o[5]); w.w = pk2(o[6], o[7]);
                *(u32x4*)(O + (size_t)row * ldc + col0) = w;
            }
    }
};
struct EpiResid {
    static constexpr bool PERM = true;
    bf16_t* Xb; i64* ssq_out; const float* bias; int row_off;
    __device__ __forceinline__ void operator()(const Acc& acc, const Unit& u, int wr, int wc, int fr, int fq) const {
        const int col0 = u.pn * BM + wc * 32 + 8 * fq;
#pragma unroll
        for (int ai = 0; ai < 2; ++ai)
#pragma unroll
            for (int m = 0; m < 4; ++m) {
                const int row = EPI_ROWS(u, wr, fr, ai, m) + row_off;
                bf16_t* xb = Xb + (size_t)row * D + col0;
                float ss = 0.f;
#pragma unroll
                for (int bj = 0; bj < 2; ++bj) {
                    const u32x4 xo = *(const u32x4*)(xb + bj * HALF);
                    f32x4 v0 = (f32x4){bf_lo(xo.x), bf_hi(xo.x), bf_lo(xo.y), bf_hi(xo.y)} + acc[ai][bj][m][0];
                    f32x4 v1 = (f32x4){bf_lo(xo.z), bf_hi(xo.z), bf_lo(xo.w), bf_hi(xo.w)} + acc[ai][bj][m][1];
                    if (bias) { v0 += *(const f32x4*)(bias + col0 + bj * HALF); v1 += *(const f32x4*)(bias + col0 + bj * HALF + 4); }
                    u32x4 w; w.x = pk2(v0[0], v0[1]); w.y = pk2(v0[2], v0[3]); w.z = pk2(v1[0], v1[1]); w.w = pk2(v1[2], v1[3]);
                    *(u32x4*)(xb + bj * HALF) = w;
                    ss += ((v0[0] * v0[0] + v0[1] * v0[1]) + (v0[2] * v0[2] + v0[3] * v0[3])) + ((v1[0] * v1[0] + v1[1] * v1[1]) + (v1[2] * v1[2] + v1[3] * v1[3]));
                }
                ss += __shfl_xor(ss, 16); ss += __shfl_xor(ss, 32);
                if (fq == 0) atomic_add_i64(ssq_out + row, (i64)(ss * SSQ_SCALE + 0.5f));
            }
    }
};
}
constexpr size_t MiB = 1u << 20;
constexpr int LDS_BYTES = 163840, RING_BYTES = 131072, LDSCTL_OFF = LDS_BYTES - 1024;

struct Inputs {
    const float *x, *mem, *mix_norm_g, *xattn_norm_g, *mem_norm_g, *xattn_wq, *xattn_wkv, *xattn_wo, *ffn_norm_g, *ffn_w_gate_up, *ffn_w_down,
        *conv_w_in, *conv_b_in, *conv_dw, *conv_dw_b, *conv_ln_g, *conv_ln_b, *conv_w_out, *conv_b_out,
        *rwkv_mix, *rwkv_w_rkv, *rwkv_w0, *rwkv_w1, *rwkv_w2, *rwkv_a0, *rwkv_a1, *rwkv_a2, *rwkv_g1, *rwkv_g2, *rwkv_k_k, *rwkv_k_a, *rwkv_r_k, *rwkv_gn_g, *rwkv_gn_b, *rwkv_w_o,
        *sgu_w_in, *sgu_b_in, *sgu_ln_g, *sgu_ln_b, *sgu_ws, *sgu_bs, *sgu_w_out, *ret_w_in, *ret_w_out, *final_norm_g;
};
struct WsMap {
    size_t ctl, ssq, lns, oss, rope, wstril, rstd_mem, wk_all, wv_all, mem_b, kall, vtall, wb0, wb1, xb, act, end;
};
__host__ __device__ inline WsMap make_wsmap(int NB) {
    WsMap w; const size_t M = (size_t)NB * T; size_t o = 0;
    w.ctl = o; o += 1 * MiB;
    w.ssq = o; o += 2 * M * 8;
    w.lns = o; o += M * 2 * 8;
    w.oss = o; o += M * 4 * 8;
    o = (o + MiB - 1) / MiB * MiB;
    w.rope = o; o += (size_t)T * 128 * 8;
    w.wstril = o; o += 8 * 128 * 128 * 2;
    w.rstd_mem = o; o += (size_t)NB * NMEM * 4; o = (o + MiB - 1) / MiB * MiB;
    w.wk_all = o; o += 8 * MiB; w.wv_all = o; o += 8 * MiB;
    w.mem_b = o; o += (size_t)NB * NMEM * D * 2; o = (o + MiB - 1) / MiB * MiB;
    w.kall = o; o += (size_t)NB * NMEM * 4096 * 2; w.vtall = o; o += (size_t)NB * NMEM * 4096 * 2; o = (o + MiB - 1) / MiB * MiB;
    w.wb0 = o; o += 37 * MiB; w.wb1 = o; o += 37 * MiB;
    w.xb = o; o += M * D * 2;
    w.act = o; o += (size_t)NB * 2048 * 8704 + 4 * MiB;
    w.end = o; return w;
}
constexpr size_t ZERO_BYTES_PER_SEQ = (size_t)T * 8 * 8;
constexpr size_t WB_WQ = 0, WB_WO = 2 * MiB, WB_GU = 4 * MiB, WB_DOWN = 15 * MiB, WB_MIX = 21 * MiB;
constexpr size_t WB_CONV_IN = WB_MIX, WB_CONV_OUT = WB_MIX + 4 * MiB;
constexpr size_t WB_RW_RKV = WB_MIX, WB_RW_L1 = WB_MIX + 6 * MiB, WB_RW_W2 = WB_MIX + 8 * MiB, WB_RW_A2 = WB_RW_W2 + MiB / 2, WB_RW_G2 = WB_RW_W2 + MiB, WB_RW_WO = WB_MIX + 10 * MiB;
constexpr size_t WB_SGU_IN = WB_MIX, WB_SGU_OUT = WB_MIX + 8 * MiB;
constexpr size_t WB_RET_QKV = WB_MIX, WB_RET_G = WB_MIX + 8 * MiB, WB_RET_OUT = WB_MIX + 12 * MiB;

struct Args { Inputs in; float* out; unsigned char* ws; const float* load_src; int NB, ph_lo, ph_hi, use_bar, load_slot, conv_layer_p1, dump_xb, pad; };

struct Frame {
    LAS unsigned char* lds;
    int wave, vcu, G, gw, NGW;
    int NB, M;
    unsigned char* ws; WsMap wm;
    bf16_t* Xb; i64* ssq; i64* lns; i64* oss;
};

struct WConv { const float* src; int src_ld, Ksrc, koff, Kdst, kd0, kd1; bf16_t* dst; int nrows, nvalid, map_blk, map_halfoff, col0; const float* kvec; float sa, sb, cscale; };
__device__ __forceinline__ WConv wconv(const float* src, int src_ld, int Ksrc, bf16_t* dst, int nrows, int Kdst) {
    WConv w; w.src = src; w.src_ld = src_ld; w.Ksrc = Ksrc; w.koff = 0; w.Kdst = Kdst; w.kd0 = 0; w.kd1 = Kdst; w.dst = dst; w.nrows = nrows; w.nvalid = nrows; w.map_blk = 0; w.map_halfoff = 0; w.col0 = 0;
    w.kvec = nullptr; w.sa = 1.f; w.sb = 0.f; w.cscale = 1.f; return w;
}
__device__ __forceinline__ void convert_w(const Frame& F, const WConv& w) {
    LAS float* scr = (LAS float*)(F.lds + F.wave * 16384);
    const int nblk = w.nrows / 32, kblk = (w.kd1 - w.kd0) / 64, nitems = nblk * kblk, lane = opaque_tid() & 63;
    const int kq = lane >> 3, nq = lane & 7;
    for (int it = F.gw; it < nitems; it += F.NGW) {
        const int kb = it / nblk, nb = it % nblk, k0 = w.kd0 + 64 * kb, n0 = 32 * nb;
        const int n = n0 + 4 * nq;
        int col = w.col0 + n;
        if (w.map_blk) { const int b2 = 2 * w.map_blk; col = w.col0 + ((n % b2) / w.map_blk) * w.map_halfoff + (n / b2) * w.map_blk + n % w.map_blk; }
        f32x4 v[8]; float kvs[8];
        const float* kvp = w.kvec ? w.kvec : w.src;
#pragma unroll
        for (int i = 0; i < 8; ++i) {
            const int k = k0 + kq + 8 * i - w.koff;
            v[i] = (k >= 0 && k < w.Ksrc && n < w.nvalid) ? *(const f32x4*)(w.src + (size_t)k * w.src_ld + col) : (f32x4){0.f, 0.f, 0.f, 0.f};
            kvs[i] = kvp[k < 0 ? 0 : (k < w.Ksrc ? k : w.Ksrc - 1)];
        }
#pragma unroll
        for (int i = 0; i < 8; ++i) {
            const int kk = kq + 8 * i, k = k0 + kk - w.koff;
            float sc = w.cscale; if (w.kvec && k >= 0 && k < w.Ksrc) sc *= (w.sa + w.sb * kvs[i]);
            LAS float* d = scr + kk * 37 + 4 * nq;
            d[0] = v[i][0] * sc; d[1] = v[i][1] * sc; d[2] = v[i][2] * sc; d[3] = v[i][3] * sc;
        }
        asm volatile("s_waitcnt lgkmcnt(0)" ::: "memory");
        const int c = lane & 7;
#pragma unroll
        for (int j = 0; j < 4; ++j) { const int nn = (lane >> 3) + 8 * j; const LAS float* s = scr + (8 * c) * 37 + nn;
            u32x4 o; o.x = pk2(s[0 * 37], s[1 * 37]); o.y = pk2(s[2 * 37], s[3 * 37]); o.z = pk2(s[4 * 37], s[5 * 37]); o.w = pk2(s[6 * 37], s[7 * 37]);
            *(u32x4*)(w.dst + (size_t)(n0 + nn) * w.Kdst + k0 + 8 * c) = o; }
        asm volatile("s_waitcnt lgkmcnt(0)" ::: "memory");
    }
}
__device__ __forceinline__ void convert_layer_weights(const Frame& F, const Inputs& I, int L, unsigned char* wb) {
    const size_t DD = (size_t)D * D;
    { WConv w = wconv(I.xattn_wq + L * DD, D, D, (bf16_t*)(wb + WB_WQ), D, D); w.kvec = I.xattn_norm_g + L * D; w.sa = 0.f; w.sb = 1.f; w.cscale = 0.0625f * 1.4426950408889634f; convert_w(F, w); }
    { WConv w = wconv(I.xattn_wo + L * DD, D, D, (bf16_t*)(wb + WB_WO), D, D); convert_w(F, w); }
    { WConv w = wconv(I.ffn_w_gate_up + (size_t)L * D * 2 * FF, 2 * FF, D, (bf16_t*)(wb + WB_GU), 2 * FF, D); w.kvec = I.ffn_norm_g + L * D; w.sa = 0.f; w.sb = 1.f; w.map_blk = 128; w.map_halfoff = FF; convert_w(F, w); }
    { WConv w = wconv(I.ffn_w_down + (size_t)L * FF * D, D, FF, (bf16_t*)(wb + WB_DOWN), D, FF); convert_w(F, w); }
    if (L == 0) {
        { WConv w = wconv(I.conv_w_in, 2 * D, D, (bf16_t*)(wb + WB_CONV_IN), 2 * D, D); w.kvec = I.mix_norm_g; w.sa = 0.f; w.sb = 1.f; w.map_blk = 128; w.map_halfoff = D; convert_w(F, w); }
        { WConv w = wconv(I.conv_w_out, D, D, (bf16_t*)(wb + WB_CONV_OUT), D, D); convert_w(F, w); }
    } else if (L == 1) {
        for (int i = 0; i < 3; ++i) { WConv w = wconv(I.rwkv_w_rkv + i * DD, D, D, (bf16_t*)(wb + WB_RW_RKV) + i * DD, D, D); convert_w(F, w); }
        bf16_t* l1 = (bf16_t*)(wb + WB_RW_L1);
        for (int part = 0; part < 2; ++part) {
            const float sa = part ? 0.f : 1.f, sb = part ? 1.f : -1.f; const int kd0 = part * D, kd1 = kd0 + D;
            { WConv w = wconv(I.rwkv_w1, 64, D, l1, 64, 2 * D); w.kvec = I.rwkv_mix + 1 * D; w.sa = sa; w.sb = sb; w.koff = kd0; w.kd0 = kd0; w.kd1 = kd1; convert_w(F, w); }
            { WConv w = wconv(I.rwkv_a1, 64, D, l1 + 64 * 2 * D, 64, 2 * D); w.kvec = I.rwkv_mix + 4 * D; w.sa = sa; w.sb = sb; w.koff = kd0; w.kd0 = kd0; w.kd1 = kd1; convert_w(F, w); }
            { WConv w = wconv(I.rwkv_g1, 160, D, l1 + 128 * 2 * D, 384, 2 * D); w.nvalid = 160; w.kvec = I.rwkv_mix + 5 * D; w.sa = sa; w.sb = sb; w.koff = kd0; w.kd0 = kd0; w.kd1 = kd1; convert_w(F, w); }
        }
        { WConv w = wconv(I.rwkv_w2, D, 64, (bf16_t*)(wb + WB_RW_W2), D, 256); convert_w(F, w); }
        { WConv w = wconv(I.rwkv_a2, D, 64, (bf16_t*)(wb + WB_RW_A2), D, 256); w.koff = 64; convert_w(F, w); }
        { WConv w = wconv(I.rwkv_g2, D, 160, (bf16_t*)(wb + WB_RW_G2), D, 256); convert_w(F, w); }
        { WConv w = wconv(I.rwkv_w_o, D, D, (bf16_t*)(wb + WB_RW_WO), D, D); convert_w(F, w); }
    } else if (L == 2) {
        { WConv w = wconv(I.sgu_w_in, 4096, D, (bf16_t*)(wb + WB_SGU_IN), 4096, D); w.kvec = I.mix_norm_g + 2 * D; w.sa = 0.f; w.sb = 1.f; convert_w(F, w); }
        { WConv w = wconv(I.sgu_w_out, D, 2048, (bf16_t*)(wb + WB_SGU_OUT), D, 2048); convert_w(F, w); }
    } else {
        for (int part = 0; part < 3; ++part) {
            const int c0 = part == 0 ? 0 : (part == 1 ? 1024 : 2048), nr = part == 2 ? 2048 : 1024;
            WConv w = wconv(I.ret_w_in, 6144, D, (bf16_t*)(wb + WB_RET_QKV) + (size_t)c0 * D, nr, D); w.col0 = c0; w.kvec = I.mix_norm_g + 3 * D; w.sa = 0.f; w.sb = 1.f; w.cscale = part == 1 ? 0.0625f : 1.f; convert_w(F, w);
        }
        { WConv w = wconv(I.ret_w_in, 6144, D, (bf16_t*)(wb + WB_RET_G), 2048, D); w.col0 = 4096; w.kvec = I.mix_norm_g + 3 * D; w.sa = 0.f; w.sb = 1.f; convert_w(F, w); }
        { WConv w = wconv(I.ret_w_out, D, 2048, (bf16_t*)(wb + WB_RET_OUT), D, 2048); convert_w(F, w); }
    }
}

__device__ __forceinline__ void load_rows(const Frame& F, const float* src, float* X, bf16_t* Xb, i64* ssq_slot, int nrows) {
    const int lane = opaque_tid() & 63;
    for (int r0 = F.gw; r0 < nrows; r0 += 2 * F.NGW) {
        const int r1 = (r0 + F.NGW < nrows) ? r0 + F.NGW : r0;
        const f32x4* s0 = (const f32x4*)(src + (size_t)r0 * D) + lane; const f32x4* s1 = (const f32x4*)(src + (size_t)r1 * D) + lane;
        f32x4 v0[4], v1[4];
#pragma unroll
        for (int j = 0; j < 4; ++j) { v0[j] = s0[64 * j]; v1[j] = s1[64 * j]; }
        float ss0 = 0.f, ss1 = 0.f;
#pragma unroll
        for (int j = 0; j < 4; ++j) { ss0 += (v0[j][0] * v0[j][0] + v0[j][1] * v0[j][1]) + (v0[j][2] * v0[j][2] + v0[j][3] * v0[j][3]); ss1 += (v1[j][0] * v1[j][0] + v1[j][1] * v1[j][1]) + (v1[j][2] * v1[j][2] + v1[j][3] * v1[j][3]); }
        ss0 = wave_sum(ss0); ss1 = wave_sum(ss1);
        if (X) { f32x4* d0 = (f32x4*)(X + (size_t)r0 * D) + lane; f32x4* d1 = (f32x4*)(X + (size_t)r1 * D) + lane;
#pragma unroll
            for (int j = 0; j < 4; ++j) { d0[64 * j] = v0[j]; d1[64 * j] = v1[j]; } }
        u32x2* b0 = (u32x2*)(Xb + (size_t)r0 * D) + lane; u32x2* b1 = (u32x2*)(Xb + (size_t)r1 * D) + lane;
#pragma unroll
        for (int j = 0; j < 4; ++j) { u32x2 w; w.x = pk2(v0[j][0], v0[j][1]); w.y = pk2(v0[j][2], v0[j][3]); b0[64 * j] = w; w.x = pk2(v1[j][0], v1[j][1]); w.y = pk2(v1[j][2], v1[j][3]); b1[64 * j] = w; }
        if (lane == 0) { ssq_slot[r0] = (i64)(ss0 * SSQ_SCALE + 0.5f); ssq_slot[r1] = (i64)(ss1 * SSQ_SCALE + 0.5f); }
    }
}
__device__ __forceinline__ void load_mem_rows(const Frame& F, const float* src, bf16_t* mb, float* rstd, int nrows) {
    const int lane = opaque_tid() & 63;
    for (int r = F.gw; r < nrows; r += F.NGW) {
        const f32x4* s = (const f32x4*)(src + (size_t)r * D) + lane; f32x4 v[4]; float ss = 0.f;
#pragma unroll
        for (int j = 0; j < 4; ++j) { v[j] = s[64 * j]; ss += (v[j][0] * v[j][0] + v[j][1] * v[j][1]) + (v[j][2] * v[j][2] + v[j][3] * v[j][3]); }
        ss = wave_sum(ss);
        u32x2* db = (u32x2*)(mb + (size_t)r * D) + lane;
#pragma unroll
        for (int j = 0; j < 4; ++j) { u32x2 w; w.x = pk2(v[j][0], v[j][1]); w.y = pk2(v[j][2], v[j][3]); db[64 * j] = w; }
        if (lane == 0) rstd[r] = rsqrtf(ss * (1.0f / D) + 1e-6f);
    }
}
__device__ __forceinline__ void zero_i64(const Frame& F, i64* p, size_t n) {
    const int lane = opaque_tid() & 63;
    for (size_t i = (size_t)F.gw * 64 + lane; i < n; i += (size_t)F.NGW * 64) p[i] = 0;
}
__device__ __forceinline__ void final_norm(const Frame& F, const bf16_t* Xb, float* out, const i64* ssq_slot, const float* g, int nrows) {
    const int lane = opaque_tid() & 63;
    f32x4 gv[4];
#pragma unroll
    for (int j = 0; j < 4; ++j) gv[j] = ((const f32x4*)g)[lane + 64 * j];
    for (int r0 = F.gw; r0 < nrows; r0 += 2 * F.NGW) {
        const int r1 = (r0 + F.NGW < nrows) ? r0 + F.NGW : r0;
        const float rs0 = rstd_from_ssq(ssq_slot[r0], 1.0f / D, 1e-6f), rs1 = rstd_from_ssq(ssq_slot[r1], 1.0f / D, 1e-6f);
        const u32x2* s0 = (const u32x2*)(Xb + (size_t)r0 * D) + lane; const u32x2* s1 = (const u32x2*)(Xb + (size_t)r1 * D) + lane;
        u32x2 u0[4], u1[4];
#pragma unroll
        for (int j = 0; j < 4; ++j) { u0[j] = s0[64 * j]; u1[j] = s1[64 * j]; }
        f32x4* d0 = (f32x4*)(out + (size_t)r0 * D) + lane; f32x4* d1 = (f32x4*)(out + (size_t)r1 * D) + lane;
#pragma unroll
        for (int j = 0; j < 4; ++j) {
            d0[64 * j] = (f32x4){bf_lo(u0[j].x), bf_hi(u0[j].x), bf_lo(u0[j].y), bf_hi(u0[j].y)} * rs0 * gv[j];
            d1[64 * j] = (f32x4){bf_lo(u1[j].x), bf_hi(u1[j].x), bf_lo(u1[j].y), bf_hi(u1[j].y)} * rs1 * gv[j];
        }
    }
}
__device__ __forceinline__ void dump_rows(const Frame& F, const bf16_t* Xb, float* out, int nrows) {
    const int lane = opaque_tid() & 63;
    for (int r = F.gw; r < nrows; r += F.NGW) {
        const u32x2* s = (const u32x2*)(Xb + (size_t)r * D) + lane; f32x4* d = (f32x4*)(out + (size_t)r * D) + lane;
#pragma unroll
        for (int j = 0; j < 4; ++j) { const u32x2 u = s[64 * j]; d[64 * j] = (f32x4){bf_lo(u.x), bf_hi(u.x), bf_lo(u.y), bf_hi(u.y)}; }
    }
}
__device__ __forceinline__ void make_tables(const Frame& F, const Inputs& I) {
    const int lane = opaque_tid() & 63;
    f32x2* rope = (f32x2*)(F.ws + F.wm.rope);
    for (int i = F.gw * 64 + lane; i < T * 128; i += F.NGW * 64) { const int t = i >> 7, p = i & 127; const float ang = powf(10000.0f, -(float)p / 127.0f), th = (float)t * ang; rope[i] = (f32x2){cosf(th), sinf(th)}; }
    bf16_t* wt = (bf16_t*)(F.ws + F.wm.wstril);
    for (int i = F.gw * 64 + lane; i < 8 * 128 * 128; i += F.NGW * 64) { const int t = (i >> 7) & 127, s = i & 127; wt[i] = (s <= t) ? (bf16_t)(pk2(I.sgu_ws[i], 0.f) & 0xffffu) : (bf16_t)0; }
}
#define RW_BAR() do { asm volatile("s_waitcnt lgkmcnt(0)" ::: "memory"); __builtin_amdgcn_s_barrier(); asm volatile("" ::: "memory"); } while (0)
#ifndef AT_PROBE
#define AT_PROBE 0
#endif
#define AT_T(k) do { if (AT_PROBE) { const unsigned long long now_ = __builtin_amdgcn_s_memrealtime(); if (AT_PROBE == (k)) pr_acc += now_ - at_last; at_last = now_; } } while (0)
__device__ __forceinline__ void attn_phase(const Frame& F, bf16_t* Q, const bf16_t* Kall, const bf16_t* Vtall, int L, unsigned long long& pr_acc) {
    const int tid = opaque_tid(), lane = tid & 63, wave = F.wave;
    const int q = lane & 31, hh = lane >> 5;
    const int nunits = F.NB * 4 * (T / 256);
    const int ldv = F.NB * NMEM;
    LAS unsigned char* lds = F.lds;
    const int dpos = lane & 31, drow0 = 32 * wave + (lane >> 5);
    bf16x8 qn[4];
    if (F.vcu < nunits) { const int u = F.vcu, qb = u % (T / 256), h = (u / (T / 256)) % 4, b = u / (4 * (T / 256));
        const bf16_t* qr = Q + (size_t)(b * T + qb * 256 + wave * 32 + q) * D + h * 256;
#pragma unroll
        for (int j = 0; j < 4; ++j) qn[j] = *(const bf16x8*)(qr + 16 * j + 8 * hh); }
    for (int u = F.vcu; u < nunits; u += F.G) {
        const int qb = u % (T / 256), h = (u / (T / 256)) % 4, b = u / (4 * (T / 256));
        unsigned long long at_last = 0ull; if (AT_PROBE) at_last = __builtin_amdgcn_s_memrealtime();
        {
            const bf16_t* kg = Kall + ((size_t)((L * 4 + h) * F.NB + b) << 16);
#pragma unroll 4
            for (int i = 0; i < 16; ++i) { const int row = drow0 + 2 * i, ch = dpos ^ (row & 15);
                __builtin_amdgcn_global_load_lds((const unsigned*)(kg + row * 256 + ch * 8), (LAS unsigned*)(lds + (16 * wave + i) * 1024), 16, 0, 0); }
        }
        bf16_t* qrow = Q + (size_t)(b * T + qb * 256 + wave * 32 + q) * D + h * 256;
        bf16_t* obase = Q + (size_t)(b * T + qb * 256 + wave * 32) * D + h * 256;
        asm volatile("s_waitcnt vmcnt(0)" ::: "memory");
        __syncthreads();
        AT_T(1);
        f32x16 sacc[8];
#pragma unroll
        for (int kb = 0; kb < 8; ++kb)
#pragma unroll
            for (int i = 0; i < 16; ++i) sacc[kb][i] = 0.f;
#pragma unroll 1
        for (int s = 0; s < 16; s += 4) {
            bf16x8 qc[4];
#pragma unroll
            for (int j = 0; j < 4; ++j) qc[j] = qn[j];
            const int sn = (s + 4 < 16) ? s + 4 : 12;
#pragma unroll
            for (int j = 0; j < 4; ++j) qn[j] = *(const bf16x8*)(qrow + 16 * (sn + j) + 8 * hh);
            const int qm = q & 15;
#pragma unroll
            for (int j = 0; j < 4; ++j) {
                const int ko = ((2 * (s + j) + hh) ^ qm) << 4;
#pragma unroll
                for (int kb = 0; kb < 8; ++kb) {
                    const bf16x8 kf = *(const LAS bf16x8*)(lds + (32 * kb + q) * 512 + ko);
                    sacc[kb] = __builtin_amdgcn_mfma_f32_32x32x16_bf16(kf, qc[j], sacc[kb], 0, 0, 0);
                }
            }
        }
        AT_T(2);
        RW_BAR();
        {
            const bf16_t* vg = Vtall + ((size_t)((L * 4 + h) * F.NB + b) << 16);
#pragma unroll 4
            for (int i = 0; i < 16; ++i) { const int row = drow0 + 2 * i, ch = dpos ^ (row & 15);
                __builtin_amdgcn_global_load_lds((const unsigned*)(vg + row * 256 + ch * 8), (LAS unsigned*)(lds + (16 * wave + i) * 1024), 16, 0, 0); }
        }
        float mx = -3.0e38f;
#pragma unroll
        for (int kb = 0; kb < 8; ++kb)
#pragma unroll
            for (int i = 0; i < 16; ++i) mx = fmaxf(mx, sacc[kb][i]);
        mx = fmaxf(mx, __shfl_xor(mx, 32));
        float sum = 0.f;
        bf16x8 pf[8][2];
#pragma unroll
        for (int kb = 0; kb < 8; ++kb) {
            float p[16];
#pragma unroll
            for (int i = 0; i < 16; ++i) { p[i] = __builtin_amdgcn_exp2f(sacc[kb][i] - mx); sum += p[i]; }
#pragma unroll
            for (int s = 0; s < 2; ++s) { u32x4 w; w.x = pk2(p[8 * s + 0], p[8 * s + 1]); w.y = pk2(p[8 * s + 2], p[8 * s + 3]); w.z = pk2(p[8 * s + 4], p[8 * s + 5]); w.w = pk2(p[8 * s + 6], p[8 * s + 7]);
                pf[kb][s] = __builtin_bit_cast(bf16x8, w); }
        }
        sum += __shfl_xor(sum, 32);
        const float inv = 1.0f / sum;
        AT_T(3);
        asm volatile("s_waitcnt vmcnt(0)" ::: "memory");
        __syncthreads();
        AT_T(4);
        {
            const int un = (u + F.G < nunits) ? u + F.G : u, qbn = un % (T / 256), hn = (un / (T / 256)) % 4, bn = un / (4 * (T / 256));
            const bf16_t* qr = Q + (size_t)(bn * T + qbn * 256 + wave * 32 + q) * D + hn * 256;
#pragma unroll
            for (int j = 0; j < 4; ++j) qn[j] = *(const bf16x8*)(qr + 16 * j + 8 * hh);
        }
#pragma unroll
        for (int db = 0; db < 8; ++db) {
            f32x16 o;
#pragma unroll
            for (int i = 0; i < 16; ++i) o[i] = 0.f;
            int qm = q & 15; asm volatile("" : "+v"(qm));
            const LAS unsigned char* vrow = lds + (32 * db + q) * 512 + 8 * (hh ^ (q >> 4));
#pragma unroll
            for (int kb = 0; kb < 8; ++kb)
#pragma unroll
                for (int s = 0; s < 2; ++s) {
                    const int c0 = 4 * kb + 2 * s;
                    const int o0 = (c0 ^ qm) << 4;
                    const s16x4 lo = *(const LAS s16x4*)(vrow + o0), hi = *(const LAS s16x4*)(vrow + (o0 ^ 16));
                    const bf16x8 vf = __builtin_shufflevector(lo, hi, 0, 1, 2, 3, 4, 5, 6, 7);
                    o = __builtin_amdgcn_mfma_f32_32x32x16_bf16(vf, pf[kb][s], o, 0, 0, 0);
                }
            LAS unsigned char* stg = lds + 131072 + wave * 2048;
#pragma unroll
            for (int g = 0; g < 4; ++g) { u32x2 w; w.x = pk2(o[4 * g + 0] * inv, o[4 * g + 1] * inv); w.y = pk2(o[4 * g + 2] * inv, o[4 * g + 3] * inv);
                *(LAS u32x2*)(stg + q * 64 + ((g ^ ((q >> 1) & 3)) << 4) + 8 * hh) = w; }
#pragma unroll
            for (int i = 0; i < 2; ++i) { const int row = 16 * i + (lane >> 2), ch = lane & 3;
                const u32x4 v = *(const LAS u32x4*)(stg + row * 64 + ((ch ^ ((row >> 1) & 3)) << 4));
                *(u32x4*)(obase + (size_t)row * D + 32 * db + 8 * ch) = v; }
        }
        AT_T(5);
        RW_BAR();
        AT_T(6);
    }
}
#define RW_BAR() do { asm volatile("s_waitcnt lgkmcnt(0)" ::: "memory"); __builtin_amdgcn_s_barrier(); asm volatile("" ::: "memory"); } while (0)
__device__ __forceinline__ void conv_ln_phase(const Frame& F, const Inputs& I, const bf16_t* U, bf16_t* S) {
    int tid_ = threadIdx.x; asm volatile("" : "+v"(tid_));
    const int tid = tid_, lane = tid & 63, wave = F.wave;
    LAS float* red = (LAS float*)F.lds;
    const int c0 = 2 * tid;
    f32x2 wv[31];
#pragma unroll
    for (int j = 0; j < 31; ++j) wv[j] = *(const f32x2*)(I.conv_dw + j * D + c0);
    const f32x2 bias = *(const f32x2*)(I.conv_dw_b + c0), lg = *(const f32x2*)(I.conv_ln_g + c0), lb = *(const f32x2*)(I.conv_ln_b + c0);
    constexpr int UT = 128;
    const int nunits = F.NB * (T / UT);
    for (int u = F.vcu; u < nunits; u += F.G) {
        const int b = u / (T / UT), tc = (u % (T / UT)) * UT;
        const bf16_t* Ub = U + (size_t)b * T * D + c0;
        unsigned in[46];
#pragma unroll
        for (int s = 0; s < 46; ++s) { const int tt = tc - 30 + s; in[s] = *(const unsigned*)(Ub + (size_t)(tt > 0 ? tt : 0) * D); }
        if (tc == 0) {
#pragma unroll
            for (int s = 0; s < 30; ++s) in[s] = 0u;
        }
#pragma unroll 1
        for (int sb = 0; sb < UT / 16; ++sb) {
            const int t0 = tc + 16 * sb;
            unsigned nx[16];
#pragma unroll
            for (int s = 0; s < 16; ++s) { int tt = t0 + 16 + s; tt = tt < T ? tt : T - 1; nx[s] = *(const unsigned*)(Ub + (size_t)tt * D); }
            f32x2 av[16];
#pragma unroll
            for (int t = 0; t < 16; ++t) av[t] = bias;
#pragma unroll
            for (int s = 0; s < 46; ++s) {
                const f32x2 x = {bf_lo(in[s]), bf_hi(in[s])};
#pragma unroll
                for (int t = 0; t < 16; ++t) { const int j = s - t; if (j >= 0 && j <= 30) av[t] = __builtin_elementwise_fma(wv[j], x, av[t]); }
            }
            float a0[16], a1[16];
#pragma unroll
            for (int t = 0; t < 16; ++t) { a0[t] = av[t][0]; a1[t] = av[t][1]; }
#pragma unroll
            for (int t = 0; t < 16; ++t) {
                float s1 = a0[t] + a1[t], s2 = a0[t] * a0[t] + a1[t] * a1[t];
                s1 = wave_sum(s1); s2 = wave_sum(s2);
                if (lane == 0) { red[wave * 32 + t] = s1; red[wave * 32 + 16 + t] = s2; }
            }
            RW_BAR();
            if (tid < 32) { float s = 0.f;
#pragma unroll
                for (int w = 0; w < 8; ++w) s += red[w * 32 + tid];
                red[256 + tid] = s; }
            RW_BAR();
#pragma unroll
            for (int t = 0; t < 16; ++t) {
                const float mean = red[256 + t] * (1.0f / D), var = red[256 + 16 + t] * (1.0f / D) - mean * mean, rstd = rsqrtf(var + 1e-5f);
                const float y0 = (a0[t] - mean) * rstd * lg[0] + lb[0], y1 = (a1[t] - mean) * rstd * lg[1] + lb[1];
                *(unsigned*)(S + ((size_t)(b * T + t0 + t)) * D + c0) = pk2(fast_silu(y0), fast_silu(y1));
            }
#pragma unroll
            for (int s = 0; s < 30; ++s) in[s] = in[s + 16];
#pragma unroll
            for (int s = 0; s < 16; ++s) in[30 + s] = nx[s];
        }
    }
}
namespace pg8 {
__device__ __forceinline__ f32x2 gelu_pk(f32x2 v) {
    const f32x2 av = __builtin_elementwise_abs(v), d = av * 0.2316418882f + 1.0f;
    f32x2 t; t.x = __builtin_amdgcn_rcpf(d.x); t.y = __builtin_amdgcn_rcpf(d.y);
    f32x2 q = t * 0.5307027145f + (-0.7265760135f); q = q * t + 0.7107068705f; q = q * t + (-0.142248368f); q = q * t + 0.127414796f; q = q * t;
    const f32x2 s = (v * v) * (-0.72134752044f);
    f32x2 e; e.x = __builtin_amdgcn_exp2f(s.x); e.y = __builtin_amdgcn_exp2f(s.y);
    const f32x2 m = v * (q * e), r = v - m;
    f32x2 o; o.x = v.x < 0.f ? m.x : r.x; o.y = v.y < 0.f ? m.y : r.y; return o;
}
struct EpiGeluStats {
    static constexpr bool PERM = true;
    bf16_t* O; int ldc; const i64* ssq; const float* bias; i64* lns; int stat_pn0;
    __device__ __forceinline__ void operator()(const Acc& acc, const Unit& u, int wr, int wc, int fr, int fq) const {
        const int col0 = u.pn * BM + wc * 32 + 8 * fq;
        f32x4 bv[2][2];
#pragma unroll
        for (int bj = 0; bj < 2; ++bj) { bv[bj][0] = *(const f32x4*)(bias + col0 + bj * HALF); bv[bj][1] = *(const f32x4*)(bias + col0 + bj * HALF + 4); }
        const bool stats = u.pn >= stat_pn0;
#pragma unroll
        for (int ai = 0; ai < 2; ++ai)
#pragma unroll
            for (int m = 0; m < 4; ++m) {
                const int row = EPI_ROWS(u, wr, fr, ai, m);
                const float rs = rstd_from_ssq(ssq[row], 1.0f / 1024.0f, 1e-6f);
                bf16_t* rowp = O + (size_t)row * ldc + col0;
                float s1 = 0.f, s2 = 0.f;
#pragma unroll
                for (int bj = 0; bj < 2; ++bj) {
                    const f32x4 v0 = acc[ai][bj][m][0] * rs + bv[bj][0], v1 = acc[ai][bj][m][1] * rs + bv[bj][1];
                    const f32x2 a = gelu_pk((f32x2){v0[0], v0[1]}), b = gelu_pk((f32x2){v0[2], v0[3]}), c = gelu_pk((f32x2){v1[0], v1[1]}), d = gelu_pk((f32x2){v1[2], v1[3]});
                    u32x4 w; w.x = pk2(a.x, a.y); w.y = pk2(b.x, b.y); w.z = pk2(c.x, c.y); w.w = pk2(d.x, d.y);
                    *(u32x4*)(rowp + bj * HALF) = w;
                    s1 += ((a.x + a.y) + (b.x + b.y)) + ((c.x + c.y) + (d.x + d.y));
                    s2 += ((a.x * a.x + a.y * a.y) + (b.x * b.x + b.y * b.y)) + ((c.x * c.x + c.y * c.y) + (d.x * d.x + d.y * d.y));
                }
                if (stats) {
                    s1 += __shfl_xor(s1, 16); s1 += __shfl_xor(s1, 32); s2 += __shfl_xor(s2, 16); s2 += __shfl_xor(s2, 32);
                    if (fq == 0) { atomic_add_i64(lns + 2 * (size_t)row, (i64)(s1 * SSQ_SCALE)); atomic_add_i64(lns + 2 * (size_t)row + 1, (i64)(s2 * SSQ_SCALE + 0.5f)); }
                }
            }
    }
};
}

#ifndef RW_BAR
#define RW_BAR() do { asm volatile("s_waitcnt lgkmcnt(0)" ::: "memory"); __builtin_amdgcn_s_barrier(); asm volatile("" ::: "memory"); } while (0)
#endif
__device__ __forceinline__ void sgu_spatial_phase(const Frame& F, const Inputs& I, bf16_t* Z) {
    const int tid = opaque_tid(), lane = tid & 63, wave = F.wave, wr = wave >> 2, wc = wave & 3, fr = lane & 15, g4 = lane >> 4;
    const bf16_t* wt = (const bf16_t*)(F.ws + F.wm.wstril);
    LAS unsigned char* lds = F.lds;
    const unsigned lds_base = (unsigned)(size_t)lds;
    const int nunits = F.NB * 16 * 8;
    const int ech = tid & 31, rg = tid >> 5, e0 = 8 * ech;
    const unsigned tr_base = lds_base + (unsigned)((8 * g4 + (fr >> 2)) * 528 + (64 * wc + 4 * (fr & 3)) * 2);
    u32x4 pv[8]; i64 ps0 = 0, ps1 = 0;
    constexpr int STAT_OFF = 128 * 528;
    if (F.vcu < nunits) {
        const int c = F.vcu >> 3, g = F.vcu & 7, row0 = c * 128;
        ps0 = F.lns[2 * (size_t)(row0 + (tid & 127))]; ps1 = F.lns[2 * (size_t)(row0 + (tid & 127)) + 1];
#pragma unroll
        for (int i = 0; i < 8; ++i) { const int row = row0 + rg + 16 * i; pv[i] = *(const u32x4*)(Z + (size_t)row * 4096 + 2048 + g * 256 + e0); }
    }
    const bool ginv = (F.G & 7) == 0;
    f32x4 lg0 = *(const f32x4*)(I.sgu_ln_g + (F.vcu & 7) * 256 + e0), lg1 = *(const f32x4*)(I.sgu_ln_g + (F.vcu & 7) * 256 + e0 + 4);
    f32x4 lb0 = *(const f32x4*)(I.sgu_ln_b + (F.vcu & 7) * 256 + e0), lb1 = *(const f32x4*)(I.sgu_ln_b + (F.vcu & 7) * 256 + e0 + 4);
#define SGU_STATS() do { const float mean_ = (float)ps0 * SSQ_INV * (1.0f / 2048.0f), rstd_ = rsqrtf((float)ps1 * SSQ_INV * (1.0f / 2048.0f) - mean_ * mean_ + 1e-5f); \
        if (tid < 128) *(LAS f32x2*)(lds + STAT_OFF + tid * 8) = (f32x2){mean_, rstd_}; } while (0)
    SGU_STATS();
    RW_BAR();
    for (int u = F.vcu; u < nunits; u += F.G) {
        const int c = u >> 3, g = u & 7, row0 = c * 128;
        {
            if (!ginv) { lg0 = *(const f32x4*)(I.sgu_ln_g + g * 256 + e0); lg1 = *(const f32x4*)(I.sgu_ln_g + g * 256 + e0 + 4);
                         lb0 = *(const f32x4*)(I.sgu_ln_b + g * 256 + e0); lb1 = *(const f32x4*)(I.sgu_ln_b + g * 256 + e0 + 4); }
#pragma unroll
            for (int i = 0; i < 8; ++i) {
                const int s = rg + 16 * i; const u32x4 v = pv[i]; const f32x2 mr = *(const LAS f32x2*)(lds + STAT_OFF + s * 8); const float mean = mr[0], rstd = mr[1];
                f32x4 y0 = {bf_lo(v.x), bf_hi(v.x), bf_lo(v.y), bf_hi(v.y)}, y1 = {bf_lo(v.z), bf_hi(v.z), bf_lo(v.w), bf_hi(v.w)};
                y0 = (y0 - mean) * rstd * lg0 + lb0; y1 = (y1 - mean) * rstd * lg1 + lb1;
                u32x4 w; w.x = pk2(y0[0], y0[1]); w.y = pk2(y0[2], y0[3]); w.z = pk2(y1[0], y1[1]); w.w = pk2(y1[2], y1[3]);
                *(LAS u32x4*)(lds + s * 528 + e0 * 2) = w;
            }
        }
        RW_BAR();
        bf16x8 af[2][4];
#pragma unroll
        for (int ks = 0; ks < 2; ++ks)
#pragma unroll
            for (int mt = 0; mt < 4; ++mt) af[ks][mt] = *(const bf16x8*)(wt + (size_t)g * 16384 + (64 * wr + 16 * mt + fr) * 128 + 32 * ks + 8 * g4);
        float bsv[4];
#pragma unroll
        for (int mt = 0; mt < 4; ++mt) bsv[mt] = I.sgu_bs[g * 128 + 64 * wr + 16 * mt + fr];
        f32x4 acc[4][4];
#pragma unroll
        for (int mt = 0; mt < 4; ++mt)
#pragma unroll
            for (int nt = 0; nt < 4; ++nt) acc[mt][nt] = (f32x4){0.f, 0.f, 0.f, 0.f};
#define SGU_KSTEP(ks, afk) do { \
                s16x4 b0[4], b1[4]; \
                const unsigned ad = tr_base + (unsigned)(32 * (ks) * 528); \
                asm volatile("ds_read_b64_tr_b16 %0, %8\n\tds_read_b64_tr_b16 %1, %8 offset:2112\n\t" \
                             "ds_read_b64_tr_b16 %2, %8 offset:32\n\tds_read_b64_tr_b16 %3, %8 offset:2144\n\t" \
                             "ds_read_b64_tr_b16 %4, %8 offset:64\n\tds_read_b64_tr_b16 %5, %8 offset:2176\n\t" \
                             "ds_read_b64_tr_b16 %6, %8 offset:96\n\tds_read_b64_tr_b16 %7, %8 offset:2208\n\ts_waitcnt lgkmcnt(0)" \
                             : "=&v"(b0[0]), "=&v"(b1[0]), "=&v"(b0[1]), "=&v"(b1[1]), "=&v"(b0[2]), "=&v"(b1[2]), "=&v"(b0[3]), "=&v"(b1[3]) : "v"(ad) : "memory"); \
                _Pragma("unroll") for (int nt = 0; nt < 4; ++nt) { \
                    const bf16x8 bf = __builtin_shufflevector(b0[nt], b1[nt], 0, 1, 2, 3, 4, 5, 6, 7); \
                    _Pragma("unroll") for (int mt = 0; mt < 4; ++mt) acc[mt][nt] = __builtin_amdgcn_mfma_f32_16x16x32_bf16(bf, afk[mt], acc[mt][nt], 0, 0, 0); } } while (0)
        SGU_KSTEP(0, af[0]); SGU_KSTEP(1, af[1]);
#pragma unroll
        for (int ks = 0; ks < 2; ++ks)
#pragma unroll
            for (int mt = 0; mt < 4; ++mt) af[ks][mt] = *(const bf16x8*)(wt + (size_t)g * 16384 + (64 * wr + 16 * mt + fr) * 128 + 32 * (ks + 2) + 8 * g4);
        {
            const int un = (u + F.G < nunits) ? u + F.G : u; const int cn = un >> 3, gn = un & 7, rn0 = cn * 128;
            ps0 = F.lns[2 * (size_t)(rn0 + (tid & 127))]; ps1 = F.lns[2 * (size_t)(rn0 + (tid & 127)) + 1];
#pragma unroll
            for (int i = 0; i < 8; ++i) { const int row = rn0 + rg + 16 * i; pv[i] = *(const u32x4*)(Z + (size_t)row * 4096 + 2048 + gn * 256 + e0); }
        }
        SGU_KSTEP(2, af[0]); SGU_KSTEP(3, af[1]);
        u32x2 uu[4][4];
#pragma unroll
        for (int mt = 0; mt < 4; ++mt)
#pragma unroll
            for (int nt = 0; nt < 4; ++nt) uu[mt][nt] = *(const u32x2*)(Z + (size_t)(row0 + 64 * wr + 16 * mt + fr) * 4096 + g * 256 + 64 * wc + 4 * g4 + 16 * nt);
#pragma unroll
        for (int mt = 0; mt < 4; ++mt) {
            const int t = 64 * wr + 16 * mt + fr;
            bf16_t* zr = Z + (size_t)(row0 + t) * 4096 + g * 256 + 64 * wc + 4 * g4;
#pragma unroll
            for (int nt = 0; nt < 4; ++nt) {
                const u32x2 u2 = uu[mt][nt];
                u32x2 w; w.x = pk2((acc[mt][nt][0] + bsv[mt]) * bf_lo(u2.x), (acc[mt][nt][1] + bsv[mt]) * bf_hi(u2.x)); w.y = pk2((acc[mt][nt][2] + bsv[mt]) * bf_lo(u2.y), (acc[mt][nt][3] + bsv[mt]) * bf_hi(u2.y));
                *(u32x2*)(zr + 16 * nt) = w;
            }
        }
        SGU_STATS();
        RW_BAR();
    }
    __syncthreads();
}
namespace pg8 {
struct EpiRope {
    static constexpr bool PERM = true;
    bf16_t* O; int ldc; const i64* ssq; const f32x4* rope; int row_off, rope_pn;
    __device__ __forceinline__ void operator()(const Acc& acc, const Unit& u, int wr, int wc, int fr, int fq) const {
        const int col0 = u.pn * BM + wc * 32 + 8 * fq;
#pragma unroll
        for (int ai = 0; ai < 2; ++ai)
#pragma unroll
            for (int m = 0; m < 4; ++m) {
                const int row = EPI_ROWS(u, wr, fr, ai, m), rg = row + row_off, t = rg & (T - 1);
                const float rs = rstd_from_ssq(ssq[rg], 1.0f / 1024.0f, 1e-6f);
                bf16_t* rowp = O + (size_t)row * ldc + col0;
#pragma unroll
                for (int bj = 0; bj < 2; ++bj) {
                    const int p0 = 64 * bj + 16 * wc + 4 * fq;
                    const f32x4 v0 = acc[ai][bj][m][0] * rs, v1 = acc[ai][bj][m][1] * rs;
                    u32x4 w;
                    if (u.pn < rope_pn) {
                        const f32x4 cs01 = rope[(size_t)t * 64 + (p0 >> 1)], cs23 = rope[(size_t)t * 64 + (p0 >> 1) + 1];
                        w.x = pk2(v0[0] * cs01[0] - v0[1] * cs01[1], v0[1] * cs01[0] + v0[0] * cs01[1]);
                        w.y = pk2(v0[2] * cs01[2] - v0[3] * cs01[3], v0[3] * cs01[2] + v0[2] * cs01[3]);
                        w.z = pk2(v1[0] * cs23[0] - v1[1] * cs23[1], v1[1] * cs23[0] + v1[0] * cs23[1]);
                        w.w = pk2(v1[2] * cs23[2] - v1[3] * cs23[3], v1[3] * cs23[2] + v1[2] * cs23[3]);
                    } else { w.x = pk2(v0[0], v0[1]); w.y = pk2(v0[2], v0[3]); w.z = pk2(v1[0], v1[1]); w.w = pk2(v1[2], v1[3]); }
                    *(u32x4*)(rowp + bj * HALF) = w;
                }
            }
    }
};
struct EpiBf16ColRstd {
    static constexpr bool PERM = true;
    bf16_t* O; int ldc; const i64* ssq; int col_off;
    __device__ __forceinline__ void operator()(const Acc& acc, const Unit& u, int wr, int wc, int fr, int fq) const {
        const int col0 = u.pn * BM + wc * 32 + 8 * fq;
        float cs[2][8];
#pragma unroll
        for (int bj = 0; bj < 2; ++bj)
#pragma unroll
            for (int j = 0; j < 8; ++j) cs[bj][j] = rstd_from_ssq(ssq[col_off + col0 + bj * HALF + j], 1.0f / 1024.0f, 1e-6f);
#pragma unroll
        for (int ai = 0; ai < 2; ++ai)
#pragma unroll
            for (int m = 0; m < 4; ++m) {
                const int row = EPI_ROWS(u, wr, fr, ai, m);
                bf16_t* rowp = O + (size_t)row * ldc + col0;
#pragma unroll
                for (int bj = 0; bj < 2; ++bj) {
                    const f32x4 v0 = acc[ai][bj][m][0], v1 = acc[ai][bj][m][1];
                    u32x4 w; w.x = pk2(v0[0] * cs[bj][0], v0[1] * cs[bj][1]); w.y = pk2(v0[2] * cs[bj][2], v0[3] * cs[bj][3]); w.z = pk2(v1[0] * cs[bj][4], v1[1] * cs[bj][5]); w.w = pk2(v1[2] * cs[bj][6], v1[3] * cs[bj][7]);
                    *(u32x4*)(rowp + bj * HALF) = w;
                }
            }
    }
};
struct EpiRetGate {
    static constexpr bool PERM = true;
    bf16_t* O; int ldc; const i64* ssq; const i64* oss; int row_off;
    __device__ __forceinline__ void operator()(const Acc& acc, const Unit& u, int wr, int wc, int fr, int fq) const {
        const int col0 = u.pn * BM + wc * 32 + 8 * fq, head = u.pn >> 1;
#pragma unroll
        for (int ai = 0; ai < 2; ++ai)
#pragma unroll
            for (int m = 0; m < 4; ++m) {
                const int row = EPI_ROWS(u, wr, fr, ai, m), rg = row + row_off;
                const float rs = rstd_from_ssq(ssq[rg], 1.0f / 1024.0f, 1e-6f);
                const float ro = rstd_from_ssq(oss[(size_t)rg * 4 + head], 1.0f / 512.0f, 1e-6f);
                bf16_t* rowp = O + (size_t)row * ldc + col0;
#pragma unroll
                for (int bj = 0; bj < 2; ++bj) {
                    const u32x4 ov = *(const u32x4*)(rowp + bj * HALF);
                    const f32x4 g0 = acc[ai][bj][m][0] * rs, g1 = acc[ai][bj][m][1] * rs;
                    u32x4 w;
                    w.x = pk2(fast_silu(g0[0]) * bf_lo(ov.x) * ro, fast_silu(g0[1]) * bf_hi(ov.x) * ro);
                    w.y = pk2(fast_silu(g0[2]) * bf_lo(ov.y) * ro, fast_silu(g0[3]) * bf_hi(ov.y) * ro);
                    w.z = pk2(fast_silu(g1[0]) * bf_lo(ov.z) * ro, fast_silu(g1[1]) * bf_hi(ov.z) * ro);
                    w.w = pk2(fast_silu(g1[2]) * bf_lo(ov.w) * ro, fast_silu(g1[3]) * bf_hi(ov.w) * ro);
                    *(u32x4*)(rowp + bj * HALF) = w;
                }
            }
    }
};
}

#ifndef RW_BAR
#define RW_BAR() do { asm volatile("s_waitcnt lgkmcnt(0)" ::: "memory"); __builtin_amdgcn_s_barrier(); asm volatile("" ::: "memory"); } while (0)
#endif
__device__ __forceinline__ void ret_chunk_phase(const Frame& F, bf16_t* QKV, i64* oss, int nseq) {
    int tid_ = threadIdx.x; asm volatile("" : "+v"(tid_));
    const int tid = tid_, lane = tid & 63, w = F.wave, fr = lane & 15, g4 = lane >> 4;
    LAS unsigned char* lds = F.lds;
    constexpr int KIMG = 0, VIMG = 128 * 528, RIMG = VIMG + 128 * 144;
    const unsigned lds_base = (unsigned)(size_t)lds;
    const int nunits = nseq * 4 * 8, tl = 16 * w + fr;
    for (int u = F.vcu; u < nunits; u += F.G) {
        const int sl = u & 7, h = (u >> 3) & 3, b = u >> 5;
        const float lg2u = __builtin_amdgcn_logf(1.0f - __builtin_amdgcn_exp2f(-5.0f - (float)h));
        f32x4 R[2][4];
#pragma unroll
        for (int dt = 0; dt < 2; ++dt)
#pragma unroll
            for (int et = 0; et < 4; ++et) R[dt][et] = (f32x4){0.f, 0.f, 0.f, 0.f};
        for (int i = tid; i < 64 * 528 / 16; i += NTHREADS) *(LAS u32x4*)(lds + RIMG + i * 16) = (u32x4){0u, 0u, 0u, 0u};
        const float cdec = __builtin_amdgcn_exp2f(lg2u * 128.0f), qdec = __builtin_amdgcn_exp2f(lg2u * (float)(tl + 1));
        float gi[8];
#pragma unroll
        for (int j = 0; j < 8; ++j) gi[j] = __uint_as_float(__builtin_amdgcn_readfirstlane(__float_as_uint(__builtin_amdgcn_exp2f(-lg2u * (float)j))));
        const float gi16 = __uint_as_float(__builtin_amdgcn_readfirstlane(__float_as_uint(__builtin_amdgcn_exp2f(-lg2u * 16.0f))));
        u32x4 pk[8], pv[2];
#pragma unroll
        for (int i = 0; i < 8; ++i) { const int cid = tid + 512 * i, row = cid >> 5, ch = cid & 31; pk[i] = *(const u32x4*)(QKV + (size_t)(b * T + row) * 4096 + 1024 + h * 256 + ch * 8); }
#pragma unroll
        for (int i = 0; i < 2; ++i) { const int cid = tid + 512 * i, row = cid >> 3, ch = cid & 7; pv[i] = *(const u32x4*)(QKV + (size_t)(b * T + row) * 4096 + 2048 + h * 512 + 64 * sl + ch * 8); }
        bf16x8 qf[8];
#pragma unroll
        for (int kk = 0; kk < 8; ++kk) qf[kk] = *(const bf16x8*)(QKV + (size_t)(b * T + tl) * 4096 + h * 256 + 32 * kk + 8 * g4);
#pragma unroll 1
        for (int n = 0; n < 16; ++n) {
            const int row_base = b * T + n * 128;
            float lg2 = lg2u; asm volatile("" : "+v"(lg2));
#pragma unroll
            for (int i = 0; i < 8; ++i) { const int cid = tid + 512 * i, row = cid >> 5, ch = cid & 31; *(LAS u32x4*)(lds + KIMG + row * 528 + ch * 16) = pk[i]; }
#pragma unroll
            for (int i = 0; i < 2; ++i) { const int cid = tid + 512 * i, row = cid >> 3, ch = cid & 7; *(LAS u32x4*)(lds + VIMG + row * 144 + ch * 16) = pv[i]; }
            RW_BAR();
            {
                const int rbn = b * T + (n < 15 ? n + 1 : 15) * 128;
#pragma unroll
                for (int i = 0; i < 8; ++i) { const int cid = tid + 512 * i, row = cid >> 5, ch = cid & 31; pk[i] = *(const u32x4*)(QKV + (size_t)(rbn + row) * 4096 + 1024 + h * 256 + ch * 8); }
#pragma unroll
                for (int i = 0; i < 2; ++i) { const int cid = tid + 512 * i, row = cid >> 3, ch = cid & 7; pv[i] = *(const u32x4*)(QKV + (size_t)(rbn + row) * 4096 + 2048 + h * 512 + 64 * sl + ch * 8); }
            }
            bf16x8 pf[4];
#pragma unroll
            for (int kk2 = 0; kk2 < 4; ++kk2) {
                f32x4 X0 = {0.f, 0.f, 0.f, 0.f}, X1 = {0.f, 0.f, 0.f, 0.f};
                if (2 * kk2 <= w) {
                    bf16x8 kfr[8];
#pragma unroll
                    for (int kk = 0; kk < 8; ++kk) kfr[kk] = *(const LAS bf16x8*)(lds + KIMG + (32 * kk2 + fr) * 528 + (32 * kk + 8 * g4) * 2);
#pragma unroll
                    for (int kk = 0; kk < 8; ++kk) X0 = __builtin_amdgcn_mfma_f32_16x16x32_bf16(kfr[kk], qf[kk], X0, 0, 0, 0);
                    if (2 * kk2 + 1 <= w) {
#pragma unroll
                        for (int kk = 0; kk < 8; ++kk) kfr[kk] = *(const LAS bf16x8*)(lds + KIMG + (32 * kk2 + 16 + fr) * 528 + (32 * kk + 8 * g4) * 2);
#pragma unroll
                        for (int kk = 0; kk < 8; ++kk) X1 = __builtin_amdgcn_mfma_f32_16x16x32_bf16(kfr[kk], qf[kk], X1, 0, 0, 0);
                    }
                    const float e0 = __builtin_amdgcn_exp2f(lg2 * (float)(tl - 4 * g4 - 32 * kk2)), e1 = e0 * gi16;
#pragma unroll
                    for (int i = 0; i < 4; ++i) {
                        const int s0 = 32 * kk2 + 4 * g4 + i, s1 = s0 + 16;
                        X0[i] = (tl >= s0) ? X0[i] * (e0 * gi[i]) : 0.f;
                        X1[i] = (tl >= s1) ? X1[i] * (e1 * gi[i]) : 0.f;
                    }
                }
                u32x4 pw; pw.x = pk2(X0[0], X0[1]); pw.y = pk2(X0[2], X0[3]); pw.z = pk2(X1[0], X1[1]); pw.w = pk2(X1[2], X1[3]);
                pf[kk2] = __builtin_bit_cast(bf16x8, pw);
                __builtin_amdgcn_sched_barrier(0);
            }
            f32x4 oa[4];
#pragma unroll
            for (int et = 0; et < 4; ++et) {
                oa[et] = (f32x4){0.f, 0.f, 0.f, 0.f};
                bf16x8 rfr[8];
#pragma unroll
                for (int kk = 0; kk < 8; ++kk) rfr[kk] = *(const LAS bf16x8*)(lds + RIMG + (16 * et + fr) * 528 + (32 * kk + 8 * g4) * 2);
#pragma unroll
                for (int kk = 0; kk < 8; ++kk) oa[et] = __builtin_amdgcn_mfma_f32_16x16x32_bf16(rfr[kk], qf[kk], oa[et], 0, 0, 0);
                oa[et] *= qdec;
                __builtin_amdgcn_sched_barrier(0);
            }
#pragma unroll
            for (int kk2 = 0; kk2 < 4; ++kk2) {
                if (2 * kk2 <= w) {
                    s16x4 v0[4], v1[4];
                    const unsigned ad = lds_base + VIMG + (unsigned)((32 * kk2 + 4 * g4 + (fr >> 2)) * 144 + 8 * (fr & 3));
                    asm volatile("ds_read_b64_tr_b16 %0, %8 offset:0\n\tds_read_b64_tr_b16 %1, %8 offset:2304\n\tds_read_b64_tr_b16 %2, %8 offset:32\n\tds_read_b64_tr_b16 %3, %8 offset:2336\n\t"
                                 "ds_read_b64_tr_b16 %4, %8 offset:64\n\tds_read_b64_tr_b16 %5, %8 offset:2368\n\tds_read_b64_tr_b16 %6, %8 offset:96\n\tds_read_b64_tr_b16 %7, %8 offset:2400\n\ts_waitcnt lgkmcnt(0)"
                                 : "=&v"(v0[0]), "=&v"(v1[0]), "=&v"(v0[1]), "=&v"(v1[1]), "=&v"(v0[2]), "=&v"(v1[2]), "=&v"(v0[3]), "=&v"(v1[3]) : "v"(ad) : "memory");
#pragma unroll
                    for (int et = 0; et < 4; ++et) oa[et] = __builtin_amdgcn_mfma_f32_16x16x32_bf16(__builtin_shufflevector(v0[et], v1[et], 0, 1, 2, 3, 4, 5, 6, 7), pf[kk2], oa[et], 0, 0, 0);
                }
            }
            {
                float ss = 0.f;
                bf16_t* op = QKV + (size_t)(row_base + tl) * 4096 + 2048 + h * 512 + 64 * sl + 4 * g4;
#pragma unroll
                for (int et = 0; et < 4; ++et) {
                    u32x2 wv; wv.x = pk2(oa[et][0], oa[et][1]); wv.y = pk2(oa[et][2], oa[et][3]);
                    *(u32x2*)(op + 16 * et) = wv;
                    ss += (oa[et][0] * oa[et][0] + oa[et][1] * oa[et][1]) + (oa[et][2] * oa[et][2] + oa[et][3] * oa[et][3]);
                }
                ss += __shfl_xor(ss, 16); ss += __shfl_xor(ss, 32);
                if (g4 == 0) atomic_add_i64(oss + (size_t)(row_base + tl) * 4 + h, (i64)(ss * SSQ_SCALE + 0.5f));
            }
            __builtin_amdgcn_sched_barrier(0);
            {
                const int rbq = b * T + (n < 15 ? n + 1 : 15) * 128;
#pragma unroll
                for (int kk = 0; kk < 8; ++kk) qf[kk] = *(const bf16x8*)(QKV + (size_t)(rbq + tl) * 4096 + h * 256 + 32 * kk + 8 * g4);
            }
            __builtin_amdgcn_sched_barrier(0);
            bf16x8 kt[2][4];
            {
                s16x4 r0[2][4], r1[2][4];
                const unsigned ad = lds_base + KIMG + (unsigned)((8 * g4 + (fr >> 2)) * 528 + (32 * w + 4 * (fr & 3)) * 2);
                asm volatile(
                    "ds_read_b64_tr_b16 %0, %16 offset:0\n\tds_read_b64_tr_b16 %1, %16 offset:2112\n\t"
                    "ds_read_b64_tr_b16 %2, %16 offset:16896\n\tds_read_b64_tr_b16 %3, %16 offset:19008\n\t"
                    "ds_read_b64_tr_b16 %4, %16 offset:33792\n\tds_read_b64_tr_b16 %5, %16 offset:35904\n\t"
                    "ds_read_b64_tr_b16 %6, %16 offset:50688\n\tds_read_b64_tr_b16 %7, %16 offset:52800\n\t"
                    "ds_read_b64_tr_b16 %8, %16 offset:32\n\tds_read_b64_tr_b16 %9, %16 offset:2144\n\t"
                    "ds_read_b64_tr_b16 %10, %16 offset:16928\n\tds_read_b64_tr_b16 %11, %16 offset:19040\n\t"
                    "ds_read_b64_tr_b16 %12, %16 offset:33824\n\tds_read_b64_tr_b16 %13, %16 offset:35936\n\t"
                    "ds_read_b64_tr_b16 %14, %16 offset:50720\n\tds_read_b64_tr_b16 %15, %16 offset:52832\n\ts_waitcnt lgkmcnt(0)"
                    : "=&v"(r0[0][0]), "=&v"(r1[0][0]), "=&v"(r0[0][1]), "=&v"(r1[0][1]), "=&v"(r0[0][2]), "=&v"(r1[0][2]), "=&v"(r0[0][3]), "=&v"(r1[0][3]),
                      "=&v"(r0[1][0]), "=&v"(r1[1][0]), "=&v"(r0[1][1]), "=&v"(r1[1][1]), "=&v"(r0[1][2]), "=&v"(r1[1][2]), "=&v"(r0[1][3]), "=&v"(r1[1][3])
                    : "v"(ad) : "memory");
#pragma unroll
                for (int kk2 = 0; kk2 < 4; ++kk2) {
                    float f[8];
                    const float fb = __builtin_amdgcn_exp2f(lg2 * (float)(127 - 32 * kk2 - 8 * g4));
#pragma unroll
                    for (int j = 0; j < 8; ++j) f[j] = fb * gi[j];
#pragma unroll
                    for (int dt = 0; dt < 2; ++dt) {
                        const u32x2 a = __builtin_bit_cast(u32x2, r0[dt][kk2]), c = __builtin_bit_cast(u32x2, r1[dt][kk2]);
                        u32x4 o; o.x = pk2(bf_lo(a.x) * f[0], bf_hi(a.x) * f[1]); o.y = pk2(bf_lo(a.y) * f[2], bf_hi(a.y) * f[3]);
                        o.z = pk2(bf_lo(c.x) * f[4], bf_hi(c.x) * f[5]); o.w = pk2(bf_lo(c.y) * f[6], bf_hi(c.y) * f[7]);
                        kt[dt][kk2] = __builtin_bit_cast(bf16x8, o);
                    }
                }
            }
#pragma unroll
            for (int dt = 0; dt < 2; ++dt)
#pragma unroll
                for (int et = 0; et < 4; ++et) R[dt][et] *= cdec;
#pragma unroll
            for (int kk2 = 0; kk2 < 4; ++kk2) {
                s16x4 v0[4], v1[4];
                const unsigned ad = lds_base + VIMG + (unsigned)((32 * kk2 + 8 * g4 + (fr >> 2)) * 144 + 8 * (fr & 3));
                asm volatile("ds_read_b64_tr_b16 %0, %8 offset:0\n\tds_read_b64_tr_b16 %1, %8 offset:576\n\tds_read_b64_tr_b16 %2, %8 offset:32\n\tds_read_b64_tr_b16 %3, %8 offset:608\n\t"
                             "ds_read_b64_tr_b16 %4, %8 offset:64\n\tds_read_b64_tr_b16 %5, %8 offset:640\n\tds_read_b64_tr_b16 %6, %8 offset:96\n\tds_read_b64_tr_b16 %7, %8 offset:672\n\ts_waitcnt lgkmcnt(0)"
                             : "=&v"(v0[0]), "=&v"(v1[0]), "=&v"(v0[1]), "=&v"(v1[1]), "=&v"(v0[2]), "=&v"(v1[2]), "=&v"(v0[3]), "=&v"(v1[3]) : "v"(ad) : "memory");
#pragma unroll
                for (int et = 0; et < 4; ++et) {
                    const bf16x8 vf = __builtin_shufflevector(v0[et], v1[et], 0, 1, 2, 3, 4, 5, 6, 7);
#pragma unroll
                    for (int dt = 0; dt < 2; ++dt) R[dt][et] = __builtin_amdgcn_mfma_f32_16x16x32_bf16(kt[dt][kk2], vf, R[dt][et], 0, 0, 0);
                }
            }
            RW_BAR();
#pragma unroll
            for (int dt = 0; dt < 2; ++dt)
#pragma unroll
                for (int et = 0; et < 4; ++et) { u32x2 wv; wv.x = pk2(R[dt][et][0], R[dt][et][1]); wv.y = pk2(R[dt][et][2], R[dt][et][3]);
                    *(LAS u32x2*)(lds + RIMG + (16 * et + fr) * 528 + (32 * w + 16 * dt + 4 * g4) * 2) = wv; }
        }
        __syncthreads();
    }
}
namespace pg8 {
struct EpiLora1 {
    static constexpr bool PERM = true;
    bf16_t* O; int ldc;
    __device__ __forceinline__ void operator()(const Acc& acc, const Unit& u, int wr, int wc, int fr, int fq) const {
        const int col0 = u.pn * BM + wc * 32 + 8 * fq;
#pragma unroll
        for (int ai = 0; ai < 2; ++ai)
#pragma unroll
            for (int m = 0; m < 4; ++m) {
                const int row = EPI_ROWS(u, wr, fr, ai, m);
                bf16_t* rowp = O + (size_t)row * ldc + col0;
#pragma unroll
                for (int bj = 0; bj < 2; ++bj) {
                    const int grp = (u.pn * BM + bj * HALF + wc * 32) >> 5;
                    float v[8];
#pragma unroll
                    for (int j = 0; j < 4; ++j) { v[j] = acc[ai][bj][m][0][j]; v[4 + j] = acc[ai][bj][m][1][j]; }
                    if (grp < 2) {
#pragma unroll
                        for (int j = 0; j < 8; ++j) { const float x = fminf(fmaxf(v[j], -10.f), 10.f), e = __builtin_amdgcn_exp2f(2.8853900817779268f * x); v[j] = (e - 1.0f) * __builtin_amdgcn_rcpf(e + 1.0f); }
                    } else if (grp >= 4 && grp < 9) {
#pragma unroll
                        for (int j = 0; j < 8; ++j) v[j] = fast_sigmoid(v[j]);
                    }
                    u32x4 w; w.x = pk2(v[0], v[1]); w.y = pk2(v[2], v[3]); w.z = pk2(v[4], v[5]); w.w = pk2(v[6], v[7]);
                    *(u32x4*)(rowp + bj * HALF) = w;
                }
            }
    }
};
template <int MODE> struct EpiRwkvAct {
    static constexpr bool PERM = true;
    bf16_t* O; int ldc; const float* c0;
    __device__ __forceinline__ void operator()(const Acc& acc, const Unit& u, int wr, int wc, int fr, int fq) const {
        const int col0 = u.pn * BM + wc * 32 + 8 * fq;
        f32x4 cv[2][2];
#pragma unroll
        for (int bj = 0; bj < 2; ++bj) { cv[bj][0] = *(const f32x4*)(c0 + col0 + bj * HALF); cv[bj][1] = *(const f32x4*)(c0 + col0 + bj * HALF + 4); }
#pragma unroll
        for (int ai = 0; ai < 2; ++ai)
#pragma unroll
            for (int m = 0; m < 4; ++m) {
                const int row = EPI_ROWS(u, wr, fr, ai, m);
                bf16_t* rowp = O + (size_t)row * ldc + col0;
#pragma unroll
                for (int bj = 0; bj < 2; ++bj) {
                    float v[8];
#pragma unroll
                    for (int j = 0; j < 4; ++j) { v[j] = acc[ai][bj][m][0][j] + cv[bj][0][j]; v[4 + j] = acc[ai][bj][m][1][j] + cv[bj][1][j]; }
#pragma unroll
                    for (int j = 0; j < 8; ++j) {
                        if (MODE == 0) { const float xw = -v[j];
                            const float sp = xw > 20.f ? xw : 0.6931471805599453f * __builtin_amdgcn_logf(1.0f + __builtin_amdgcn_exp2f(1.4426950408889634f * xw));
                            v[j] = -1.4426950408889634f * __builtin_amdgcn_exp2f(1.4426950408889634f * (-sp - 0.5f)); }
                        else v[j] = fast_sigmoid(v[j]);
                    }
                    u32x4 w; w.x = pk2(v[0], v[1]); w.y = pk2(v[2], v[3]); w.z = pk2(v[4], v[5]); w.w = pk2(v[6], v[7]);
                    *(u32x4*)(rowp + bj * HALF) = w;
                }
            }
    }
};
}

__device__ __forceinline__ void unpack8(const u32x4 u, float* o) { o[0] = bf_lo(u.x); o[1] = bf_hi(u.x); o[2] = bf_lo(u.y); o[3] = bf_hi(u.y); o[4] = bf_lo(u.z); o[5] = bf_hi(u.z); o[6] = bf_lo(u.w); o[7] = bf_hi(u.w); }
__device__ __forceinline__ u32x4 pack8(const float* v) { u32x4 w; w.x = pk2(v[0], v[1]); w.y = pk2(v[2], v[3]); w.z = pk2(v[4], v[5]); w.w = pk2(v[6], v[7]); return w; }
__device__ __forceinline__ void rwkv_mix_phase(const Frame& F, const Inputs& I, const bf16_t* X, const i64* ssq, int rb, int Mh, bf16_t* hn_pad, bf16_t* xs  ) {
    const int lane = opaque_tid() & 63;
    f32x4 g[4], mr[4], mk[4], mv[4];
#pragma unroll
    for (int j = 0; j < 4; ++j) { g[j] = ((const f32x4*)I.mix_norm_g)[256 + lane + 64 * j]; mr[j] = ((const f32x4*)I.rwkv_mix)[lane + 64 * j]; mk[j] = ((const f32x4*)I.rwkv_mix)[512 + lane + 64 * j]; mv[j] = ((const f32x4*)I.rwkv_mix)[768 + lane + 64 * j]; }
    for (int r = F.gw; r < Mh; r += F.NGW) {
        const int rg = rb + r, t = r & (T - 1);
        const float rs = rstd_from_ssq(ssq[rg], 1.0f / D, 1e-6f), rp = t ? rstd_from_ssq(ssq[rg - 1], 1.0f / D, 1e-6f) : 0.f;
        const u32x2* xr = (const u32x2*)(X + (size_t)rg * D) + lane; const u32x2* xp = (const u32x2*)(X + (size_t)(t ? rg - 1 : rg) * D) + lane;
        const size_t prow = (size_t)r + (r >> 11) + 1;
        u32x2* hp = (u32x2*)(hn_pad + prow * D) + lane;
        u32x2* o0 = (u32x2*)(xs + (size_t)r * D) + lane; u32x2* o1 = (u32x2*)(xs + ((size_t)Mh + r) * D) + lane; u32x2* o2 = (u32x2*)(xs + (2 * (size_t)Mh + r) * D) + lane;
#pragma unroll
        for (int j = 0; j < 4; ++j) {
            const u32x2 ur = xr[64 * j], up = xp[64 * j];
            const f32x4 h = (f32x4){bf_lo(ur.x), bf_hi(ur.x), bf_lo(ur.y), bf_hi(ur.y)} * rs * g[j], p = (f32x4){bf_lo(up.x), bf_hi(up.x), bf_lo(up.y), bf_hi(up.y)} * rp * g[j], d = p - h;
            u32x2 w; w.x = pk2(h[0], h[1]); w.y = pk2(h[2], h[3]); hp[64 * j] = w;
            const f32x4 a = h + d * mr[j], b = h + d * mk[j], c = h + d * mv[j];
            w.x = pk2(a[0], a[1]); w.y = pk2(a[2], a[3]); o0[64 * j] = w;
            w.x = pk2(b[0], b[1]); w.y = pk2(b[2], b[3]); o1[64 * j] = w;
            w.x = pk2(c[0], c[1]); w.y = pk2(c[2], c[3]); o2[64 * j] = w;
            if (t == 0) (hp - 256)[64 * j] = (u32x2){0u, 0u};
        }
    }
}

__device__ __forceinline__ void rwkv_scan_phase(const Frame& F, const Inputs& I, const bf16_t* rr, const bf16_t* kk_, const bf16_t* vv, const bf16_t* wraw, const bf16_t* araw, bf16_t* y, int nseq) {
    const int tid = opaque_tid(), lane = tid & 63, w = F.wave, r4 = lane >> 4, cg = lane & 15;
    LAS unsigned char* lds = F.lds;
    constexpr int TS = 32, VEC = TS * 64 * 4, BUF = 5 * VEC + TS * 32 * 4 + TS * 32 * 4;
    const int nitems = nseq * 32;
    const int pt = tid >> 4, pj = 4 * (tid & 15);
    for (int it = F.vcu; it < nitems; it += F.G) {
        const int rh = it & 1, h = (it >> 1) & 15, b = it >> 5;
        const int ch = h * 64;
        const f32x4 w0 = *(const f32x4*)(I.rwkv_w0 + ch + pj), a0 = *(const f32x4*)(I.rwkv_a0 + ch + pj), kkc = *(const f32x4*)(I.rwkv_k_k + ch + pj), kac = *(const f32x4*)(I.rwkv_k_a + ch + pj);
        f32x4 S = {0.f, 0.f, 0.f, 0.f};
        u32x2 nr, nk, nw, na; unsigned nv = 0u;
        {   const size_t o = (size_t)(b * T + pt) * D + ch + pj;
            nr = *(const u32x2*)(rr + o); nk = *(const u32x2*)(kk_ + o); nw = *(const u32x2*)(wraw + o); na = *(const u32x2*)(araw + o);
            nv = *(const unsigned*)(vv + (size_t)(b * T + pt) * D + ch + 32 * rh + 2 * (tid & 15)); }
#pragma unroll 1
        for (int blk = 0; blk < T / TS; ++blk) {
            LAS unsigned char* bufp = lds + (blk & 1) * BUF;
            {
                const f32x4 kr = {bf_lo(nk.x), bf_hi(nk.x), bf_lo(nk.y), bf_hi(nk.y)}, rv = {bf_lo(nr.x), bf_hi(nr.x), bf_lo(nr.y), bf_hi(nr.y)};
                const f32x4 wr_ = {bf_lo(nw.x), bf_hi(nw.x), bf_lo(nw.y), bf_hi(nw.y)}, ar = {bf_lo(na.x), bf_hi(na.x), bf_lo(na.y), bf_hi(na.y)};
                f32x4 dec, av, kkv, km;
                const f32x4 kq = kr * kkc;
                float n2 = (kq[0] * kq[0] + kq[1] * kq[1]) + (kq[2] * kq[2] + kq[3] * kq[3]);
                n2 = dpp_sum16(n2);
                const float inv = 1.0f / fmaxf(sqrtf(n2), 1e-12f);
#pragma unroll
                for (int c = 0; c < 4; ++c) {
                    const float xw = -(w0[c] + wr_[c]);
                    const float sp = xw > 20.f ? xw : 0.6931471805599453f * __builtin_amdgcn_logf(1.0f + __builtin_amdgcn_exp2f(1.4426950408889634f * xw));
                    const float ww = -sp - 0.5f;
                    dec[c] = __builtin_amdgcn_exp2f(-1.4426950408889634f * __builtin_amdgcn_exp2f(1.4426950408889634f * ww));
                    av[c] = fast_sigmoid(a0[c] + ar[c]);
                    kkv[c] = kq[c] * inv;
                    km[c] = kr[c] * (1.0f + (av[c] - 1.0f) * kac[c]);
                }
                *(LAS f32x4*)(bufp + 0 * VEC + (pt * 64 + pj) * 4) = -kkv;
                *(LAS f32x4*)(bufp + 1 * VEC + (pt * 64 + pj) * 4) = dec;
                *(LAS f32x4*)(bufp + 2 * VEC + (pt * 64 + pj) * 4) = kkv * av;
                *(LAS f32x4*)(bufp + 3 * VEC + (pt * 64 + pj) * 4) = km;
                *(LAS f32x4*)(bufp + 4 * VEC + (pt * 64 + pj) * 4) = rv;
                *(LAS f32x2*)(bufp + 5 * VEC + (pt * 32 + 2 * (tid & 15)) * 4) = (f32x2){bf_lo(nv), bf_hi(nv)};
            }
            __syncthreads();
            if (blk > 0) {
                const LAS unsigned char* pb = lds + ((blk - 1) & 1) * BUF + 5 * VEC + TS * 32 * 4;
                const f32x2 yv = *(const LAS f32x2*)(pb + (pt * 32 + 2 * (tid & 15)) * 4);
                *(unsigned*)(y + (size_t)(b * T + (blk - 1) * TS + pt) * D + ch + 32 * rh + 2 * (tid & 15)) = pk2(yv[0], yv[1]);
            }
            if (blk + 1 < T / TS) {
                const size_t o = (size_t)(b * T + (blk + 1) * TS + pt) * D + ch + pj;
                nr = *(const u32x2*)(rr + o); nk = *(const u32x2*)(kk_ + o); nw = *(const u32x2*)(wraw + o); na = *(const u32x2*)(araw + o);
                nv = *(const unsigned*)(vv + (size_t)(b * T + (blk + 1) * TS + pt) * D + ch + 32 * rh + 2 * (tid & 15));
            }
            const LAS unsigned char* va = bufp + 16 * cg;
            LAS float* yb = (LAS float*)(bufp + 5 * VEC + TS * 32 * 4);
#pragma unroll 4
            for (int s = 0; s < TS; ++s) {
                const f32x4 ah = *(const LAS f32x4*)(va + 0 * VEC + s * 256), wd = *(const LAS f32x4*)(va + 1 * VEC + s * 256), bb = *(const LAS f32x4*)(va + 2 * VEC + s * 256);
                const f32x4 kv = *(const LAS f32x4*)(va + 3 * VEC + s * 256), rv = *(const LAS f32x4*)(va + 4 * VEC + s * 256);
                const float vi = *(const LAS float*)(bufp + 5 * VEC + (s * 32 + 4 * w + r4) * 4);
                float sa = (S[0] * ah[0] + S[1] * ah[1]) + (S[2] * ah[2] + S[3] * ah[3]);
                sa = dpp_sum16(sa);
                S = S * wd + sa * bb + vi * kv;
                float yv = (S[0] * rv[0] + S[1] * rv[1]) + (S[2] * rv[2] + S[3] * rv[3]);
                yv = dpp_sum16(yv);
                if (cg == 0) yb[s * 32 + 4 * w + r4] = yv;
            }
        }
        __syncthreads();
        {
            const LAS unsigned char* pb = lds + ((T / TS - 1) & 1) * BUF + 5 * VEC + TS * 32 * 4;
            const f32x2 yv = *(const LAS f32x2*)(pb + (pt * 32 + 2 * (tid & 15)) * 4);
            *(unsigned*)(y + (size_t)(b * T + (T / TS - 1) * TS + pt) * D + ch + 32 * rh + 2 * (tid & 15)) = pk2(yv[0], yv[1]);
        }
        __syncthreads();
    }
}
__device__ __forceinline__ float dpp_sum8(float v) {
    v += __int_as_float(__builtin_amdgcn_update_dpp(0, __float_as_int(v), 0xB1, 0xF, 0xF, true));
    v += __int_as_float(__builtin_amdgcn_update_dpp(0, __float_as_int(v), 0x4E, 0xF, 0xF, true));
    v += __int_as_float(__builtin_amdgcn_update_dpp(0, __float_as_int(v), 0x141, 0xF, 0xF, true));
    return v;
}
__device__ __forceinline__ void rwkv_post_phase(const Frame& F, const Inputs& I, const bf16_t* y, const bf16_t* rr, const bf16_t* kk_, const bf16_t* vv, const bf16_t* araw, const bf16_t* gg, bf16_t* out, int Mh) {
    const int lane = opaque_tid() & 63;
    const int ntask = Mh * 2;
    for (int task = F.gw; task < ntask; task += F.NGW) {
        const int row = task >> 1, c0 = (task & 1) * 512 + 8 * lane; const size_t o = (size_t)row * D + c0;
        const u32x4 yu = *(const u32x4*)(y + o), ru = *(const u32x4*)(rr + o), ku = *(const u32x4*)(kk_ + o), vu = *(const u32x4*)(vv + o), au = *(const u32x4*)(araw + o), gu = *(const u32x4*)(gg + o);
        float yv[8], rv[8], kv[8], v8[8], av[8], gv[8], kac[8], rk[8], gg8[8], gb8[8];
        unpack8(yu, yv); unpack8(ru, rv); unpack8(ku, kv); unpack8(vu, v8); unpack8(au, av); unpack8(gu, gv);
#pragma unroll
        for (int e4 = 0; e4 < 2; ++e4) { const f32x4 a = *(const f32x4*)(I.rwkv_k_a + c0 + 4 * e4), b = *(const f32x4*)(I.rwkv_r_k + c0 + 4 * e4), c = *(const f32x4*)(I.rwkv_gn_g + c0 + 4 * e4), d = *(const f32x4*)(I.rwkv_gn_b + c0 + 4 * e4);
#pragma unroll
            for (int e = 0; e < 4; ++e) { kac[4 * e4 + e] = a[e]; rk[4 * e4 + e] = b[e]; gg8[4 * e4 + e] = c[e]; gb8[4 * e4 + e] = d[e]; } }
        float s1 = 0.f;
#pragma unroll
        for (int e = 0; e < 8; ++e) s1 += yv[e];
        const float mean = dpp_sum8(s1) * (1.0f / 64.0f);
        float s2 = 0.f, s3 = 0.f;
#pragma unroll
        for (int e = 0; e < 8; ++e) { const float d = yv[e] - mean; yv[e] = d; s2 = fmaf(d, d, s2); s3 = fmaf(rv[e] * rk[e], kv[e] * (1.0f + (av[e] - 1.0f) * kac[e]), s3); }
        const float rstd = rsqrtf(dpp_sum8(s2) * (1.0f / 64.0f) + 64e-5f), bonus = dpp_sum8(s3);
        float res[8];
#pragma unroll
        for (int e = 0; e < 8; ++e) res[e] = (yv[e] * rstd * gg8[e] + gb8[e] + bonus * v8[e]) * gv[e];
        *(u32x4*)(out + o) = pack8(res);
    }
}
#define MF16(a, b, c) __builtin_amdgcn_mfma_f32_16x16x32_bf16((a), (b), (c), 0, 0, 0)
#define WAVE_SYNC() asm volatile("s_waitcnt lgkmcnt(0)" ::: "memory")
__device__ __forceinline__ bf16x8 frag_lo(const f32x4 x) { u32x4 w; w.x = pk2(x[0], x[1]); w.y = pk2(x[2], x[3]); w.z = 0u; w.w = 0u; return __builtin_bit_cast(bf16x8, w); }
__device__ __forceinline__ bf16x8 frag_pair(const f32x4 lo, const f32x4 hi) { u32x4 w; w.x = pk2(lo[0], lo[1]); w.y = pk2(lo[2], lo[3]); w.z = pk2(hi[0], hi[1]); w.w = pk2(hi[2], hi[3]); return __builtin_bit_cast(bf16x8, w); }

__device__ __forceinline__ void rwkv_chunk_phase(const Frame& F, const Inputs& I, const bf16_t* rr, const bf16_t* kk_, const bf16_t* vv, const bf16_t* ldp, const bf16_t* ap, bf16_t* y, int nseq) {
    const int tid = opaque_tid(), lane = tid & 63, w = F.wave, fr = lane & 15, g = lane >> 4;
    if (w >= 2) return;
    constexpr int IMG_A = 0, IMG_B = 2304, IMG_K = 4608, IMG_R = 6912, IMG_S = 9216, IMG_V = 11520, SCR = 12288, WLO = 16640, WAVE_LDS = 17408;
    LAS unsigned char* L = F.lds + w * WAVE_LDS;
    const unsigned Lb = (unsigned)(size_t)L;
    const int tq = lane >> 2, jq = lane & 3;
    const int nitems = nseq * 64;
    const f32x4 zero4 = {0.f, 0.f, 0.f, 0.f};
    for (int item = 2 * F.vcu + w; item < nitems; item += 2 * F.G) {
        const int it = item & 3, h = (item >> 2) & 15, b = item >> 6, ch = h * 64, i0 = 16 * it;
        float kkc[16], kac[16];
#pragma unroll
        for (int c = 0; c < 16; ++c) { kkc[c] = I.rwkv_k_k[ch + 16 * jq + c]; kac[c] = I.rwkv_k_a[ch + 16 * jq + c]; }
        f32x4 Sm[4] = {zero4, zero4, zero4, zero4};
        for (int i = lane; i < 2304 / 16; i += 64) *(LAS u32x4*)(L + IMG_S + i * 16) = (u32x4){0u, 0u, 0u, 0u};
        u32x4 nk[2], na[2], nl[2], nr[2]; u32x2 nv;
        {   const size_t o = (size_t)(b * T + tq) * D + ch + 16 * jq;
            nk[0] = *(const u32x4*)(kk_ + o); nk[1] = *(const u32x4*)(kk_ + o + 8); na[0] = *(const u32x4*)(ap + o); na[1] = *(const u32x4*)(ap + o + 8);
            nl[0] = *(const u32x4*)(ldp + o); nl[1] = *(const u32x4*)(ldp + o + 8); nr[0] = *(const u32x4*)(rr + o); nr[1] = *(const u32x4*)(rr + o + 8);
            nv = *(const u32x2*)(vv + (size_t)(b * T + tq) * D + ch + i0 + 4 * jq); }
#pragma unroll 1
        for (int n = 0; n < T / 16; ++n) {
            const int row0 = b * T + 16 * n;
            float kf[16], af[16], rf[16];
            {
                float lf[16];
                unpack8(nl[0], lf); unpack8(nl[1], lf + 8); unpack8(nk[0], kf); unpack8(nk[1], kf + 8); unpack8(na[0], af); unpack8(na[1], af + 8); unpack8(nr[0], rf); unpack8(nr[1], rf + 8);
#pragma unroll
                for (int c = 0; c < 4; ++c) *(LAS f32x4*)(L + SCR + tq * 272 + (16 * jq + 4 * c) * 4) = (f32x4){lf[4 * c], lf[4 * c + 1], lf[4 * c + 2], lf[4 * c + 3]};
                *(LAS bf16_t*)(L + IMG_V + (4 * jq + 0) * 48 + tq * 2) = (bf16_t)(nv.x & 0xffffu); *(LAS bf16_t*)(L + IMG_V + (4 * jq + 1) * 48 + tq * 2) = (bf16_t)(nv.x >> 16);
                *(LAS bf16_t*)(L + IMG_V + (4 * jq + 2) * 48 + tq * 2) = (bf16_t)(nv.y & 0xffffu); *(LAS bf16_t*)(L + IMG_V + (4 * jq + 3) * 48 + tq * 2) = (bf16_t)(nv.y >> 16);
            }
            if (n + 1 < T / 16) {
                const size_t o = (size_t)(row0 + 16 + tq) * D + ch + 16 * jq;
                nk[0] = *(const u32x4*)(kk_ + o); nk[1] = *(const u32x4*)(kk_ + o + 8); na[0] = *(const u32x4*)(ap + o); na[1] = *(const u32x4*)(ap + o + 8);
                nl[0] = *(const u32x4*)(ldp + o); nl[1] = *(const u32x4*)(ldp + o + 8); nr[0] = *(const u32x4*)(rr + o); nr[1] = *(const u32x4*)(rr + o + 8);
                nv = *(const u32x2*)(vv + (size_t)(row0 + 16 + tq) * D + ch + i0 + 4 * jq);
            }
            WAVE_SYNC();
            {
                float cs = 0.f;
#pragma unroll
                for (int t = 0; t < 16; ++t) { cs += *(const LAS float*)(L + SCR + t * 272 + lane * 4); *(LAS float*)(L + SCR + t * 272 + lane * 4) = cs; }
                *(LAS float*)(L + WLO + lane * 4) = __builtin_amdgcn_exp2f(cs);
            }
            WAVE_SYNC();
            {
                float kq[16], n2 = 0.f;
#pragma unroll
                for (int c = 0; c < 16; ++c) { kq[c] = kf[c] * kkc[c]; n2 = fmaf(kq[c], kq[c], n2); }
                n2 += __int_as_float(__builtin_amdgcn_update_dpp(0, __float_as_int(n2), 0xB1, 0xF, 0xF, true));
                n2 += __int_as_float(__builtin_amdgcn_update_dpp(0, __float_as_int(n2), 0x4E, 0xF, 0xF, true));
                const float inv = 1.0f / fmaxf(sqrtf(n2), 1e-12f);
#pragma unroll
                for (int hh = 0; hh < 2; ++hh) {
                    float ci[8], cp[8], oa[8], ob[8], ok[8], orr[8];
#pragma unroll
                    for (int c = 0; c < 2; ++c) { const f32x4 x = *(const LAS f32x4*)(L + SCR + tq * 272 + (16 * jq + 8 * hh + 4 * c) * 4);
                        const f32x4 p = tq ? *(const LAS f32x4*)(L + SCR + (tq - 1) * 272 + (16 * jq + 8 * hh + 4 * c) * 4) : zero4;
#pragma unroll
                        for (int e = 0; e < 4; ++e) { ci[4 * c + e] = x[e]; cp[4 * c + e] = p[e]; } }
#pragma unroll
                    for (int c = 0; c < 8; ++c) {
                        const int cc = 8 * hh + c;
                        const float Wt = __builtin_amdgcn_exp2f(ci[c]), Wi = __builtin_amdgcn_exp2f(-ci[c]), Wp = __builtin_amdgcn_exp2f(cp[c]);
                        const float kkv = kq[cc] * inv, av = af[cc];
                        oa[c] = -kkv * Wp; ob[c] = kkv * av * Wi; ok[c] = kf[cc] * (1.0f + (av - 1.0f) * kac[cc]) * Wi; orr[c] = rf[cc] * Wt;
                    }
                    const int off = tq * 144 + (16 * jq + 8 * hh) * 2;
                    *(LAS u32x4*)(L + IMG_A + off) = pack8(oa); *(LAS u32x4*)(L + IMG_B + off) = pack8(ob); *(LAS u32x4*)(L + IMG_K + off) = pack8(ok); *(LAS u32x4*)(L + IMG_R + off) = pack8(orr);
                }
            }
            WAVE_SYNC();
            bf16x8 fa[2], fb[2], fk[2], fq[2], fs[2];
#pragma unroll
            for (int ks = 0; ks < 2; ++ks) { const int off = fr * 144 + (32 * ks + 8 * g) * 2;
                fa[ks] = *(const LAS bf16x8*)(L + IMG_A + off); fb[ks] = *(const LAS bf16x8*)(L + IMG_B + off); fk[ks] = *(const LAS bf16x8*)(L + IMG_K + off);
                fq[ks] = *(const LAS bf16x8*)(L + IMG_R + off); fs[ks] = *(const LAS bf16x8*)(L + IMG_S + off); }
            f32x4 N = MF16(fb[0], fa[0], zero4); N = MF16(fb[1], fa[1], N);
            f32x4 NT = MF16(fa[0], fb[0], zero4); NT = MF16(fa[1], fb[1], NT);
            f32x4 Mk = MF16(fk[0], fa[0], zero4); Mk = MF16(fk[1], fa[1], Mk);
            f32x4 Tb = MF16(fb[0], fq[0], zero4); Tb = MF16(fb[1], fq[1], Tb);
            f32x4 Tk = MF16(fk[0], fq[0], zero4); Tk = MF16(fk[1], fq[1], Tk);
            f32x4 P, PT;
#pragma unroll
            for (int e = 0; e < 4; ++e) { const int rw = 4 * g + e;
                N[e] = (rw < fr) ? N[e] : 0.f; Mk[e] = (rw < fr) ? Mk[e] : 0.f; NT[e] = (fr < rw) ? NT[e] : 0.f;
                Tb[e] = (rw <= fr) ? Tb[e] : 0.f; Tk[e] = (rw <= fr) ? Tk[e] : 0.f;
                P[e] = N[e] + ((rw == fr) ? 1.0f : 0.f); PT[e] = NT[e] + ((rw == fr) ? 1.0f : 0.f); }
            {
                f32x4 X = N, XT = NT;
#pragma unroll
                for (int lv = 0; lv < 3; ++lv) {
                    const bf16x8 xf = frag_lo(X), xtf = frag_lo(XT);
                    const f32x4 X2 = MF16(xtf, xf, zero4);
                    f32x4 X2T = zero4; if (lv < 2) X2T = MF16(xf, xtf, zero4);
                    const bf16x8 x2f = frag_lo(X2), ptf = frag_lo(PT);
                    P = MF16(ptf, x2f, P);
                    if (lv < 2) PT = MF16(x2f, ptf, PT);
                    X = X2; XT = X2T;
                }
            }
            const s16x4 v4 = *(const LAS s16x4*)(L + IMG_V + fr * 48 + 8 * g);
            const s16x4 z4 = {0, 0, 0, 0};
            f32x4 GT = MF16(fa[0], fs[0], zero4); GT = MF16(fa[1], fs[1], GT);
            GT = MF16(frag_lo(Mk), __builtin_shufflevector(v4, z4, 0, 1, 2, 3, 4, 5, 6, 7), GT);
            const f32x4 UT = MF16(frag_lo(P), frag_lo(GT), zero4);
            u32x4 auw; auw.x = pk2(UT[0], UT[1]); auw.y = pk2(UT[2], UT[3]); { const u32x2 vv2 = __builtin_bit_cast(u32x2, v4); auw.z = vv2.x; auw.w = vv2.y; }
            const bf16x8 auv = __builtin_bit_cast(bf16x8, auw);
            f32x4 Y = MF16(fs[0], fq[0], zero4); Y = MF16(fs[1], fq[1], Y);
            Y = MF16(auv, frag_pair(Tb, Tk), Y);
            { u32x2 wv; wv.x = pk2(Y[0], Y[1]); wv.y = pk2(Y[2], Y[3]); *(u32x2*)(y + (size_t)(row0 + fr) * D + ch + i0 + 4 * g) = wv; }
            {
                s16x4 tb[4], tk[4];
                const unsigned ad = Lb + IMG_B + (unsigned)((4 * g + (fr >> 2)) * 144 + 8 * (fr & 3));
                asm volatile("ds_read_b64_tr_b16 %0, %8 offset:0\n\tds_read_b64_tr_b16 %1, %8 offset:32\n\tds_read_b64_tr_b16 %2, %8 offset:64\n\tds_read_b64_tr_b16 %3, %8 offset:96\n\t"
                             "ds_read_b64_tr_b16 %4, %8 offset:2304\n\tds_read_b64_tr_b16 %5, %8 offset:2336\n\tds_read_b64_tr_b16 %6, %8 offset:2368\n\tds_read_b64_tr_b16 %7, %8 offset:2400\n\ts_waitcnt lgkmcnt(0)"
                             : "=&v"(tb[0]), "=&v"(tb[1]), "=&v"(tb[2]), "=&v"(tb[3]), "=&v"(tk[0]), "=&v"(tk[1]), "=&v"(tk[2]), "=&v"(tk[3]) : "v"(ad) : "memory");
#pragma unroll
                for (int jt = 0; jt < 4; ++jt) {
                    Sm[jt] = MF16(auv, __builtin_shufflevector(tb[jt], tk[jt], 0, 1, 2, 3, 4, 5, 6, 7), Sm[jt]);
                    Sm[jt] *= *(const LAS float*)(L + WLO + (16 * jt + fr) * 4);
#pragma unroll
                    for (int e = 0; e < 4; ++e) *(LAS bf16_t*)(L + IMG_S + (4 * g + e) * 144 + (16 * jt + fr) * 2) = (bf16_t)(pk2(Sm[jt][e], 0.f) & 0xffffu);
                }
            }
            WAVE_SYNC();
        }
    }
}

#ifndef RW_BAR
#define RW_BAR() do { asm volatile("s_waitcnt lgkmcnt(0)" ::: "memory"); __builtin_amdgcn_s_barrier(); asm volatile("" ::: "memory"); } while (0)
#endif
__device__ __forceinline__ void rwkv_chunk_pipe_phase(const Frame& F, const Inputs& I, const bf16_t* rr, const bf16_t* kk_, const bf16_t* vv, const bf16_t* ldp, const bf16_t* ap, bf16_t* y, int nseq, unsigned long long& pr_acc) {
#ifndef RWS
#define RWS (-1)
#endif
#define RWS_T0(k) unsigned long long rws_t0 = 0ull; if (RWS == (k)) rws_t0 = __builtin_amdgcn_s_memrealtime()
#define RWS_T1(k) do { if (RWS == (k)) { asm volatile("s_waitcnt lgkmcnt(0)" ::: "memory"); pr_acc += __builtin_amdgcn_s_memrealtime() - rws_t0; } } while (0)
    const int tid = opaque_tid(), lane = tid & 63, w = F.wave, fr = lane & 15, g = lane >> 4;
    const int q = w >> 2, st = (w + q) & 3;
    constexpr int SCRSZ = 2 * 4352, SCR0 = 0, WL0 = 2 * SCRSZ, IMG0 = WL0 + 1024, IMGSZ = 9984, SM0 = IMG0 + 3 * IMGSZ, IMGS = SM0 + 8192, KC0 = IMGS + 2304, SLOT = KC0 + 512;
    constexpr int IA = 0, IB = 2304, IK = 4608, IR = 6912, IV = 9216;
    LAS unsigned char* L = F.lds + q * SLOT;
    const unsigned Lb = (unsigned)(size_t)L;
    const int tq = lane >> 2, jq = lane & 3;
    const int nitems = nseq * 64, NCH = T / 16;
    const f32x4 zero4 = {0.f, 0.f, 0.f, 0.f};
    const int trips = (nitems - 2 * F.vcu + 2 * F.G - 1) / (2 * F.G);
    for (int trip = 0; trip < trips; ++trip) {
        const int item = 2 * F.vcu + q + trip * 2 * F.G;
        const int it = item & 3, h = (item >> 2) & 15, b = item >> 6, ch = h * 64, i0 = 16 * it;
        const size_t gbase = (size_t)(b * T + tq) * D + ch + 16 * jq;
        if (st == 0) {
            u32x4 p0[2], p1[2];
            p0[0] = *(const u32x4*)(ldp + gbase); p0[1] = *(const u32x4*)(ldp + gbase + 8);
            p1[0] = *(const u32x4*)(ldp + gbase + (size_t)16 * D); p1[1] = *(const u32x4*)(ldp + gbase + (size_t)16 * D + 8);
#pragma unroll 1
            for (int c0 = 0; c0 < NCH; c0 += 2) {
#pragma unroll
                for (int sub = 0; sub < 2; ++sub) {
                    const int c = c0 + sub;
                    RWS_T0(0);
                    LAS unsigned char* scr = L + SCR0 + (c & 1) * SCRSZ;
                    float lf[16]; if (sub == 0) { unpack8(p0[0], lf); unpack8(p0[1], lf + 8); } else { unpack8(p1[0], lf); unpack8(p1[1], lf + 8); }
                    { const int cn = (c + 2 < NCH) ? c + 2 : NCH - 1; const size_t o = gbase + (size_t)cn * 16 * D;
                      if (sub == 0) { p0[0] = *(const u32x4*)(ldp + o); p0[1] = *(const u32x4*)(ldp + o + 8); } else { p1[0] = *(const u32x4*)(ldp + o); p1[1] = *(const u32x4*)(ldp + o + 8); } }
#pragma unroll
                    for (int e = 0; e < 4; ++e) *(LAS f32x4*)(scr + tq * 272 + (16 * jq + 4 * e) * 4) = (f32x4){lf[4 * e], lf[4 * e + 1], lf[4 * e + 2], lf[4 * e + 3]};
                    WAVE_SYNC();
                    float lcol[16], cs = 0.f, wt = 1.f;
#pragma unroll
                    for (int t = 0; t < 16; ++t) lcol[t] = *(const LAS float*)(scr + t * 272 + lane * 4);
#pragma unroll
                    for (int t = 0; t < 16; ++t) { cs += lcol[t]; wt = __builtin_amdgcn_exp2f(cs);
                        *(LAS float*)(scr + t * 272 + lane * 4) = wt; *(LAS float*)(scr + 4352 + t * 272 + lane * 4) = __builtin_amdgcn_exp2f(-cs); }
                    *(LAS float*)(L + WL0 + (c & 3) * 256 + lane * 4) = wt;
                    RWS_T1(0);
                    RW_BAR();
                }
            }
            RW_BAR(); RW_BAR(); RW_BAR(); RW_BAR();
        } else if (st == 1) {
            *(LAS float*)(L + KC0 + lane * 4) = I.rwkv_k_k[ch + lane]; *(LAS float*)(L + KC0 + 256 + lane * 4) = I.rwkv_k_a[ch + lane];
            const size_t vbase = (size_t)(b * T + tq) * D + ch + i0 + 4 * jq;
            u32x4 k0[2], a0[2], r0[2], k1[2], a1[2], r1[2]; u32x2 v0, v1;
            k0[0] = *(const u32x4*)(kk_ + gbase); k0[1] = *(const u32x4*)(kk_ + gbase + 8); a0[0] = *(const u32x4*)(ap + gbase); a0[1] = *(const u32x4*)(ap + gbase + 8);
            r0[0] = *(const u32x4*)(rr + gbase); r0[1] = *(const u32x4*)(rr + gbase + 8); v0 = *(const u32x2*)(vv + vbase);
            { const size_t o = gbase + (size_t)16 * D;
              k1[0] = *(const u32x4*)(kk_ + o); k1[1] = *(const u32x4*)(kk_ + o + 8); a1[0] = *(const u32x4*)(ap + o); a1[1] = *(const u32x4*)(ap + o + 8);
              r1[0] = *(const u32x4*)(rr + o); r1[1] = *(const u32x4*)(rr + o + 8); v1 = *(const u32x2*)(vv + vbase + (size_t)16 * D); }
            RW_BAR();
#pragma unroll 1
            for (int c0 = 0; c0 < NCH; c0 += 2) {
#pragma unroll
                for (int sub = 0; sub < 2; ++sub) {
                    const int c = c0 + sub;
                    RWS_T0(1);
                    const LAS unsigned char* scr = L + SCR0 + (c & 1) * SCRSZ;
                    LAS unsigned char* img = L + IMG0 + (c % 3) * IMGSZ;
                    u32x4 ck[2], ca[2], cr[2]; u32x2 cv;
                    if (sub == 0) { ck[0] = k0[0]; ck[1] = k0[1]; ca[0] = a0[0]; ca[1] = a0[1]; cr[0] = r0[0]; cr[1] = r0[1]; cv = v0; }
                    else { ck[0] = k1[0]; ck[1] = k1[1]; ca[0] = a1[0]; ca[1] = a1[1]; cr[0] = r1[0]; cr[1] = r1[1]; cv = v1; }
                    { const int cn = (c + 2 < NCH) ? c + 2 : NCH - 1; const size_t o = gbase + (size_t)cn * 16 * D, ov = vbase + (size_t)cn * 16 * D;
                      if (sub == 0) { k0[0] = *(const u32x4*)(kk_ + o); k0[1] = *(const u32x4*)(kk_ + o + 8); a0[0] = *(const u32x4*)(ap + o); a0[1] = *(const u32x4*)(ap + o + 8); r0[0] = *(const u32x4*)(rr + o); r0[1] = *(const u32x4*)(rr + o + 8); v0 = *(const u32x2*)(vv + ov); }
                      else { k1[0] = *(const u32x4*)(kk_ + o); k1[1] = *(const u32x4*)(kk_ + o + 8); a1[0] = *(const u32x4*)(ap + o); a1[1] = *(const u32x4*)(ap + o + 8); r1[0] = *(const u32x4*)(rr + o); r1[1] = *(const u32x4*)(rr + o + 8); v1 = *(const u32x2*)(vv + ov); } }
                    *(LAS bf16_t*)(img + IV + (4 * jq + 0) * 48 + tq * 2) = (bf16_t)(cv.x & 0xffffu); *(LAS bf16_t*)(img + IV + (4 * jq + 1) * 48 + tq * 2) = (bf16_t)(cv.x >> 16);
                    *(LAS bf16_t*)(img + IV + (4 * jq + 2) * 48 + tq * 2) = (bf16_t)(cv.y & 0xffffu); *(LAS bf16_t*)(img + IV + (4 * jq + 3) * 48 + tq * 2) = (bf16_t)(cv.y >> 16);
                    float n2 = 0.f;
#pragma unroll
                    for (int hh = 0; hh < 2; ++hh) { float kf[8]; unpack8(ck[hh], kf);
#pragma unroll
                        for (int e4 = 0; e4 < 2; ++e4) { const f32x4 kc = *(const LAS f32x4*)(L + KC0 + (16 * jq + 8 * hh + 4 * e4) * 4);
#pragma unroll
                            for (int e = 0; e < 4; ++e) { const float x = kf[4 * e4 + e] * kc[e]; n2 = fmaf(x, x, n2); } } }
                    n2 += __int_as_float(__builtin_amdgcn_update_dpp(0, __float_as_int(n2), 0xB1, 0xF, 0xF, true));
                    n2 += __int_as_float(__builtin_amdgcn_update_dpp(0, __float_as_int(n2), 0x4E, 0xF, 0xF, true));
                    const float inv = 1.0f / fmaxf(sqrtf(n2), 1e-12f);
#pragma unroll
                    for (int hh = 0; hh < 2; ++hh) {
                        float kf[8], af[8], rf[8], kac[8], kkc8[8], ci[8], cp[8], oa[8], ob[8], ok[8], orr[8];
                        unpack8(ck[hh], kf); unpack8(ca[hh], af); unpack8(cr[hh], rf);
#pragma unroll
                        for (int e2 = 0; e2 < 2; ++e2) { const int so = (16 * jq + 8 * hh + 4 * e2) * 4;
                            const f32x4 x = *(const LAS f32x4*)(scr + tq * 272 + so), xi = *(const LAS f32x4*)(scr + 4352 + tq * 272 + so);
                            const f32x4 p = tq ? *(const LAS f32x4*)(scr + (tq - 1) * 272 + so) : (f32x4){1.f, 1.f, 1.f, 1.f};
                            const f32x4 ka = *(const LAS f32x4*)(L + KC0 + 256 + so), kc = *(const LAS f32x4*)(L + KC0 + so);
#pragma unroll
                            for (int e = 0; e < 4; ++e) { ci[4 * e2 + e] = x[e]; cp[4 * e2 + e] = p[e]; oa[4 * e2 + e] = xi[e]; kac[4 * e2 + e] = ka[e]; kkc8[4 * e2 + e] = kc[e]; } }
#pragma unroll
                        for (int e = 0; e < 8; ++e) {
                            const float Wt = ci[e], Wi = oa[e], Wp = cp[e];
                            const float kkv = kf[e] * kkc8[e] * inv, av = af[e];
                            oa[e] = -kkv * Wp; ob[e] = kkv * av * Wi; ok[e] = kf[e] * (1.0f + (av - 1.0f) * kac[e]) * Wi; orr[e] = rf[e] * Wt;
                        }
                        const int off = tq * 144 + (16 * jq + 8 * hh) * 2;
                        *(LAS u32x4*)(img + IA + off) = pack8(oa); *(LAS u32x4*)(img + IB + off) = pack8(ob); *(LAS u32x4*)(img + IK + off) = pack8(ok); *(LAS u32x4*)(img + IR + off) = pack8(orr);
                    }
                    RWS_T1(1);
                    RW_BAR();
                }
            }
            RW_BAR(); RW_BAR(); RW_BAR();
        } else if (st == 2) {
            RW_BAR(); RW_BAR();
#pragma unroll 1
            for (int c = 0; c < NCH; ++c) {
                RWS_T0(2);
                const LAS unsigned char* img = L + IMG0 + (c % 3) * IMGSZ;
                LAS unsigned char* sm = L + SM0 + (c & 1) * 4096;
                bf16x8 fa[2], fb[2], fk[2], fq[2];
#pragma unroll
                for (int ks = 0; ks < 2; ++ks) { const int off = fr * 144 + (32 * ks + 8 * g) * 2;
                    fa[ks] = *(const LAS bf16x8*)(img + IA + off); fb[ks] = *(const LAS bf16x8*)(img + IB + off); fk[ks] = *(const LAS bf16x8*)(img + IK + off); fq[ks] = *(const LAS bf16x8*)(img + IR + off); }
                f32x4 N = MF16(fb[0], fa[0], zero4); N = MF16(fb[1], fa[1], N);
                f32x4 NT = MF16(fa[0], fb[0], zero4); NT = MF16(fa[1], fb[1], NT);
                f32x4 Mk = MF16(fk[0], fa[0], zero4); Mk = MF16(fk[1], fa[1], Mk);
                f32x4 Tb = MF16(fb[0], fq[0], zero4); Tb = MF16(fb[1], fq[1], Tb);
                f32x4 Tk = MF16(fk[0], fq[0], zero4); Tk = MF16(fk[1], fq[1], Tk);
                f32x4 P, PT;
#pragma unroll
                for (int e = 0; e < 4; ++e) { const int rw = 4 * g + e;
                    N[e] = (rw < fr) ? N[e] : 0.f; Mk[e] = (rw < fr) ? Mk[e] : 0.f; NT[e] = (fr < rw) ? NT[e] : 0.f;
                    Tb[e] = (rw <= fr) ? Tb[e] : 0.f; Tk[e] = (rw <= fr) ? Tk[e] : 0.f;
                    P[e] = N[e] + ((rw == fr) ? 1.0f : 0.f); PT[e] = NT[e] + ((rw == fr) ? 1.0f : 0.f); }
                f32x4 X = N, XT = NT;
#pragma unroll
                for (int lv = 0; lv < 3; ++lv) {
                    const bf16x8 xf = frag_lo(X), xtf = frag_lo(XT);
                    const f32x4 X2 = MF16(xtf, xf, zero4);
                    f32x4 X2T = zero4; if (lv < 2) X2T = MF16(xf, xtf, zero4);
                    const bf16x8 x2f = frag_lo(X2), ptf = frag_lo(PT);
                    P = MF16(ptf, x2f, P);
                    if (lv < 2) PT = MF16(x2f, ptf, PT);
                    X = X2; XT = X2T;
                }
                *(LAS f32x4*)(sm + 0 * 1024 + lane * 16) = Mk; *(LAS f32x4*)(sm + 1 * 1024 + lane * 16) = Tb; *(LAS f32x4*)(sm + 2 * 1024 + lane * 16) = Tk; *(LAS f32x4*)(sm + 3 * 1024 + lane * 16) = P;
                RWS_T1(2);
                RW_BAR();
            }
            RW_BAR(); RW_BAR();
        } else {
            f32x4 Sm[4] = {zero4, zero4, zero4, zero4};
            for (int i = lane; i < 2304 / 16; i += 64) *(LAS u32x4*)(L + IMGS + i * 16) = (u32x4){0u, 0u, 0u, 0u};
            RW_BAR(); RW_BAR(); RW_BAR();
#pragma unroll 1
            for (int c = 0; c < NCH; ++c) {
                RWS_T0(3);
                const int row0 = b * T + 16 * c;
                const LAS unsigned char* img = L + IMG0 + (c % 3) * IMGSZ;
                const LAS unsigned char* sm = L + SM0 + (c & 1) * 4096;
                bf16x8 fa[2], fq[2], fs[2];
#pragma unroll
                for (int ks = 0; ks < 2; ++ks) { const int off = fr * 144 + (32 * ks + 8 * g) * 2;
                    fa[ks] = *(const LAS bf16x8*)(img + IA + off); fq[ks] = *(const LAS bf16x8*)(img + IR + off); fs[ks] = *(const LAS bf16x8*)(L + IMGS + off); }
                const f32x4 Mk = *(const LAS f32x4*)(sm + 0 * 1024 + lane * 16), Tb = *(const LAS f32x4*)(sm + 1 * 1024 + lane * 16), Tk = *(const LAS f32x4*)(sm + 2 * 1024 + lane * 16), P = *(const LAS f32x4*)(sm + 3 * 1024 + lane * 16);
                const s16x4 v4 = *(const LAS s16x4*)(img + IV + fr * 48 + 8 * g);
                const s16x4 z4 = {0, 0, 0, 0};
                f32x4 GT = MF16(fa[0], fs[0], zero4); GT = MF16(fa[1], fs[1], GT);
                GT = MF16(frag_lo(Mk), __builtin_shufflevector(v4, z4, 0, 1, 2, 3, 4, 5, 6, 7), GT);
                const f32x4 UT = MF16(frag_lo(P), frag_lo(GT), zero4);
                u32x4 auw; auw.x = pk2(UT[0], UT[1]); auw.y = pk2(UT[2], UT[3]); { const u32x2 vv2 = __builtin_bit_cast(u32x2, v4); auw.z = vv2.x; auw.w = vv2.y; }
                const bf16x8 auv = __builtin_bit_cast(bf16x8, auw);
                f32x4 Y = MF16(fs[0], fq[0], zero4); Y = MF16(fs[1], fq[1], Y);
                Y = MF16(auv, frag_pair(Tb, Tk), Y);
                { u32x2 wv; wv.x = pk2(Y[0], Y[1]); wv.y = pk2(Y[2], Y[3]); *(u32x2*)(y + (size_t)(row0 + fr) * D + ch + i0 + 4 * g) = wv; }
                s16x4 tb[4], tk[4];
                const unsigned ad = Lb + IMG0 + (unsigned)((c % 3) * IMGSZ) + IB + (unsigned)((4 * g + (fr >> 2)) * 144 + 8 * (fr & 3));
                asm volatile("ds_read_b64_tr_b16 %0, %8 offset:0\n\tds_read_b64_tr_b16 %1, %8 offset:32\n\tds_read_b64_tr_b16 %2, %8 offset:64\n\tds_read_b64_tr_b16 %3, %8 offset:96\n\t"
                             "ds_read_b64_tr_b16 %4, %8 offset:2304\n\tds_read_b64_tr_b16 %5, %8 offset:2336\n\tds_read_b64_tr_b16 %6, %8 offset:2368\n\tds_read_b64_tr_b16 %7, %8 offset:2400\n\ts_waitcnt lgkmcnt(0)"
                             : "=&v"(tb[0]), "=&v"(tb[1]), "=&v"(tb[2]), "=&v"(tb[3]), "=&v"(tk[0]), "=&v"(tk[1]), "=&v"(tk[2]), "=&v"(tk[3]) : "v"(ad) : "memory");
#pragma unroll
                for (int jt = 0; jt < 4; ++jt) {
                    Sm[jt] = MF16(auv, __builtin_shufflevector(tb[jt], tk[jt], 0, 1, 2, 3, 4, 5, 6, 7), Sm[jt]);
                    Sm[jt] *= *(const LAS float*)(L + WL0 + (c & 3) * 256 + (16 * jt + fr) * 4);
#pragma unroll
                    for (int e = 0; e < 4; ++e) *(LAS bf16_t*)(L + IMGS + (4 * g + e) * 144 + (16 * jt + fr) * 2) = (bf16_t)(pk2(Sm[jt][e], 0.f) & 0xffffu);
                }
                RWS_T1(3);
                RW_BAR();
            }
            RW_BAR();
        }
        __syncthreads();
    }
}
#define MIXER_CONV \
        if (L == 0) { \
            bf16_t* const Ub = (bf16_t*)act; bf16_t* const Sb = (bf16_t*)act + (size_t)M * D; \
            if (IN(base + 0)) {        \
                zero_i64(F, ssq_m_out, M); \
                pg8::Gemm g = pg8::make_gemm(F.Xb, D, (const bf16_t*)(wb + WB_CONV_IN), D, M, 2 * D, D); \
                pg8::StaticOrder S; S.init(g.M, g.N, F.G, (int)blockIdx.x); \
                pg8::EpiGated<1> E{Ub, D, ssq_m_in, I.conv_b_in, I.conv_b_in + D}; \
                pg8::gemm_phase(F.lds, g, S, E); \
                SEAM(base + 0, 2); \
            } \
            if (IN(base + 1)) { conv_ln_phase(F, I, Ub, Sb); SEAM(base + 1, 3); } \
            if (IN(base + 2)) {        \
                pg8::Gemm g = pg8::make_gemm(Sb, D, (const bf16_t*)(wb + WB_CONV_OUT), D, M, D, D); \
                pg8::StaticOrder S; S.init(g.M, g.N, F.G, (int)blockIdx.x); \
                pg8::EpiResid E{F.Xb, ssq_m_out, I.conv_b_out, 0}; \
                pg8::gemm_phase(F.lds, g, S, E); \
                SEAM(base + 2, 4); \
            } \
        }
#define MIXER_SGU \
        if (L == 2) { \
            bf16_t* const Zb = (bf16_t*)act; \
            if (IN(base + 0)) {        \
                zero_i64(F, ssq_m_out, M); \
                pg8::Gemm g = pg8::make_gemm(F.Xb, D, (const bf16_t*)(wb + WB_SGU_IN), D, M, 4096, D); \
                pg8::StaticOrder S; S.init(g.M, g.N, F.G, (int)blockIdx.x); \
                pg8::EpiGeluStats E{Zb, 4096, ssq_m_in, I.sgu_b_in, F.lns, 8}; \
                pg8::gemm_phase(F.lds, g, S, E); \
                SEAM(base + 0, 11); \
            } \
            if (IN(base + 1)) { sgu_spatial_phase(F, I, Zb); SEAM(base + 1, 12); } \
            if (IN(base + 2)) {        \
                pg8::Gemm g = pg8::make_gemm(Zb, 4096, (const bf16_t*)(wb + WB_SGU_OUT), 2048, M, D, 2048); \
                pg8::StaticOrder S; S.init(g.M, g.N, F.G, (int)blockIdx.x); \
                pg8::EpiResid E{F.Xb, ssq_m_out, nullptr, 0}; \
                pg8::gemm_phase(F.lds, g, S, E); \
                SEAM(base + 2, 13); \
            } \
        }
#define MIXER_RET \
        if (L == 3) { \
            bf16_t* const QKVb = (bf16_t*)act;          \
            if (IN(base + 0)) {        \
                zero_i64(F, ssq_m_out, M); \
                pg8::Gemm g = pg8::make_gemm(F.Xb, D, (const bf16_t*)(wb + WB_RET_QKV), D, M, 4096, D); \
                pg8::StaticOrder S; S.init(g.M, g.N, F.G, (int)blockIdx.x); \
                pg8::EpiRope E{QKVb, 4096, ssq_m_in, (const f32x4*)(a.ws + F.wm.rope), 0, 8}; \
                pg8::gemm_phase(F.lds, g, S, E); \
                SEAM(base + 0, 14); \
            } \
            if (IN(base + 1)) { ret_chunk_phase(F, QKVb, F.oss, F.NB); SEAM(base + 1, 15); } \
            if (IN(base + 2)) {        \
                pg8::Gemm g = pg8::make_gemm(F.Xb, D, (const bf16_t*)(wb + WB_RET_G), D, M, 2048, D); \
                pg8::StaticOrder S; S.init(g.M, g.N, F.G, (int)blockIdx.x); \
                pg8::EpiRetGate E{QKVb + 2048, 4096, ssq_m_in, F.oss, 0}; \
                pg8::gemm_phase(F.lds, g, S, E); \
                SEAM(base + 2, 16); \
            } \
            if (IN(base + 3)) {        \
                pg8::Gemm g = pg8::make_gemm(QKVb + 2048, 4096, (const bf16_t*)(wb + WB_RET_OUT), 2048, M, D, 2048); \
                pg8::StaticOrder S; S.init(g.M, g.N, F.G, (int)blockIdx.x); \
                pg8::EpiResid E{F.Xb, ssq_m_out, nullptr, 0}; \
                pg8::gemm_phase(F.lds, g, S, E); \
                SEAM(base + 3, 17); \
            } \
        }
#define MIXER_RWKV \
        if (L == 1) { \
            const int Mh = M / 2; const size_t MD = (size_t)Mh * D; \
            bf16_t* const hnp = (bf16_t*)act; bf16_t* const xsb = hnp + MD + (size_t)64 * D; bf16_t* const rkv = xsb + 3 * MD; bf16_t* const l1b = rkv + 3 * MD; \
            bf16_t* const wagb = xsb; bf16_t* const yb = hnp; bf16_t* const Ob = xsb; \
            for (int hf = 0; hf < 2; ++hf) { \
                const int rb = hf * Mh, pb = base + 6 * hf; \
                if (IN(pb + 0)) { if (hf == 0) zero_i64(F, ssq_m_out, M); rwkv_mix_phase(F, I, F.Xb, ssq_m_in, rb, Mh, hnp, xsb); SEAM(pb + 0, 5); } \
                if (IN(pb + 1)) {        \
                    const int Gh = F.G / 2; \
                    if ((int)blockIdx.x < Gh) { \
                      pg8::Gemm g = pg8::make_gemm(hnp, D, (const bf16_t*)(wb + WB_RW_L1), 2 * D, Mh, 512, 2 * D); g.seq_pad = 1; g.ksplit = 16; g.ajump = -(D * 2 + 16 * 128); \
                      pg8::StaticOrder S; S.init(g.M, g.N, Gh, (int)blockIdx.x); \
                      pg8::EpiLora1 E{l1b, 512}; \
                      pg8::gemm_phase(F.lds, g, S, E); \
                    } else { \
                      pg8::Gemm g = pg8::make_gemm(xsb, D, (const bf16_t*)(wb + WB_RW_RKV), D, Mh, D, D); \
                      pg8::StaticOrder S; S.init(g.M, g.N, F.G - Gh, (int)blockIdx.x - Gh); \
                      pg8::EpiBf16 E{rkv, D, nullptr, nullptr, nullptr, 0}; \
                      pg8::gemm_phase(F.lds, g, S, E); \
                    } \
                    for (int i = 1; i < 3; ++i) { \
                      pg8::Gemm g = pg8::make_gemm(xsb + i * MD, D, (const bf16_t*)(wb + WB_RW_RKV) + (size_t)i * D * D, D, Mh, D, D); \
                      pg8::StaticOrder S; S.init(g.M, g.N, F.G, (int)blockIdx.x); \
                      pg8::EpiBf16 E{rkv + i * MD, D, nullptr, nullptr, nullptr, 0}; \
                      pg8::gemm_phase(F.lds, g, S, E); } \
                    SEAM(pb + 1, 6); \
                } \
                if (IN(pb + 2)) {        \
                    { pg8::Gemm g = pg8::make_gemm(l1b, 512, (const bf16_t*)(wb + WB_RW_W2), 256, Mh, D, 256); \
                      pg8::StaticOrder S; S.init(g.M, g.N, F.G, (int)blockIdx.x); \
                      pg8::EpiRwkvAct<0> E{wagb, D, I.rwkv_w0}; \
                      pg8::gemm_phase(F.lds, g, S, E); } \
                    { pg8::Gemm g = pg8::make_gemm(l1b, 512, (const bf16_t*)(wb + WB_RW_A2), 256, Mh, D, 256); \
                      pg8::StaticOrder S; S.init(g.M, g.N, F.G, (int)blockIdx.x); \
                      pg8::EpiRwkvAct<1> E{wagb + MD, D, I.rwkv_a0}; \
                      pg8::gemm_phase(F.lds, g, S, E); } \
                    { pg8::Gemm g = pg8::make_gemm(l1b + 128, 512, (const bf16_t*)(wb + WB_RW_G2), 256, Mh, D, 256); \
                      pg8::StaticOrder S; S.init(g.M, g.N, F.G, (int)blockIdx.x); \
                      pg8::EpiBf16 E{wagb + 2 * MD, D, nullptr, nullptr, nullptr, 0}; \
                      pg8::gemm_phase(F.lds, g, S, E); } \
                    SEAM(pb + 2, 7); \
                } \
                if (IN(pb + 3)) { rwkv_chunk_pipe_phase(F, I, rkv, rkv + MD, rkv + 2 * MD, wagb, wagb + MD, yb, F.NB / 2, pr_sum); SEAM(pb + 3, 8); } \
                if (IN(pb + 4)) { rwkv_post_phase(F, I, yb, rkv, rkv + MD, rkv + 2 * MD, wagb + MD, wagb + 2 * MD, Ob, Mh); SEAM(pb + 4, 9); } \
                if (IN(pb + 5)) {        \
                    pg8::Gemm g = pg8::make_gemm(Ob, D, (const bf16_t*)(wb + WB_RW_WO), D, Mh, D, D); \
                    pg8::StaticOrder S; S.init(g.M, g.N, F.G, (int)blockIdx.x); \
                    pg8::EpiResid E{F.Xb, ssq_m_out, nullptr, rb}; \
                    pg8::gemm_phase(F.lds, g, S, E); \
                    SEAM(pb + 5, 10); \
                } \
            } \
        }
#define MIXER_PHASES MIXER_CONV MIXER_RWKV MIXER_SGU MIXER_RET
constexpr int PH_LAYER0 = 2, PH_PER_LAYER = 17, PH_XATTN = 12, PH_FFN = 15, PH_FINAL = PH_LAYER0 + 4 * PH_PER_LAYER, PH_END = PH_FINAL + 1;

__global__ void __launch_bounds__(NTHREADS, 2) mega(Args a) {
    extern __shared__ __attribute__((aligned(16))) unsigned char lds_raw[];
    Frame F;
    F.lds = (LAS unsigned char*)lds_raw;
    F.wave = __builtin_amdgcn_readfirstlane((int)threadIdx.x >> 6);
    F.G = gridDim.x; { const int bx = blockIdx.x; F.vcu = (F.G % 8 == 0) ? (bx % 8) * (F.G / 8) + bx / 8 : bx; }
    F.gw = F.vcu * NWAVES + F.wave; F.NGW = F.G * NWAVES;
    F.NB = a.NB; F.M = a.NB * T; F.ws = a.ws; F.wm = make_wsmap(a.NB);
    F.Xb = (bf16_t*)(a.ws + F.wm.xb); F.ssq = (i64*)(a.ws + F.wm.ssq); F.lns = (i64*)(a.ws + F.wm.lns); F.oss = (i64*)(a.ws + F.wm.oss);
    const Inputs& I = a.in;
    const int M = F.M;
    volatile LAS unsigned* lctl = (volatile LAS unsigned*)(F.lds + LDSCTL_OFF);
    if (threadIdx.x < 64) lctl[threadIdx.x] = 0u;
    __syncthreads();
    XcdBarrier bar; bar.bar = (unsigned*)(a.ws + F.wm.ctl) + 4096; bar.x = 0; bar.st = lctl;
    if (a.use_bar) bar = xcd_barrier_post((unsigned*)(a.ws + F.wm.ctl) + 4096, lctl);
    const int lo = a.ph_lo, hi = a.ph_hi;
#define IN(k) (lo <= (k) && (k) < hi)
#ifndef PROBE_MASK
#define PROBE_MASK 0ull
#endif
#ifndef PROBE_MULT
#define PROBE_MULT 4
#endif
    unsigned long long pr_last = 0ull, pr_sum = 0ull;
    if (PROBE_MASK) pr_last = __builtin_amdgcn_s_memrealtime();
#ifndef BAR_PROBE
#define BAR_PROBE 0
#endif
#define SEAM(k, site) do { unsigned long long bt0_ = 0ull; if (BAR_PROBE) bt0_ = __builtin_amdgcn_s_memrealtime(); \
        if (a.use_bar && (k) + 1 < hi) xcd_barrier(bar); else __syncthreads(); \
        if (BAR_PROBE) pr_sum += __builtin_amdgcn_s_memrealtime() - bt0_; \
        if (PROBE_MASK) { const unsigned long long now_ = __builtin_amdgcn_s_memrealtime(); if ((PROBE_MASK >> (site)) & 1ull) pr_sum += now_ - pr_last; pr_last = now_; } } while (0)
    unsigned char* const wbuf0 = a.ws + F.wm.wb0; unsigned char* const wbuf1 = a.ws + F.wm.wb1;
#define WBUF(i) (((i) & 1) ? wbuf1 : wbuf0)
    unsigned char* const act = a.ws + F.wm.act;

    if (a.conv_layer_p1) convert_layer_weights(F, I, a.conv_layer_p1 - 1, WBUF(a.conv_layer_p1 - 1));
    if (a.dump_xb) dump_rows(F, F.Xb, a.out, M);
    if (a.load_src) { load_rows(F, a.load_src, nullptr, F.Xb, F.ssq + (size_t)a.load_slot * M, M); zero_i64(F, F.ssq + (size_t)(a.load_slot ^ 1) * M, M); }

    if (IN(0)) {
        load_rows(F, I.x, nullptr, F.Xb, F.ssq, M);
        load_mem_rows(F, I.mem, (bf16_t*)(a.ws + F.wm.mem_b), (float*)(a.ws + F.wm.rstd_mem), F.NB * NMEM);
        make_tables(F, I);
        for (int L = 0; L < 4; ++L) {
            { WConv w = wconv(I.xattn_wkv + (size_t)L * D * 2 * D, 2 * D, D, (bf16_t*)(a.ws + F.wm.wk_all) + (size_t)L * D * D, D, D); w.kvec = I.mem_norm_g + L * D; w.sa = 0.f; w.sb = 1.f; convert_w(F, w); }
            { WConv w = wconv(I.xattn_wkv + (size_t)L * D * 2 * D, 2 * D, D, (bf16_t*)(a.ws + F.wm.wv_all) + (size_t)L * D * D, D, D); w.col0 = D; w.kvec = I.mem_norm_g + L * D; w.sa = 0.f; w.sb = 1.f; convert_w(F, w); }
        }
        convert_layer_weights(F, I, 0, wbuf0);
        SEAM(0, 0);
    }
    if (IN(1)) {
        { pg8::Gemm g = pg8::make_gemm((const bf16_t*)(a.ws + F.wm.mem_b), D, (const bf16_t*)(a.ws + F.wm.wk_all), D, F.NB * NMEM, 4096, D);
          pg8::StaticOrder S; S.init(g.M, g.N, F.G, (int)blockIdx.x);
          pg8::EpiBf16 E{(bf16_t*)(a.ws + F.wm.kall), 4096, nullptr, (const float*)(a.ws + F.wm.rstd_mem), nullptr, 0, 1, F.NB};
          pg8::gemm_phase(F.lds, g, S, E); }
        { pg8::Gemm g = pg8::make_gemm((const bf16_t*)(a.ws + F.wm.wv_all), D, (const bf16_t*)(a.ws + F.wm.mem_b), D, 4096, F.NB * NMEM, D);
          pg8::StaticOrder S; S.init(g.M, g.N, F.G, (int)blockIdx.x);
          pg8::EpiBf16ColScale E{(bf16_t*)(a.ws + F.wm.vtall), F.NB * NMEM, (const float*)(a.ws + F.wm.rstd_mem), F.NB, 1};
          pg8::gemm_phase(F.lds, g, S, E); }
        __syncthreads();
    }
    for (int L = 0; L < 4; ++L) {
        const int base = PH_LAYER0 + L * PH_PER_LAYER;
        if (hi <= base || lo >= base + PH_PER_LAYER) continue;
        unsigned char* const wb = WBUF(L);
        i64* const ssq_m_in = F.ssq + (size_t)((3 * L) & 1) * M, * const ssq_m_out = F.ssq + (size_t)((3 * L + 1) & 1) * M;
        i64* const ssq_a_in = ssq_m_out, * const ssq_a_out = ssq_m_in;
        i64* const ssq_f_in = ssq_m_in, * const ssq_f_out = ssq_m_out;
MIXER_PHASES
        if (IN(base + PH_XATTN + 0)) {
            zero_i64(F, ssq_a_out, M);
            pg8::Gemm g = pg8::make_gemm(F.Xb, D, (const bf16_t*)(wb + WB_WQ), D, M, D, D);
            pg8::StaticOrder S; S.init(g.M, g.N, F.G, (int)blockIdx.x);
            pg8::EpiBf16 E{(bf16_t*)act, D, ssq_a_in, nullptr, nullptr, 0};
            pg8::gemm_phase(F.lds, g, S, E);
            SEAM(base + PH_XATTN + 0, 18);
        }
        if (IN(base + PH_XATTN + 1)) {
            attn_phase(F, (bf16_t*)act, (const bf16_t*)(a.ws + F.wm.kall), (const bf16_t*)(a.ws + F.wm.vtall), L, pr_sum);
            SEAM(base + PH_XATTN + 1, 19);
        }
        if (IN(base + PH_XATTN + 2)) {
            pg8::Gemm g = pg8::make_gemm((const bf16_t*)act, D, (const bf16_t*)(wb + WB_WO), D, M, D, D);
            pg8::StaticOrder S; S.init(g.M, g.N, F.G, (int)blockIdx.x);
            pg8::EpiResid E{F.Xb, ssq_a_out, nullptr, 0};
            pg8::gemm_phase(F.lds, g, S, E);
            SEAM(base + PH_XATTN + 2, 20);
        }
        if (IN(base + PH_FFN + 0)) {
            zero_i64(F, ssq_f_out, M);
            pg8::Gemm g = pg8::make_gemm(F.Xb, D, (const bf16_t*)(wb + WB_GU), D, M, 2 * FF, D);
            pg8::StaticOrder S; S.init(g.M, g.N, F.G, (int)blockIdx.x);
            pg8::EpiGated<0> E{(bf16_t*)act, FF, ssq_f_in, nullptr, nullptr};
            pg8::gemm_phase(F.lds, g, S, E);
            SEAM(base + PH_FFN + 0, 21);
        }
        if (IN(base + PH_FFN + 1)) {
            if (L < 3) { convert_layer_weights(F, I, L + 1, WBUF(L + 1)); __syncthreads(); }
            pg8::Gemm g = pg8::make_gemm((const bf16_t*)act, FF, (const bf16_t*)(wb + WB_DOWN), FF, M, D, FF);
            pg8::StaticOrder S; S.init(g.M, g.N, F.G, (int)blockIdx.x);
            pg8::EpiResid E{F.Xb, ssq_f_out, nullptr, 0};
            pg8::gemm_phase(F.lds, g, S, E);
            SEAM(base + PH_FFN + 1, 22);
        }
    }
#ifdef EXTRA_BARS
    if (a.use_bar) for (int i = 0; i < EXTRA_BARS; ++i) xcd_barrier(bar);
#endif
    if (IN(PH_FINAL)) final_norm(F, F.Xb, a.out, F.ssq + (size_t)(12 & 1) * M, I.final_norm_g, M);
    if (PROBE_MASK || RWS >= 0 || AT_PROBE || BAR_PROBE) {
        if ((PROBE_MASK >> 23) & 1ull) pr_sum += __builtin_amdgcn_s_memrealtime() - pr_last;
        if (blockIdx.x == 0) { const unsigned long long t0 = __builtin_amdgcn_s_memrealtime(); while (__builtin_amdgcn_s_memrealtime() - t0 < (unsigned long long)PROBE_MULT * pr_sum) __builtin_amdgcn_s_sleep(32); }
    }
#undef IN
#undef SEAM
}

struct Launcher {
    int grid = 0; bool ok = false;
    void init() {
        if (grid) return;
        int dev = 0, cus = 0, per_cu = 0;
        if (hipGetDevice(&dev) != hipSuccess || hipDeviceGetAttribute(&cus, hipDeviceAttributeMultiprocessorCount, dev) != hipSuccess) { grid = -1; return; }
        if (hipFuncSetAttribute((const void*)mega, hipFuncAttributeMaxDynamicSharedMemorySize, LDS_BYTES) != hipSuccess) { fprintf(stderr, "hipFuncSetAttribute failed\n"); grid = -1; return; }
        if (hipOccupancyMaxActiveBlocksPerMultiprocessor(&per_cu, (const void*)mega, NTHREADS, LDS_BYTES) != hipSuccess || per_cu < 1) fprintf(stderr, "occupancy query: %d\n", per_cu);
        (void)hipGetLastError();
        grid = cus; ok = true;
    }
};
static Launcher g_launcher;
static Inputs make_inputs(void* const* d_in) { Inputs I; const float** p = (const float**)&I; for (int i = 0; i < 45; ++i) p[i] = (const float*)d_in[i]; return I; }
static void launch_phases(hipStream_t st, const Inputs& I, float* out, void* ws, int NB, int lo, int hi, int use_bar, const float* load_src, int load_slot, int conv_layer_p1, int dump_xb = 0) {
    Args a{}; a.in = I; a.out = out; a.ws = (unsigned char*)ws; a.load_src = load_src; a.NB = NB; a.ph_lo = lo; a.ph_hi = hi; a.use_bar = use_bar; a.load_slot = load_slot; a.conv_layer_p1 = conv_layer_p1; a.dump_xb = dump_xb; a.pad = 0;
    hipLaunchKernelGGL(mega, dim3(g_launcher.grid), dim3(NTHREADS), LDS_BYTES, st, a);
}
}
#ifndef ONE_LAUNCH
#define ONE_LAUNCH 1
#endif
extern "C" void kernel_launch(void* const* d_in, const int* in_sizes, int n_in, void* d_out, int out_size, void* d_ws, size_t ws_size, hipStream_t stream) {
    (void)in_sizes; (void)n_in; (void)out_size;
    constexpr int NB = 16;
    const fp::WsMap wm = fp::make_wsmap(NB);
    fp::g_launcher.init();
    if (ws_size < wm.end || fp::g_launcher.grid <= 0) { fprintf(stderr, "kernel_launch: workspace too small (%zu < %zu) or launcher init failed; nothing launched\n", ws_size, wm.end); return; }
    const fp::Inputs I = fp::make_inputs(d_in);
    (void)hipMemsetAsync(d_ws, 0, wm.rope, stream);
    if (ONE_LAUNCH) fp::launch_phases(stream, I, (float*)d_out, d_ws, NB, 0, fp::PH_END, 1, nullptr, 0, 0);
    else for (int p = 0; p < fp::PH_END; ++p) fp::launch_phases(stream, I, (float*)d_out, d_ws, NB, p, p + 1, 0, nullptr, 0, 0);
}
```

```cpp
#include <hip/hip_runtime.h>
#include <cstdio>
#include <cstdint>

namespace fp {
#define LAS __attribute__((address_space(3)))
#define GAS __attribute__((address_space(1)))
typedef unsigned short bf16_t;
typedef short bf16x8 __attribute__((ext_vector_type(8)));
typedef short s16x4 __attribute__((ext_vector_type(4)));
typedef float f32x2 __attribute__((ext_vector_type(2)));
typedef float f32x4 __attribute__((ext_vector_type(4)));
typedef float f32x16 __attribute__((ext_vector_type(16)));
typedef unsigned u32x2 __attribute__((ext_vector_type(2)));
typedef unsigned u32x4 __attribute__((ext_vector_type(4)));
typedef __bf16 bf16x2_t __attribute__((ext_vector_type(2)));
typedef unsigned long long u64;
typedef long long i64;

constexpr int T = 2048, D = 1024, NMEM = 256, FF = 2816, NWAVES = 8, NTHREADS = 512;
constexpr float SSQ_SCALE = 16777216.0f, SSQ_INV = 1.0f / 16777216.0f;

__device__ __forceinline__ unsigned pk2(float a, float b) { f32x2 v = {a, b}; bf16x2_t r = __builtin_convertvector(v, bf16x2_t); return __builtin_bit_cast(unsigned, r); }
__device__ __forceinline__ float bf_lo(unsigned u) { return __uint_as_float(u << 16); }
__device__ __forceinline__ float bf_hi(unsigned u) { return __uint_as_float(u & 0xffff0000u); }
__device__ __forceinline__ float bf2f(bf16_t b) { return __uint_as_float(((unsigned)b) << 16); }
__device__ __forceinline__ float fast_sigmoid(float x) { return __builtin_amdgcn_rcpf(1.0f + __builtin_amdgcn_exp2f(-1.4426950408889634f * x)); }
__device__ __forceinline__ float fast_silu(float x) { return x * fast_sigmoid(x); }
__device__ __forceinline__ int opaque_tid() { int t = threadIdx.x; asm volatile("" : "+v"(t)); return t; }
__device__ __forceinline__ float dpp_sum16(float v) {
    v += __int_as_float(__builtin_amdgcn_update_dpp(0, __float_as_int(v), 0xB1, 0xF, 0xF, true));
    v += __int_as_float(__builtin_amdgcn_update_dpp(0, __float_as_int(v), 0x4E, 0xF, 0xF, true));
    v += __int_as_float(__builtin_amdgcn_update_dpp(0, __float_as_int(v), 0x141, 0xF, 0xF, true));
    v += __int_as_float(__builtin_amdgcn_update_dpp(0, __float_as_int(v), 0x140, 0xF, 0xF, true));
    return v;
}
__device__ __forceinline__ float wave_sum(float v) { v = dpp_sum16(v); v += __shfl_xor(v, 16); v += __shfl_xor(v, 32); return v; }
#define RLX_AGENT __ATOMIC_RELAXED, __HIP_MEMORY_SCOPE_AGENT
__device__ __forceinline__ void atomic_add_i64(i64* p, i64 v) { (void)__hip_atomic_fetch_add((u64*)p, (u64)v, RLX_AGENT); }
__device__ __forceinline__ float rstd_from_ssq(i64 s, float inv_n, float eps) { return rsqrtf((float)s * SSQ_INV * inv_n + eps); }

#define XB_TMO      128
#define XB_XCNT(j)  (256  + 64 * (j))
#define XB_XSUB(j)  (1280 + 64 * (j))
#define XB_XGEN(j)  (2304 + 64 * (j))
#define XB_TOP      3328
#define XB_TOPGEN   3392
#define XCD_BAR_WORDS 3456
#define XB_SPIN_CAP (1u << 22)
__device__ __forceinline__ unsigned xb_ld(unsigned* p)              { return __hip_atomic_load(p, __ATOMIC_RELAXED, __HIP_MEMORY_SCOPE_AGENT); }
__device__ __forceinline__ unsigned xb_add(unsigned* p, unsigned v) { return __hip_atomic_fetch_add(p, v, __ATOMIC_RELAXED, __HIP_MEMORY_SCOPE_AGENT); }
__device__ __forceinline__ unsigned xb_xcc_id() { return (unsigned)__builtin_amdgcn_s_getreg((3 << 11) | 20) & 0xFu; }
#define XB_SPIN(cond, bar) do { unsigned _sp = 0; while (cond) { __builtin_amdgcn_s_sleep(1); \
    if ((++_sp & 255u) == 0u) { if (xb_ld(&(bar)[XB_TMO])) break; if (_sp > XB_SPIN_CAP) { atomicAdd(&(bar)[XB_TMO], 1u); break; } } } } while (0)
struct XcdBarrier { unsigned* bar; unsigned x; volatile LAS unsigned* st; };
__device__ __forceinline__ XcdBarrier xcd_barrier_post(unsigned* bar, volatile LAS unsigned* st) {
    XcdBarrier b; b.bar = bar; b.x = xb_xcc_id(); b.st = st;
    if (threadIdx.x == 0) (void)xb_add(&bar[XB_XCNT(b.x)], 1u);
    return b;
}
__device__ __forceinline__ void xcd_barrier_complete(unsigned* bar, unsigned x, unsigned& nloc, unsigned& nx) {
    const unsigned G = gridDim.x * gridDim.y * gridDim.z;
    unsigned sum, cnt, mine, sp = 0u;
    for (;;) {
        sum = 0u; cnt = 0u; mine = 0u;
        unsigned cv[16];
        {
            const unsigned* cp = &bar[XB_XCNT(0)];
            asm volatile("global_load_dword %0, %16, off sc1\n\tglobal_load_dword %1, %16, off offset:256 sc1\n\tglobal_load_dword %2, %16, off offset:512 sc1\n\t"
                         "global_load_dword %3, %16, off offset:768 sc1\n\tglobal_load_dword %4, %16, off offset:1024 sc1\n\tglobal_load_dword %5, %16, off offset:1280 sc1\n\t"
                         "global_load_dword %6, %16, off offset:1536 sc1\n\tglobal_load_dword %7, %16, off offset:1792 sc1\n\tglobal_load_dword %8, %16, off offset:2048 sc1\n\t"
                         "global_load_dword %9, %16, off offset:2304 sc1\n\tglobal_load_dword %10, %16, off offset:2560 sc1\n\tglobal_load_dword %11, %16, off offset:2816 sc1\n\t"
                         "global_load_dword %12, %16, off offset:3072 sc1\n\tglobal_load_dword %13, %16, off offset:3328 sc1\n\tglobal_load_dword %14, %16, off offset:3584 sc1\n\t"
                         "global_load_dword %15, %16, off offset:3840 sc1\n\ts_waitcnt vmcnt(0)"
                         : "=&v"(cv[0]), "=&v"(cv[1]), "=&v"(cv[2]), "=&v"(cv[3]), "=&v"(cv[4]), "=&v"(cv[5]), "=&v"(cv[6]), "=&v"(cv[7]),
                           "=&v"(cv[8]), "=&v"(cv[9]), "=&v"(cv[10]), "=&v"(cv[11]), "=&v"(cv[12]), "=&v"(cv[13]), "=&v"(cv[14]), "=&v"(cv[15])
                         : "v"(cp) : "memory");
        }
#pragma unroll
        for (unsigned j = 0; j < 16; ++j) { const unsigned c = cv[j]; sum += c; cnt += (c > 0u) ? 1u : 0u; mine = (j == x) ? c : mine; }
        if (sum == G) break;
        __builtin_amdgcn_s_sleep(1);
        if ((++sp & 255u) == 0u) { if (xb_ld(&bar[XB_TMO])) break; if (sp > XB_SPIN_CAP) { atomicAdd(&bar[XB_TMO], 1u); break; } }
    }
    nloc = mine > 0u ? mine : 1u; nx = cnt > 0u ? cnt : 1u;
}
__device__ __forceinline__ void xcd_barrier(const XcdBarrier& b) {
    asm volatile("s_waitcnt vmcnt(0)" ::: "memory");
    __syncthreads();
    if (threadIdx.x == 0) {
        unsigned* bar = b.bar;
        __builtin_amdgcn_s_waitcnt(0);
        unsigned nloc = b.st[0], nx = b.st[1];
        if (nloc == 0u) { xcd_barrier_complete(bar, b.x, nloc, nx); b.st[0] = nloc; b.st[1] = nx; }
        const unsigned old = xb_add(&bar[XB_XSUB(b.x)], 1u);
        const unsigned gen = old / nloc;
        if (old + 1u == (gen + 1u) * nloc) {
            __builtin_amdgcn_fence(__ATOMIC_RELEASE, "agent");
            asm volatile("s_waitcnt vmcnt(0)" ::: "memory");
            const unsigned og = xb_add(&bar[XB_TOP], 1u);
            const unsigned tg = og / nx;
            if (og + 1u == (tg + 1u) * nx) xb_add(&bar[XB_TOPGEN], 1u);
            else XB_SPIN(xb_ld(&bar[XB_TOPGEN]) == tg, bar);
            __builtin_amdgcn_fence(__ATOMIC_ACQUIRE, "agent");
            xb_add(&bar[XB_XGEN(b.x)], 1u);
            asm volatile("s_waitcnt vmcnt(0)" ::: "memory");
        } else {
            XB_SPIN(xb_ld(&bar[XB_XGEN(b.x)]) == gen, bar);
            __builtin_amdgcn_fence(__ATOMIC_ACQUIRE, "agent");
            asm volatile("s_waitcnt vmcnt(0)" ::: "memory");
        }
    }
    __syncthreads();
}

namespace pg8 {
constexpr int BM = 256, BK = 64, HALF = 128, HTB = HALF * BK * 2, STAGE_BYTES = 8 * HTB, NXCD = 8, WGM = 8;
__host__ __device__ __forceinline__ int lds_byte(int r, int c) { const int st = (r >> 4) * 2 + (c >> 5), rr = r & 15, cc = c & 31, ob = rr * 64 + cc * 2; return st * 1024 + (ob ^ (((ob >> 9) & 1) << 5)); }
__host__ __device__ __forceinline__ void stage_rc(int b, int& R, int& C) { const int st = b / 1024, sb = b % 1024, swz = sb ^ (((sb >> 9) & 1) << 5); R = (st >> 1) * 16 + swz / 64; C = (st & 1) * 32 + (swz % 64) / 2; }
__host__ __device__ __forceinline__ int perm32(int rho) { const int n = rho >> 4, i = rho & 15; return 8 * (i >> 2) + 4 * n + (i & 3); }

struct Unit { int pm, pn; };
struct Gemm { const bf16_t* A; const bf16_t* Bt; int M, N, K, lda, ldb, ksplit, ajump, seq_pad; };
__device__ __forceinline__ Gemm make_gemm(const bf16_t* A, int lda, const bf16_t* Bt, int ldb, int M, int N, int K) { Gemm g; g.A = A; g.Bt = Bt; g.M = M; g.N = N; g.K = K; g.lda = lda; g.ldb = ldb; g.ksplit = 1 << 20; g.ajump = 0; g.seq_pad = 0; return g; }

struct StaticOrder {
    int nM, nN, nwg, G, c;
    __device__ void init(int M, int N, int G_, int c_) { nM = M / BM; nN = N / BM; nwg = nM * nN; G = G_; c = c_; }
    __device__ bool next(int i, Unit& u) const {
        const long L = (long)i * G + c; if (L >= nwg) return false;
        int wgid = (int)L; { const int q = nwg / NXCD, r = nwg % NXCD, xcd = wgid % NXCD, off = wgid / NXCD; wgid = (xcd < r ? xcd * (q + 1) : r * (q + 1) + (xcd - r) * q) + off; }
        const int nig = WGM * nN, gid = wgid / nig, fm = gid * WGM, gsz = (nM - fm) < WGM ? (nM - fm) : WGM;
        u.pm = fm + ((wgid % nig) % gsz); u.pn = (wgid % nig) / gsz; return true;
    }
};

template <class Epi>
__device__ __forceinline__ void gemm_phase(LAS unsigned char* lds, const Gemm g, const StaticOrder& S, const Epi& E) {
    int tid_ = threadIdx.x; asm volatile("" : "+v"(tid_));
    const int tid = tid_, wid = __builtin_amdgcn_readfirstlane(tid >> 6), lane = tid & 63, wr = wid >> 2, wc = wid & 3, fr = lane & 15, fq = lane >> 4;
    const int K = g.K, nt = K / BK;
    unsigned voffA[2], voffB[2];
#pragma unroll
    for (int i = 0; i < 2; ++i) { int R, C; stage_rc(tid * 16 + i * 8192, R, C); const int Rb = Epi::PERM ? ((R & ~31) + perm32(R & 31)) : R;
        voffA[i] = (unsigned)(R * g.lda + C) * 2u; voffB[i] = (unsigned)(Rb * g.ldb + C) * 2u; }
    const long kstep = (long)(BK * 2);
    const long hstepA = (long)HALF * g.lda * 2, hstepB = (long)HALF * g.ldb * 2;
    const long rowA = (long)g.lda * 2;
    const int ksplit = g.ksplit; const long ajump = g.ajump;
    const unsigned ldsw = (unsigned)wid * 1024u;
    const int aoff = lds_byte(wr * 64 + fr, fq * 8), boff = lds_byte(wc * 32 + fr, fq * 8);
#define PG8_SA(b, h) (((b) * 2 + (h)) * HTB)
#define PG8_SB(b, h) ((4 + (b) * 2 + (h)) * HTB)
#define PG8_STAGE(bufoff, gbase, voff) do { _Pragma("unroll") for (int _i = 0; _i < 2; ++_i) \
        __builtin_amdgcn_global_load_lds((const unsigned*)((const char*)(gbase) + (voff)[_i]), (LAS unsigned*)(lds + (bufoff) + ldsw + _i * 8192), 16, 0, 0); } while (0)
#define PG8_LDA(dst, b, h) do { _Pragma("unroll") for (int m = 0; m < 4; ++m) _Pragma("unroll") for (int k = 0; k < 2; ++k) dst[m][k] = *(const LAS bf16x8*)(lds + PG8_SA(b, h) + aoff + m * 2048 + k * 1024); } while (0)
#define PG8_LDB(dst, b, h) do { _Pragma("unroll") for (int n = 0; n < 2; ++n) _Pragma("unroll") for (int k = 0; k < 2; ++k) dst[n][k] = *(const LAS bf16x8*)(lds + PG8_SB(b, h) + boff + n * 2048 + k * 1024); } while (0)
#define PG8_MMA(ai, bj, At, Bt) do { __builtin_amdgcn_s_setprio(1); _Pragma("unroll") for (int m = 0; m < 4; ++m) _Pragma("unroll") for (int n = 0; n < 2; ++n) _Pragma("unroll") for (int k = 0; k < 2; ++k) \
        acc[ai][bj][m][n] = __builtin_amdgcn_mfma_f32_16x16x32_bf16(Bt[n][k], At[m][k], acc[ai][bj][m][n], 0, 0, 0); __builtin_amdgcn_s_setprio(0); } while (0)
#define PG8_WAIT_V(n) asm volatile("s_waitcnt vmcnt(" #n ")" ::: "memory")
#define PG8_WAIT_L(n) asm volatile("s_waitcnt lgkmcnt(" #n ")" ::: "memory")
#define PG8_BAR __builtin_amdgcn_s_barrier()
#define PG8_SCHED __builtin_amdgcn_sched_barrier(0)
#define PG8_ABASE(u) ((const char*)g.A + ((long)(u).pm * BM + (g.seq_pad ? (((u).pm >> 3) + 1) : 0)) * rowA)
#define PG8_BBASE(u) ((const char*)g.Bt + (long)(u).pn * 2 * hstepB)
#define PG8_AK(base, kt) ((base) + (long)(kt) * kstep + ((kt) >= ksplit ? ajump : 0L))
    Unit cur, nxt; int ui = 0;
    if (!S.next(0, cur)) return;
    f32x4 acc[2][2][4][2];
#pragma unroll
    for (int a = 0; a < 2; ++a)
#pragma unroll
        for (int b = 0; b < 2; ++b)
#pragma unroll
            for (int m = 0; m < 4; ++m)
#pragma unroll
                for (int n = 0; n < 2; ++n) acc[a][b][m][n] = (f32x4){0.f, 0.f, 0.f, 0.f};
    bf16x8 At[4][2], B0[2][2], B1[2][2];
    const char* cA = PG8_ABASE(cur); const char* cB = PG8_BBASE(cur);
#ifndef PG8_SP2
#define PG8_SP2 1
#endif
#if PG8_SP2
    PG8_STAGE(PG8_SB(0, 0), cB, voffB); PG8_STAGE(PG8_SB(0, 1), cB + hstepB, voffB); PG8_STAGE(PG8_SA(0, 0), cA, voffA); PG8_STAGE(PG8_SA(0, 1), cA + hstepA, voffA);
    if (wr == 1) PG8_BAR;
    PG8_WAIT_V(2); PG8_BAR;
    { const char* a1p = PG8_AK(cA, 1);
      PG8_STAGE(PG8_SB(1, 0), cB + kstep, voffB); PG8_STAGE(PG8_SA(1, 0), a1p, voffA); PG8_STAGE(PG8_SB(1, 1), cB + hstepB + kstep, voffB); }
    PG8_WAIT_V(6); PG8_BAR;
#else
    PG8_STAGE(PG8_SB(0, 0), cB, voffB); PG8_STAGE(PG8_SA(0, 0), cA, voffA); PG8_STAGE(PG8_SB(0, 1), cB + hstepB, voffB); PG8_STAGE(PG8_SA(0, 1), cA + hstepA, voffA);
    if (wr == 1) PG8_BAR;
    PG8_WAIT_V(4); PG8_BAR;
    { const char* a1p = PG8_AK(cA, 1);
      PG8_STAGE(PG8_SB(1, 0), cB + kstep, voffB); PG8_STAGE(PG8_SA(1, 0), a1p, voffA); PG8_STAGE(PG8_SB(1, 1), cB + hstepB + kstep, voffB); }
    PG8_WAIT_V(6); PG8_BAR;
#endif
    for (;;) {
        const bool has_next = S.next(ui + 1, nxt);
        const char* nA = has_next ? PG8_ABASE(nxt) : cA; const char* nB = has_next ? PG8_BBASE(nxt) : cB;
        for (int t = 0; t < nt; t += 2) {
            const bool last = (t == nt - 2);
            const char* a1 = PG8_AK(cA, t + 1);
            const char* a2 = last ? nA : PG8_AK(cA, t + 2); const char* b2 = last ? nB : cB + (long)(t + 2) * kstep;
            const char* a3 = last ? PG8_AK(nA, 1) : PG8_AK(cA, t + 3); const char* b3 = b2 + kstep;
#if PG8_SP2
            PG8_LDB(B0, 0, 0); PG8_LDB(B1, 0, 1); PG8_SCHED; PG8_LDA(At, 0, 0); PG8_STAGE(PG8_SA(1, 1), a1 + hstepA, voffA);
            PG8_WAIT_V(8); PG8_WAIT_L(0); PG8_BAR; PG8_MMA(0, 0, At, B0); PG8_MMA(0, 1, At, B1); PG8_BAR; PG8_SCHED;
            PG8_LDA(At, 0, 1); PG8_STAGE(PG8_SB(0, 0), b2, voffB); PG8_STAGE(PG8_SB(0, 1), b2 + hstepB, voffB); PG8_STAGE(PG8_SA(0, 0), a2, voffA);
            PG8_WAIT_V(8); PG8_WAIT_L(0); PG8_BAR; PG8_MMA(1, 0, At, B0); PG8_MMA(1, 1, At, B1); PG8_BAR; PG8_SCHED;
            PG8_LDB(B0, 1, 0); PG8_LDB(B1, 1, 1); PG8_SCHED; PG8_LDA(At, 1, 0); PG8_STAGE(PG8_SA(0, 1), a2 + hstepA, voffA);
            PG8_WAIT_V(8); PG8_WAIT_L(0); PG8_BAR; PG8_MMA(0, 0, At, B0); PG8_MMA(0, 1, At, B1); PG8_BAR; PG8_SCHED;
            PG8_LDA(At, 1, 1); PG8_STAGE(PG8_SB(1, 0), b3, voffB); PG8_STAGE(PG8_SB(1, 1), b3 + hstepB, voffB); PG8_STAGE(PG8_SA(1, 0), a3, voffA);
            PG8_WAIT_V(8); PG8_WAIT_L(0); PG8_BAR; PG8_MMA(1, 0, At, B0); PG8_MMA(1, 1, At, B1); PG8_BAR; PG8_SCHED;
#else
            PG8_LDB(B0, 0, 0); PG8_SCHED; PG8_LDA(At, 0, 0); PG8_STAGE(PG8_SA(1, 1), a1 + hstepA, voffA);
            PG8_WAIT_L(8); PG8_BAR; PG8_WAIT_L(0); PG8_MMA(0, 0, At, B0); PG8_BAR; PG8_SCHED;
            PG8_LDB(B1, 0, 1); PG8_STAGE(PG8_SB(0, 0), b2, voffB);
            PG8_BAR; PG8_WAIT_L(0); PG8_MMA(0, 1, At, B1); PG8_BAR;
            PG8_LDA(At, 0, 1); PG8_STAGE(PG8_SA(0, 0), a2, voffA);
            PG8_BAR; PG8_WAIT_L(0); PG8_MMA(1, 0, At, B0); PG8_BAR; PG8_SCHED;
            PG8_STAGE(PG8_SB(0, 1), b2 + hstepB, voffB);
            PG8_WAIT_V(6); PG8_BAR; PG8_MMA(1, 1, At, B1); PG8_BAR;
            PG8_LDB(B0, 1, 0); PG8_SCHED; PG8_LDA(At, 1, 0); PG8_STAGE(PG8_SA(0, 1), a2 + hstepA, voffA);
            PG8_WAIT_L(8); PG8_BAR; PG8_WAIT_L(0); PG8_MMA(0, 0, At, B0); PG8_BAR; PG8_SCHED;
            PG8_LDB(B1, 1, 1); PG8_STAGE(PG8_SB(1, 0), b3, voffB);
            PG8_BAR; PG8_WAIT_L(0); PG8_MMA(0, 1, At, B1); PG8_BAR;
            PG8_LDA(At, 1, 1); PG8_STAGE(PG8_SA(1, 0), a3, voffA);
            PG8_BAR; PG8_WAIT_L(0); PG8_MMA(1, 0, At, B0); PG8_BAR; PG8_SCHED;
            PG8_STAGE(PG8_SB(1, 1), b3 + hstepB, voffB);
            PG8_WAIT_V(6); PG8_BAR; PG8_MMA(1, 1, At, B1); PG8_BAR;
#endif
        }
#ifndef PG8_ALIGN
#define PG8_ALIGN 1
#endif
        if (PG8_ALIGN && wr == 0) PG8_BAR;
        E(acc, cur, wr, wc, fr, fq);
        if (!has_next) break;
#pragma unroll
        for (int a = 0; a < 2; ++a)
#pragma unroll
            for (int b = 0; b < 2; ++b)
#pragma unroll
                for (int m = 0; m < 4; ++m)
#pragma unroll
                    for (int n = 0; n < 2; ++n) acc[a][b][m][n] = (f32x4){0.f, 0.f, 0.f, 0.f};
        cur = nxt; cA = nA; cB = nB; ++ui;
        if (PG8_ALIGN && wr == 1) PG8_BAR;
    }
    PG8_WAIT_V(0);
    if (!PG8_ALIGN && wr == 0) PG8_BAR;
    PG8_BAR;
#undef PG8_SA
#undef PG8_SB
#undef PG8_STAGE
#undef PG8_LDA
#undef PG8_LDB
#undef PG8_MMA
#undef PG8_WAIT_V
#undef PG8_WAIT_L
#undef PG8_BAR
#undef PG8_SCHED
#undef PG8_ABASE
#undef PG8_BBASE
#undef PG8_AK
}

typedef f32x4 Acc[2][2][4][2];
#define EPI_ROWS(u, wr, fr, ai, m) ((u).pm * BM + (ai) * HALF + (wr) * 64 + (m) * 16 + (fr))

struct EpiBf16 {
    static constexpr bool PERM = true;
    bf16_t* O; int ldc; const i64* ssq; const float* rowscale; const float* bias; int row_off;
    int mpm = 0, mpn = 0;
    __device__ __forceinline__ void operator()(const Acc& acc, const Unit& u, int wr, int wc, int fr, int fq) const {
        const int col0 = u.pn * BM + wc * 32 + 8 * fq;
#pragma unroll
        for (int ai = 0; ai < 2; ++ai)
#pragma unroll
            for (int m = 0; m < 4; ++m) {
                const int row = EPI_ROWS(u, wr, fr, ai, m);
                float rs = 1.0f;
                if (ssq) rs = rstd_from_ssq(ssq[row + row_off], 1.0f / 1024.0f, 1e-6f);
                else if (rowscale) rs = rowscale[row + row_off];
                bf16_t* rowp = (mpm | mpn) ? O + ((size_t)(u.pm * mpm + u.pn * mpn) << 16) + (row & 255) * 256 + (col0 & 255) : O + (size_t)row * ldc + col0;
#pragma unroll
                for (int bj = 0; bj < 2; ++bj) {
                    f32x4 v0 = acc[ai][bj][m][0] * rs, v1 = acc[ai][bj][m][1] * rs;
                    if (bias) { v0 += *(const f32x4*)(bias + col0 + bj * HALF); v1 += *(const f32x4*)(bias + col0 + bj * HALF + 4); }
                    u32x4 w; w.x = pk2(v0[0], v0[1]); w.y = pk2(v0[2], v0[3]); w.z = pk2(v1[0], v1[1]); w.w = pk2(v1[2], v1[3]);
                    *(u32x4*)(rowp + bj * HALF) = w;
                }
            }
    }
};
struct EpiBf16ColScale {
    static constexpr bool PERM = true;
    bf16_t* O; int ldc; const float* colscale;
    int mpm = 0, mpn = 0;
    __device__ __forceinline__ void operator()(const Acc& acc, const Unit& u, int wr, int wc, int fr, int fq) const {
        const int col0 = u.pn * BM + wc * 32 + 8 * fq;
        f32x4 cs[2][2];
#pragma unroll
        for (int bj = 0; bj < 2; ++bj) { cs[bj][0] = *(const f32x4*)(colscale + col0 + bj * HALF); cs[bj][1] = *(const f32x4*)(colscale + col0 + bj * HALF + 4); }
#pragma unroll
        for (int ai = 0; ai < 2; ++ai)
#pragma unroll
            for (int m = 0; m < 4; ++m) {
                const int row = EPI_ROWS(u, wr, fr, ai, m);
                bf16_t* rowp = (mpm | mpn) ? O + ((size_t)(u.pm * mpm + u.pn * mpn) << 16) + (row & 255) * 256 + (col0 & 255) : O + (size_t)row * ldc + col0;
#pragma unroll
                for (int bj = 0; bj < 2; ++bj) {
                    const f32x4 v0 = acc[ai][bj][m][0] * cs[bj][0], v1 = acc[ai][bj][m][1] * cs[bj][1];
                    u32x4 w; w.x = pk2(v0[0], v0[1]); w.y = pk2(v0[2], v0[3]); w.z = pk2(v1[0], v1[1]); w.w = pk2(v1[2], v1[3]);
                    if (row & 16) { const unsigned t0 = w.x, t1 = w.y; w.x = w.z; w.y = w.w; w.z = t0; w.w = t1; }
                    *(u32x4*)(rowp + bj * HALF) = w;
                }
            }
    }
};
template <int MODE> struct EpiGated {
    static constexpr bool PERM = true;
    bf16_t* O; int ldc; const i64* ssq; const float* biasA; const float* biasB;
    __device__ __forceinline__ void operator()(const Acc& acc, const Unit& u, int wr, int wc, int fr, int fq) const {
        const int col0 = u.pn * HALF + wc * 32 + 8 * fq;
        f32x4 ba[2], bb[2];
        if (MODE == 1) { ba[0] = *(const f32x4*)(biasA + col0); ba[1] = *(const f32x4*)(biasA + col0 + 4); bb[0] = *(const f32x4*)(biasB + col0); bb[1] = *(const f32x4*)(biasB + col0 + 4); }
#pragma unroll
        for (int ai = 0; ai < 2; ++ai)
#pragma unroll
            for (int m = 0; m < 4; ++m) {
                const int row = EPI_ROWS(u, wr, fr, ai, m);
                const float rs = rstd_from_ssq(ssq[row], 1.0f / 1024.0f, 1e-6f);
                float o[8];
                if (MODE == 0) {
                    const float rsl = rs * 1.4426950408889634f, rsi = rs * 0.6931471805599453f;
#pragma unroll
                    for (int n = 0; n < 2; ++n)
#pragma unroll
                        for (int j = 0; j < 4; j += 2) {
                            const f32x2 t = (f32x2){acc[ai][0][m][n][j], acc[ai][0][m][n][j + 1]} * rsl;
                            const f32x2 ub = (f32x2){acc[ai][1][m][n][j], acc[ai][1][m][n][j + 1]} * rsi;
                            const f32x2 d = (f32x2){__builtin_amdgcn_exp2f(-t[0]), __builtin_amdgcn_exp2f(-t[1])} + 1.0f;
                            const f32x2 r = {__builtin_amdgcn_rcpf(d[0]), __builtin_amdgcn_rcpf(d[1])};
                            const f32x2 res = (t * r) * ub;
                            o[n * 4 + j] = res[0]; o[n * 4 + j + 1] = res[1];
                        }
                } else {
                    const float rsl = rs * 1.4426950408889634f;
#pragma unroll
                    for (int n = 0; n < 2; ++n)
#pragma unroll
                        for (int j = 0; j < 4; j += 2) {
                            const f32x2 tz = (f32x2){acc[ai][1][m][n][j], acc[ai][1][m][n][j + 1]} * rsl + (f32x2){bb[n][j], bb[n][j + 1]} * 1.4426950408889634f;
                            const f32x2 av = (f32x2){acc[ai][0][m][n][j], acc[ai][0][m][n][j + 1]} * rs + (f32x2){ba[n][j], ba[n][j + 1]};
                            const f32x2 d = (f32x2){__builtin_amdgcn_exp2f(-tz[0]), __builtin_amdgcn_exp2f(-tz[1])} + 1.0f;
                            const f32x2 r = {__builtin_amdgcn_rcpf(d[0]), __builtin_amdgcn_rcpf(d[1])};
                            const f32x2 res = av * r;
                            o[n * 4 + j] = res[0]; o[n * 4 + j + 1] = res[1];
                        }
                }
                u32x4 w; w.x = pk2(o[0], o[1]); w.y = pk2(o[2], o[3]); w.z = pk2(o[4], o[5]); w.w = pk2(o[6], o[7]);
                *(u32x4*)(O + (size_t)row * ldc + col0) = w;
            }
    }
};
struct EpiResid {
    static constexpr bool PERM = true;
    bf16_t* Xb; i64* ssq_out; const float* bias; int row_off;
    __device__ __forceinline__ void operator()(const Acc& acc, const Unit& u, int wr, int wc, int fr, int fq) const {
        const int col0 = u.pn * BM + wc * 32 + 8 * fq;
#pragma unroll
        for (int ai = 0; ai < 2; ++ai)
#pragma unroll
            for (int m = 0; m < 4; ++m) {
                const int row = EPI_ROWS(u, wr, fr, ai, m) + row_off;
                bf16_t* xb = Xb + (size_t)row * D + col0;
                float ss = 0.f;
#pragma unroll
                for (int bj = 0; bj < 2; ++bj) {
                    const u32x4 xo = *(const u32x4*)(xb + bj * HALF);
                    f32x4 v0 = (f32x4){bf_lo(xo.x), bf_hi(xo.x), bf_lo(xo.y), bf_hi(xo.y)} + acc[ai][bj][m][0];
                    f32x4 v1 = (f32x4){bf_lo(xo.z), bf_hi(xo.z), bf_lo(xo.w), bf_hi(xo.w)} + acc[ai][bj][m][1];
                    if (bias) { v0 += *(const f32x4*)(bias + col0 + bj * HALF); v1 += *(const f32x4*)(bias + col0 + bj * HALF + 4); }
                    u32x4 w; w.x = pk2(v0[0], v0[1]); w.y = pk2(v0[2], v0[3]); w.z = pk2(v1[0], v1[1]); w.w = pk2(v1[2], v1[3]);
                    *(u32x4*)(xb + bj * HALF) = w;
                    ss += ((v0[0] * v0[0] + v0[1] * v0[1]) + (v0[2] * v0[2] + v0[3] * v0[3])) + ((v1[0] * v1[0] + v1[1] * v1[1]) + (v1[2] * v1[2] + v1[3] * v1[3]));
                }
                ss += __shfl_xor(ss, 16); ss += __shfl_xor(ss, 32);
                if (fq == 0) atomic_add_i64(ssq_out + row, (i64)(ss * SSQ_SCALE + 0.5f));
            }
    }
};
}
constexpr size_t MiB = 1u << 20;
constexpr int LDS_BYTES = 163840, RING_BYTES = 131072, LDSCTL_OFF = LDS_BYTES - 1024;

struct Inputs {
    const float *x, *mem, *mix_norm_g, *xattn_norm_g, *mem_norm_g, *xattn_wq, *xattn_wkv, *xattn_wo, *ffn_norm_g, *ffn_w_gate_up, *ffn_w_down,
        *conv_w_in, *conv_b_in, *conv_dw, *conv_dw_b, *conv_ln_g, *conv_ln_b, *conv_w_out, *conv_b_out,
        *rwkv_mix, *rwkv_w_rkv, *rwkv_w0, *rwkv_w1, *rwkv_w2, *rwkv_a0, *rwkv_a1, *rwkv_a2, *rwkv_g1, *rwkv_g2, *rwkv_k_k, *rwkv_k_a, *rwkv_r_k, *rwkv_gn_g, *rwkv_gn_b, *rwkv_w_o,
        *sgu_w_in, *sgu_b_in, *sgu_ln_g, *sgu_ln_b, *sgu_ws, *sgu_bs, *sgu_w_out, *ret_w_in, *ret_w_out, *final_norm_g;
};
struct WsMap {
    size_t ctl, ssq, lns, oss, rope, wstril, rstd_mem, wk_all, wv_all, mem_b, kall, vtall, wb0, wb1, xb, act, end;
};
__host__ __device__ inline WsMap make_wsmap(int NB) {
    WsMap w; const size_t M = (size_t)NB * T; size_t o = 0;
    w.ctl = o; o += 1 * MiB;
    w.ssq = o; o += 2 * M * 8;
    w.lns = o; o += M * 2 * 8;
    w.oss = o; o += M * 4 * 8;
    o = (o + MiB - 1) / MiB * MiB;
    w.rope = o; o += (size_t)T * 128 * 8;
    w.wstril = o; o += 8 * 128 * 128 * 2;
    w.rstd_mem = o; o += (size_t)NB * NMEM * 4; o = (o + MiB - 1) / MiB * MiB;
    w.wk_all = o; o += 8 * MiB; w.wv_all = o; o += 8 * MiB;
    w.mem_b = o; o += (size_t)NB * NMEM * D * 2; o = (o + MiB - 1) / MiB * MiB;
    w.kall = o; o += (size_t)NB * NMEM * 4096 * 2; w.vtall = o; o += (size_t)NB * NMEM * 4096 * 2; o = (o + MiB - 1) / MiB * MiB;
    w.wb0 = o; o += 37 * MiB; w.wb1 = o; o += 37 * MiB;
    w.xb = o; o += M * D * 2;
    w.act = o; o += (size_t)NB * 2048 * 8704 + 4 * MiB;
    w.end = o; return w;
}
constexpr size_t ZERO_BYTES_PER_SEQ = (size_t)T * 8 * 8;
constexpr size_t WB_WQ = 0, WB_WO = 2 * MiB, WB_GU = 4 * MiB, WB_DOWN = 15 * MiB, WB_MIX = 21 * MiB;
constexpr size_t WB_CONV_IN = WB_MIX, WB_CONV_OUT = WB_MIX + 4 * MiB;
constexpr size_t WB_RW_RKV = WB_MIX, WB_RW_L1 = WB_MIX + 6 * MiB, WB_RW_W2 = WB_MIX + 8 * MiB, WB_RW_A2 = WB_RW_W2 + MiB / 2, WB_RW_G2 = WB_RW_W2 + MiB, WB_RW_WO = WB_MIX + 10 * MiB;
constexpr size_t WB_SGU_IN = WB_MIX, WB_SGU_OUT = WB_MIX + 8 * MiB;
constexpr size_t WB_RET_QKV = WB_MIX, WB_RET_G = WB_MIX + 8 * MiB, WB_RET_OUT = WB_MIX + 12 * MiB;

struct Args { Inputs in; float* out; unsigned char* ws; const float* load_src; int NB, ph_lo, ph_hi, use_bar, load_slot, conv_layer_p1, dump_xb, pad; };

struct Frame {
    LAS unsigned char* lds;
    int wave, vcu, G, gw, NGW;
    mutable int conv_rot;
    int NB, M;
    unsigned char* ws; WsMap wm;
    bf16_t* Xb; i64* ssq; i64* lns; i64* oss;
};

struct WConv { const float* src; int src_ld, Ksrc, koff, Kdst, kd0, kd1; bf16_t* dst; int nrows, nvalid, map_blk, map_halfoff, col0; const float* kvec; float sa, sb, cscale; };
__device__ __forceinline__ WConv wconv(const float* src, int src_ld, int Ksrc, bf16_t* dst, int nrows, int Kdst) {
    WConv w; w.src = src; w.src_ld = src_ld; w.Ksrc = Ksrc; w.koff = 0; w.Kdst = Kdst; w.kd0 = 0; w.kd1 = Kdst; w.dst = dst; w.nrows = nrows; w.nvalid = nrows; w.map_blk = 0; w.map_halfoff = 0; w.col0 = 0;
    w.kvec = nullptr; w.sa = 1.f; w.sb = 0.f; w.cscale = 1.f; return w;
}
__device__ __forceinline__ void convert_w(const Frame& F, const WConv& w) {
    LAS float* scr = (LAS float*)(F.lds + F.wave * 16384);
    const int nblk = w.nrows / 32, kblk = (w.kd1 - w.kd0) / 64, nitems = nblk * kblk, lane = opaque_tid() & 63;
    const int kq = lane >> 3, nq = lane & 7;
    int first = F.gw - F.conv_rot; if (first < 0) first += F.NGW;
    F.conv_rot = (F.conv_rot + nitems) % F.NGW;
    for (int it = first; it < nitems; it += F.NGW) {
        const int kb = it / nblk, nb = it % nblk, k0 = w.kd0 + 64 * kb, n0 = 32 * nb;
        const int n = n0 + 4 * nq;
        int col = w.col0 + n;
        if (w.map_blk) { const int b2 = 2 * w.map_blk; col = w.col0 + ((n % b2) / w.map_blk) * w.map_halfoff + (n / b2) * w.map_blk + n % w.map_blk; }
        f32x4 v[8]; float kvs[8];
        const float* kvp = w.kvec ? w.kvec : w.src;
#pragma unroll
        for (int i = 0; i < 8; ++i) {
            const int k = k0 + kq + 8 * i - w.koff;
            v[i] = (k >= 0 && k < w.Ksrc && n < w.nvalid) ? *(const f32x4*)(w.src + (size_t)k * w.src_ld + col) : (f32x4){0.f, 0.f, 0.f, 0.f};
            kvs[i] = kvp[k < 0 ? 0 : (k < w.Ksrc ? k : w.Ksrc - 1)];
        }
#pragma unroll
        for (int i = 0; i < 8; ++i) {
            const int kk = kq + 8 * i, k = k0 + kk - w.koff;
            float sc = w.cscale; if (w.kvec && k >= 0 && k < w.Ksrc) sc *= (w.sa + w.sb * kvs[i]);
            LAS float* d = scr + kk * 37 + 4 * nq;
            d[0] = v[i][0] * sc; d[1] = v[i][1] * sc; d[2] = v[i][2] * sc; d[3] = v[i][3] * sc;
        }
        asm volatile("s_waitcnt lgkmcnt(0)" ::: "memory");
        const int c = lane & 7;
#pragma unroll
        for (int j = 0; j < 4; ++j) { const int nn = (lane >> 3) + 8 * j; const LAS float* s = scr + (8 * c) * 37 + nn;
            u32x4 o; o.x = pk2(s[0 * 37], s[1 * 37]); o.y = pk2(s[2 * 37], s[3 * 37]); o.z = pk2(s[4 * 37], s[5 * 37]); o.w = pk2(s[6 * 37], s[7 * 37]);
            *(u32x4*)(w.dst + (size_t)(n0 + nn) * w.Kdst + k0 + 8 * c) = o; }
        asm volatile("s_waitcnt lgkmcnt(0)" ::: "memory");
    }
}
__device__ __forceinline__ void convert_layer_weights(const Frame& F, const Inputs& I, int L, unsigned char* wb) {
    const size_t DD = (size_t)D * D;
    { WConv w = wconv(I.xattn_wq + L * DD, D, D, (bf16_t*)(wb + WB_WQ), D, D); w.kvec = I.xattn_norm_g + L * D; w.sa = 0.f; w.sb = 1.f; w.cscale = 0.0625f * 1.4426950408889634f; convert_w(F, w); }
    { WConv w = wconv(I.xattn_wo + L * DD, D, D, (bf16_t*)(wb + WB_WO), D, D); convert_w(F, w); }
    { WConv w = wconv(I.ffn_w_gate_up + (size_t)L * D * 2 * FF, 2 * FF, D, (bf16_t*)(wb + WB_GU), 2 * FF, D); w.kvec = I.ffn_norm_g + L * D; w.sa = 0.f; w.sb = 1.f; w.map_blk = 128; w.map_halfoff = FF; convert_w(F, w); }
    { WConv w = wconv(I.ffn_w_down + (size_t)L * FF * D, D, FF, (bf16_t*)(wb + WB_DOWN), D, FF); convert_w(F, w); }
    if (L == 0) {
        { WConv w = wconv(I.conv_w_in, 2 * D, D, (bf16_t*)(wb + WB_CONV_IN), 2 * D, D); w.kvec = I.mix_norm_g; w.sa = 0.f; w.sb = 1.f; w.map_blk = 128; w.map_halfoff = D; convert_w(F, w); }
        { WConv w = wconv(I.conv_w_out, D, D, (bf16_t*)(wb + WB_CONV_OUT), D, D); convert_w(F, w); }
    } else if (L == 1) {
        for (int i = 0; i < 3; ++i) { WConv w = wconv(I.rwkv_w_rkv + i * DD, D, D, (bf16_t*)(wb + WB_RW_RKV) + i * DD, D, D); convert_w(F, w); }
        bf16_t* l1 = (bf16_t*)(wb + WB_RW_L1);
        for (int part = 0; part < 2; ++part) {
            const float sa = part ? 0.f : 1.f, sb = part ? 1.f : -1.f; const int kd0 = part * D, kd1 = kd0 + D;
            { WConv w = wconv(I.rwkv_w1, 64, D, l1, 64, 2 * D); w.kvec = I.rwkv_mix + 1 * D; w.sa = sa; w.sb = sb; w.koff = kd0; w.kd0 = kd0; w.kd1 = kd1; convert_w(F, w); }
            { WConv w = wconv(I.rwkv_a1, 64, D, l1 + 64 * 2 * D, 64, 2 * D); w.kvec = I.rwkv_mix + 4 * D; w.sa = sa; w.sb = sb; w.koff = kd0; w.kd0 = kd0; w.kd1 = kd1; convert_w(F, w); }
            { WConv w = wconv(I.rwkv_g1, 160, D, l1 + 128 * 2 * D, 384, 2 * D); w.nvalid = 160; w.kvec = I.rwkv_mix + 5 * D; w.sa = sa; w.sb = sb; w.koff = kd0; w.kd0 = kd0; w.kd1 = kd1; convert_w(F, w); }
        }
        { WConv w = wconv(I.rwkv_w2, D, 64, (bf16_t*)(wb + WB_RW_W2), D, 256); convert_w(F, w); }
        { WConv w = wconv(I.rwkv_a2, D, 64, (bf16_t*)(wb + WB_RW_A2), D, 256); w.koff = 64; convert_w(F, w); }
        { WConv w = wconv(I.rwkv_g2, D, 160, (bf16_t*)(wb + WB_RW_G2), D, 256); convert_w(F, w); }
        { WConv w = wconv(I.rwkv_w_o, D, D, (bf16_t*)(wb + WB_RW_WO), D, D); convert_w(F, w); }
    } else if (L == 2) {
        { WConv w = wconv(I.sgu_w_in, 4096, D, (bf16_t*)(wb + WB_SGU_IN), 4096, D); w.kvec = I.mix_norm_g + 2 * D; w.sa = 0.f; w.sb = 1.f; convert_w(F, w); }
        { WConv w = wconv(I.sgu_w_out, D, 2048, (bf16_t*)(wb + WB_SGU_OUT), D, 2048); convert_w(F, w); }
    } else {
        for (int part = 0; part < 3; ++part) {
            const int c0 = part == 0 ? 0 : (part == 1 ? 1024 : 2048), nr = part == 2 ? 2048 : 1024;
            WConv w = wconv(I.ret_w_in, 6144, D, (bf16_t*)(wb + WB_RET_QKV) + (size_t)c0 * D, nr, D); w.col0 = c0; w.kvec = I.mix_norm_g + 3 * D; w.sa = 0.f; w.sb = 1.f; w.cscale = part == 1 ? 0.0625f : 1.f; convert_w(F, w);
        }
        { WConv w = wconv(I.ret_w_in, 6144, D, (bf16_t*)(wb + WB_RET_G), 2048, D); w.col0 = 4096; w.kvec = I.mix_norm_g + 3 * D; w.sa = 0.f; w.sb = 1.f; convert_w(F, w); }
        { WConv w = wconv(I.ret_w_out, D, 2048, (bf16_t*)(wb + WB_RET_OUT), D, 2048); convert_w(F, w); }
    }
}

__device__ __forceinline__ void load_rows(const Frame& F, const float* src, float* X, bf16_t* Xb, i64* ssq_slot, int nrows) {
    const int lane = opaque_tid() & 63;
    for (int r0 = F.gw; r0 < nrows; r0 += 2 * F.NGW) {
        const int r1 = (r0 + F.NGW < nrows) ? r0 + F.NGW : r0;
        const f32x4* s0 = (const f32x4*)(src + (size_t)r0 * D) + lane; const f32x4* s1 = (const f32x4*)(src + (size_t)r1 * D) + lane;
        f32x4 v0[4], v1[4];
#pragma unroll
        for (int j = 0; j < 4; ++j) { v0[j] = s0[64 * j]; v1[j] = s1[64 * j]; }
        float ss0 = 0.f, ss1 = 0.f;
#pragma unroll
        for (int j = 0; j < 4; ++j) { ss0 += (v0[j][0] * v0[j][0] + v0[j][1] * v0[j][1]) + (v0[j][2] * v0[j][2] + v0[j][3] * v0[j][3]); ss1 += (v1[j][0] * v1[j][0] + v1[j][1] * v1[j][1]) + (v1[j][2] * v1[j][2] + v1[j][3] * v1[j][3]); }
        ss0 = wave_sum(ss0); ss1 = wave_sum(ss1);
        if (X) { f32x4* d0 = (f32x4*)(X + (size_t)r0 * D) + lane; f32x4* d1 = (f32x4*)(X + (size_t)r1 * D) + lane;
#pragma unroll
            for (int j = 0; j < 4; ++j) { d0[64 * j] = v0[j]; d1[64 * j] = v1[j]; } }
        u32x2* b0 = (u32x2*)(Xb + (size_t)r0 * D) + lane; u32x2* b1 = (u32x2*)(Xb + (size_t)r1 * D) + lane;
#pragma unroll
        for (int j = 0; j < 4; ++j) { u32x2 w; w.x = pk2(v0[j][0], v0[j][1]); w.y = pk2(v0[j][2], v0[j][3]); b0[64 * j] = w; w.x = pk2(v1[j][0], v1[j][1]); w.y = pk2(v1[j][2], v1[j][3]); b1[64 * j] = w; }
        if (lane == 0) { ssq_slot[r0] = (i64)(ss0 * SSQ_SCALE + 0.5f); ssq_slot[r1] = (i64)(ss1 * SSQ_SCALE + 0.5f); }
    }
}
__device__ __forceinline__ void load_mem_rows(const Frame& F, const float* src, bf16_t* mb, float* rstd, int nrows) {
    const int lane = opaque_tid() & 63;
    for (int r = F.gw; r < nrows; r += F.NGW) {
        const f32x4* s = (const f32x4*)(src + (size_t)r * D) + lane; f32x4 v[4]; float ss = 0.f;
#pragma unroll
        for (int j = 0; j < 4; ++j) { v[j] = s[64 * j]; ss += (v[j][0] * v[j][0] + v[j][1] * v[j][1]) + (v[j][2] * v[j][2] + v[j][3] * v[j][3]); }
        ss = wave_sum(ss);
        u32x2* db = (u32x2*)(mb + (size_t)r * D) + lane;
#pragma unroll
        for (int j = 0; j < 4; ++j) { u32x2 w; w.x = pk2(v[j][0], v[j][1]); w.y = pk2(v[j][2], v[j][3]); db[64 * j] = w; }
        if (lane == 0) rstd[r] = rsqrtf(ss * (1.0f / D) + 1e-6f);
    }
}
__device__ __forceinline__ void zero_i64(const Frame& F, i64* p, size_t n) {
    const int lane = opaque_tid() & 63;
    for (size_t i = (size_t)F.gw * 64 + lane; i < n; i += (size_t)F.NGW * 64) p[i] = 0;
}
__device__ __forceinline__ void final_norm(const Frame& F, const bf16_t* Xb, float* out, const i64* ssq_slot, const float* g, int nrows) {
    const int lane = opaque_tid() & 63;
    f32x4 gv[4];
#pragma unroll
    for (int j = 0; j < 4; ++j) gv[j] = ((const f32x4*)g)[lane + 64 * j];
    for (int r0 = F.gw; r0 < nrows; r0 += 2 * F.NGW) {
        const int r1 = (r0 + F.NGW < nrows) ? r0 + F.NGW : r0;
        const float rs0 = rstd_from_ssq(ssq_slot[r0], 1.0f / D, 1e-6f), rs1 = rstd_from_ssq(ssq_slot[r1], 1.0f / D, 1e-6f);
        const u32x2* s0 = (const u32x2*)(Xb + (size_t)r0 * D) + lane; const u32x2* s1 = (const u32x2*)(Xb + (size_t)r1 * D) + lane;
        u32x2 u0[4], u1[4];
#pragma unroll
        for (int j = 0; j < 4; ++j) { u0[j] = s0[64 * j]; u1[j] = s1[64 * j]; }
        f32x4* d0 = (f32x4*)(out + (size_t)r0 * D) + lane; f32x4* d1 = (f32x4*)(out + (size_t)r1 * D) + lane;
#pragma unroll
        for (int j = 0; j < 4; ++j) {
            d0[64 * j] = (f32x4){bf_lo(u0[j].x), bf_hi(u0[j].x), bf_lo(u0[j].y), bf_hi(u0[j].y)} * rs0 * gv[j];
            d1[64 * j] = (f32x4){bf_lo(u1[j].x), bf_hi(u1[j].x), bf_lo(u1[j].y), bf_hi(u1[j].y)} * rs1 * gv[j];
        }
    }
}
__device__ __forceinline__ void dump_rows(const Frame& F, const bf16_t* Xb, float* out, int nrows) {
    const int lane = opaque_tid() & 63;
    for (int r = F.gw; r < nrows; r += F.NGW) {
        const u32x2* s = (const u32x2*)(Xb + (size_t)r * D) + lane; f32x4* d = (f32x4*)(out + (size_t)r * D) + lane;
#pragma unroll
        for (int j = 0; j < 4; ++j) { const u32x2 u = s[64 * j]; d[64 * j] = (f32x4){bf_lo(u.x), bf_hi(u.x), bf_lo(u.y), bf_hi(u.y)}; }
    }
}
__device__ __forceinline__ void make_tables(const Frame& F, const Inputs& I) {
    const int lane = opaque_tid() & 63;
    f32x2* rope = (f32x2*)(F.ws + F.wm.rope);
    for (int i = F.gw * 64 + lane; i < T * 128; i += F.NGW * 64) { const int t = i >> 7, p = i & 127; const float ang = powf(10000.0f, -(float)p / 127.0f), th = (float)t * ang; rope[i] = (f32x2){cosf(th), sinf(th)}; }
    bf16_t* wt = (bf16_t*)(F.ws + F.wm.wstril);
    for (int i = F.gw * 64 + lane; i < 8 * 128 * 128; i += F.NGW * 64) { const int t = (i >> 7) & 127, s = i & 127; wt[i] = (s <= t) ? (bf16_t)(pk2(I.sgu_ws[i], 0.f) & 0xffffu) : (bf16_t)0; }
}
#define RW_BAR() do { asm volatile("s_waitcnt lgkmcnt(0)" ::: "memory"); __builtin_amdgcn_s_barrier(); asm volatile("" ::: "memory"); } while (0)
#ifndef AT_PROBE
#define AT_PROBE 0
#endif
#define AT_T(k) do { if (AT_PROBE) { const unsigned long long now_ = __builtin_amdgcn_s_memrealtime(); if (AT_PROBE == (k)) pr_acc += now_ - at_last; at_last = now_; } } while (0)
__device__ __forceinline__ void attn_phase(const Frame& F, bf16_t* Q, const bf16_t* Kall, const bf16_t* Vtall, int L, unsigned long long& pr_acc) {
    const int tid = opaque_tid(), lane = tid & 63, wave = F.wave;
    const int q = lane & 31, hh = lane >> 5;
    const int nunits = F.NB * 4 * (T / 256);
    const int ldv = F.NB * NMEM;
    LAS unsigned char* lds = F.lds;
    const int dpos = lane & 31, drow0 = 32 * wave + (lane >> 5);
    bf16x8 qn[4];
    if (F.vcu < nunits) { const int u = F.vcu, qb = u % (T / 256), h = (u / (T / 256)) % 4, b = u / (4 * (T / 256));
        const bf16_t* qr = Q + (size_t)(b * T + qb * 256 + wave * 32 + q) * D + h * 256;
#pragma unroll
        for (int j = 0; j < 4; ++j) qn[j] = *(const bf16x8*)(qr + 16 * j + 8 * hh); }
    for (int u = F.vcu; u < nunits; u += F.G) {
        const int qb = u % (T / 256), h = (u / (T / 256)) % 4, b = u / (4 * (T / 256));
        unsigned long long at_last = 0ull; if (AT_PROBE) at_last = __builtin_amdgcn_s_memrealtime();
        {
            const bf16_t* kg = Kall + ((size_t)((L * 4 + h) * F.NB + b) << 16);
#pragma unroll 4
            for (int i = 0; i < 16; ++i) { const int row = drow0 + 2 * i, ch = dpos ^ (row & 15);
                __builtin_amdgcn_global_load_lds((const unsigned*)(kg + row * 256 + ch * 8), (LAS unsigned*)(lds + (16 * wave + i) * 1024), 16, 0, 0); }
        }
        bf16_t* qrow = Q + (size_t)(b * T + qb * 256 + wave * 32 + q) * D + h * 256;
        bf16_t* obase = Q + (size_t)(b * T + qb * 256 + wave * 32) * D + h * 256;
        asm volatile("s_waitcnt vmcnt(0)" ::: "memory");
        __syncthreads();
        AT_T(1);
        f32x16 sacc[8];
#pragma unroll
        for (int kb = 0; kb < 8; ++kb)
#pragma unroll
            for (int i = 0; i < 16; ++i) sacc[kb][i] = 0.f;
#pragma unroll 1
        for (int s = 0; s < 16; s += 4) {
            bf16x8 qc[4];
#pragma unroll
            for (int j = 0; j < 4; ++j) qc[j] = qn[j];
            const int sn = (s + 4 < 16) ? s + 4 : 12;
#pragma unroll
            for (int j = 0; j < 4; ++j) qn[j] = *(const bf16x8*)(qrow + 16 * (sn + j) + 8 * hh);
            const int qm = q & 15;
#pragma unroll
            for (int j = 0; j < 4; ++j) {
                const int ko = ((2 * (s + j) + hh) ^ qm) << 4;
#pragma unroll
                for (int kb = 0; kb < 8; ++kb) {
                    const bf16x8 kf = *(const LAS bf16x8*)(lds + (32 * kb + q) * 512 + ko);
                    sacc[kb] = __builtin_amdgcn_mfma_f32_32x32x16_bf16(kf, qc[j], sacc[kb], 0, 0, 0);
                }
            }
        }
        AT_T(2);
        RW_BAR();
        {
            const bf16_t* vg = Vtall + ((size_t)((L * 4 + h) * F.NB + b) << 16);
#pragma unroll 4
            for (int i = 0; i < 16; ++i) { const int row = drow0 + 2 * i, ch = dpos ^ (row & 15);
                __builtin_amdgcn_global_load_lds((const unsigned*)(vg + row * 256 + ch * 8), (LAS unsigned*)(lds + (16 * wave + i) * 1024), 16, 0, 0); }
        }
        float mx = -3.0e38f;
#pragma unroll
        for (int kb = 0; kb < 8; ++kb)
#pragma unroll
            for (int i = 0; i < 16; ++i) mx = fmaxf(mx, sacc[kb][i]);
        mx = fmaxf(mx, __shfl_xor(mx, 32));
        float sum = 0.f;
        bf16x8 pf[8][2];
#pragma unroll
        for (int kb = 0; kb < 8; ++kb) {
            float p[16];
#pragma unroll
            for (int i = 0; i < 16; ++i) { p[i] = __builtin_amdgcn_exp2f(sacc[kb][i] - mx); sum += p[i]; }
#pragma unroll
            for (int s = 0; s < 2; ++s) { u32x4 w; w.x = pk2(p[8 * s + 0], p[8 * s + 1]); w.y = pk2(p[8 * s + 2], p[8 * s + 3]); w.z = pk2(p[8 * s + 4], p[8 * s + 5]); w.w = pk2(p[8 * s + 6], p[8 * s + 7]);
                pf[kb][s] = __builtin_bit_cast(bf16x8, w); }
        }
        sum += __shfl_xor(sum, 32);
        const float inv = 1.0f / sum;
        AT_T(3);
        asm volatile("s_waitcnt vmcnt(0)" ::: "memory");
        __syncthreads();
        AT_T(4);
        {
            const int un = (u + F.G < nunits) ? u + F.G : u, qbn = un % (T / 256), hn = (un / (T / 256)) % 4, bn = un / (4 * (T / 256));
            const bf16_t* qr = Q + (size_t)(bn * T + qbn * 256 + wave * 32 + q) * D + hn * 256;
#pragma unroll
            for (int j = 0; j < 4; ++j) qn[j] = *(const bf16x8*)(qr + 16 * j + 8 * hh);
        }
#pragma unroll
        for (int db = 0; db < 8; ++db) {
            f32x16 o;
#pragma unroll
            for (int i = 0; i < 16; ++i) o[i] = 0.f;
            int qm = q & 15; asm volatile("" : "+v"(qm));
            const LAS unsigned char* vrow = lds + (32 * db + q) * 512 + 8 * (hh ^ (q >> 4));
#pragma unroll
            for (int kb = 0; kb < 8; ++kb)
#pragma unroll
                for (int s = 0; s < 2; ++s) {
                    const int c0 = 4 * kb + 2 * s;
                    const int o0 = (c0 ^ qm) << 4;
                    const s16x4 lo = *(const LAS s16x4*)(vrow + o0), hi = *(const LAS s16x4*)(vrow + (o0 ^ 16));
                    const bf16x8 vf = __builtin_shufflevector(lo, hi, 0, 1, 2, 3, 4, 5, 6, 7);
                    o = __builtin_amdgcn_mfma_f32_32x32x16_bf16(vf, pf[kb][s], o, 0, 0, 0);
                }
            LAS unsigned char* stg = lds + 131072 + wave * 2048;
#pragma unroll
            for (int g = 0; g < 4; ++g) { u32x2 w; w.x = pk2(o[4 * g + 0] * inv, o[4 * g + 1] * inv); w.y = pk2(o[4 * g + 2] * inv, o[4 * g + 3] * inv);
                *(LAS u32x2*)(stg + q * 64 + ((g ^ ((q >> 1) & 3)) << 4) + 8 * hh) = w; }
#pragma unroll
            for (int i = 0; i < 2; ++i) { const int row = 16 * i + (lane >> 2), ch = lane & 3;
                const u32x4 v = *(const LAS u32x4*)(stg + row * 64 + ((ch ^ ((row >> 1) & 3)) << 4));
                *(u32x4*)(obase + (size_t)row * D + 32 * db + 8 * ch) = v; }
        }
        AT_T(5);
        RW_BAR();
        AT_T(6);
    }
}
#define RW_BAR() do { asm volatile("s_waitcnt lgkmcnt(0)" ::: "memory"); __builtin_amdgcn_s_barrier(); asm volatile("" ::: "memory"); } while (0)
__device__ __forceinline__ void conv_ln_phase(const Frame& F, const Inputs& I, const bf16_t* U, bf16_t* S) {
    int tid_ = threadIdx.x; asm volatile("" : "+v"(tid_));
    const int tid = tid_, lane = tid & 63, wave = F.wave;
    LAS float* red = (LAS float*)F.lds;
    const int c0 = 2 * tid;
    f32x2 wv[31];
#pragma unroll
    for (int j = 0; j < 31; ++j) wv[j] = *(const f32x2*)(I.conv_dw + j * D + c0);
    const f32x2 bias = *(const f32x2*)(I.conv_dw_b + c0), lg = *(const f32x2*)(I.conv_ln_g + c0), lb = *(const f32x2*)(I.conv_ln_b + c0);
    constexpr int UT = 128;
    const int nunits = F.NB * (T / UT);
    for (int u = F.vcu; u < nunits; u += F.G) {
        const int b = u / (T / UT), tc = (u % (T / UT)) * UT;
        const bf16_t* Ub = U + (size_t)b * T * D + c0;
        unsigned in[46];
#pragma unroll
        for (int s = 0; s < 46; ++s) { const int tt = tc - 30 + s; in[s] = *(const unsigned*)(Ub + (size_t)(tt > 0 ? tt : 0) * D); }
        if (tc == 0) {
#pragma unroll
            for (int s = 0; s < 30; ++s) in[s] = 0u;
        }
#pragma unroll 1
        for (int sb = 0; sb < UT / 16; ++sb) {
            const int t0 = tc + 16 * sb;
            unsigned nx[16];
#pragma unroll
            for (int s = 0; s < 16; ++s) { int tt = t0 + 16 + s; tt = tt < T ? tt : T - 1; nx[s] = *(const unsigned*)(Ub + (size_t)tt * D); }
            f32x2 av[16];
#pragma unroll
            for (int t = 0; t < 16; ++t) av[t] = bias;
#pragma unroll
            for (int s = 0; s < 46; ++s) {
                const f32x2 x = {bf_lo(in[s]), bf_hi(in[s])};
#pragma unroll
                for (int t = 0; t < 16; ++t) { const int j = s - t; if (j >= 0 && j <= 30) av[t] = __builtin_elementwise_fma(wv[j], x, av[t]); }
            }
            float a0[16], a1[16];
#pragma unroll
            for (int t = 0; t < 16; ++t) { a0[t] = av[t][0]; a1[t] = av[t][1]; }
#pragma unroll
            for (int t = 0; t < 16; ++t) {
                float s1 = a0[t] + a1[t], s2 = a0[t] * a0[t] + a1[t] * a1[t];
                s1 = wave_sum(s1); s2 = wave_sum(s2);
                if (lane == 0) { red[wave * 32 + t] = s1; red[wave * 32 + 16 + t] = s2; }
            }
            RW_BAR();
            if (tid < 32) { float s = 0.f;
#pragma unroll
                for (int w = 0; w < 8; ++w) s += red[w * 32 + tid];
                red[256 + tid] = s; }
            RW_BAR();
#pragma unroll
            for (int t = 0; t < 16; ++t) {
                const float mean = red[256 + t] * (1.0f / D), var = red[256 + 16 + t] * (1.0f / D) - mean * mean, rstd = rsqrtf(var + 1e-5f);
                const float y0 = (a0[t] - mean) * rstd * lg[0] + lb[0], y1 = (a1[t] - mean) * rstd * lg[1] + lb[1];
                *(unsigned*)(S + ((size_t)(b * T + t0 + t)) * D + c0) = pk2(fast_silu(y0), fast_silu(y1));
            }
#pragma unroll
            for (int s = 0; s < 30; ++s) in[s] = in[s + 16];
#pragma unroll
            for (int s = 0; s < 16; ++s) in[30 + s] = nx[s];
        }
    }
}
namespace pg8 {
__device__ __forceinline__ f32x2 gelu_pk(f32x2 v) {
    const f32x2 av = __builtin_elementwise_abs(v), d = av * 0.2316418882f + 1.0f;
    f32x2 t; t.x = __builtin_amdgcn_rcpf(d.x); t.y = __builtin_amdgcn_rcpf(d.y);
    f32x2 q = t * 0.5307027145f + (-0.7265760135f); q = q * t + 0.7107068705f; q = q * t + (-0.142248368f); q = q * t + 0.127414796f; q = q * t;
    const f32x2 s = (v * v) * (-0.72134752044f);
    f32x2 e; e.x = __builtin_amdgcn_exp2f(s.x); e.y = __builtin_amdgcn_exp2f(s.y);
    const f32x2 m = v * (q * e), r = v - m;
    f32x2 o; o.x = v.x < 0.f ? m.x : r.x; o.y = v.y < 0.f ? m.y : r.y; return o;
}
struct EpiGeluStats {
    static constexpr bool PERM = true;
    bf16_t* O; int ldc; const i64* ssq; const float* bias; i64* lns; int stat_pn0;
    __device__ __forceinline__ void operator()(const Acc& acc, const Unit& u, int wr, int wc, int fr, int fq) const {
        const int col0 = u.pn * BM + wc * 32 + 8 * fq;
        f32x4 bv[2][2];
#pragma unroll
        for (int bj = 0; bj < 2; ++bj) { bv[bj][0] = *(const f32x4*)(bias + col0 + bj * HALF); bv[bj][1] = *(const f32x4*)(bias + col0 + bj * HALF + 4); }
        const bool stats = u.pn >= stat_pn0;
#pragma unroll
        for (int ai = 0; ai < 2; ++ai)
#pragma unroll
            for (int m = 0; m < 4; ++m) {
                const int row = EPI_ROWS(u, wr, fr, ai, m);
                const float rs = rstd_from_ssq(ssq[row], 1.0f / 1024.0f, 1e-6f);
                bf16_t* rowp = O + (size_t)row * ldc + col0;
                float s1 = 0.f, s2 = 0.f;
#pragma unroll
                for (int bj = 0; bj < 2; ++bj) {
                    const f32x4 v0 = acc[ai][bj][m][0] * rs + bv[bj][0], v1 = acc[ai][bj][m][1] * rs + bv[bj][1];
                    const f32x2 a = gelu_pk((f32x2){v0[0], v0[1]}), b = gelu_pk((f32x2){v0[2], v0[3]}), c = gelu_pk((f32x2){v1[0], v1[1]}), d = gelu_pk((f32x2){v1[2], v1[3]});
                    u32x4 w; w.x = pk2(a.x, a.y); w.y = pk2(b.x, b.y); w.z = pk2(c.x, c.y); w.w = pk2(d.x, d.y);
                    *(u32x4*)(rowp + bj * HALF) = w;
                    s1 += ((a.x + a.y) + (b.x + b.y)) + ((c.x + c.y) + (d.x + d.y));
                    s2 += ((a.x * a.x + a.y * a.y) + (b.x * b.x + b.y * b.y)) + ((c.x * c.x + c.y * c.y) + (d.x * d.x + d.y * d.y));
                }
                if (stats) {
                    s1 += __shfl_xor(s1, 16); s1 += __shfl_xor(s1, 32); s2 += __shfl_xor(s2, 16); s2 += __shfl_xor(s2, 32);
                    if (fq == 0) { atomic_add_i64(lns + 2 * (size_t)row, (i64)(s1 * SSQ_SCALE)); atomic_add_i64(lns + 2 * (size_t)row + 1, (i64)(s2 * SSQ_SCALE + 0.5f)); }
                }
            }
    }
};
}

#ifndef RW_BAR
#define RW_BAR() do { asm volatile("s_waitcnt lgkmcnt(0)" ::: "memory"); __builtin_amdgcn_s_barrier(); asm volatile("" ::: "memory"); } while (0)
#endif
__device__ __forceinline__ void sgu_spatial_phase(const Frame& F, const Inputs& I, bf16_t* Z) {
    const int tid = opaque_tid(), lane = tid & 63, wave = F.wave, wr = wave >> 2, wc = wave & 3, fr = lane & 15, g4 = lane >> 4;
    const bf16_t* wt = (const bf16_t*)(F.ws + F.wm.wstril);
    LAS unsigned char* lds = F.lds;
    const unsigned lds_base = (unsigned)(size_t)lds;
    const int nunits = F.NB * 16 * 8;
    const int ech = tid & 31, rg = tid >> 5, e0 = 8 * ech;
    const unsigned tr_base = lds_base + (unsigned)((8 * g4 + (fr >> 2)) * 528 + (64 * wc + 4 * (fr & 3)) * 2);
    u32x4 pv[8]; i64 ps0 = 0, ps1 = 0;
    constexpr int STAT_OFF = 128 * 528;
    if (F.vcu < nunits) {
        const int c = F.vcu >> 3, g = F.vcu & 7, row0 = c * 128;
        ps0 = F.lns[2 * (size_t)(row0 + (tid & 127))]; ps1 = F.lns[2 * (size_t)(row0 + (tid & 127)) + 1];
#pragma unroll
        for (int i = 0; i < 8; ++i) { const int row = row0 + rg + 16 * i; pv[i] = *(const u32x4*)(Z + (size_t)row * 4096 + 2048 + g * 256 + e0); }
    }
    const bool ginv = (F.G & 7) == 0;
    f32x4 lg0 = *(const f32x4*)(I.sgu_ln_g + (F.vcu & 7) * 256 + e0), lg1 = *(const f32x4*)(I.sgu_ln_g + (F.vcu & 7) * 256 + e0 + 4);
    f32x4 lb0 = *(const f32x4*)(I.sgu_ln_b + (F.vcu & 7) * 256 + e0), lb1 = *(const f32x4*)(I.sgu_ln_b + (F.vcu & 7) * 256 + e0 + 4);
    for (int u = F.vcu; u < nunits; u += F.G) {
        const int c = u >> 3, g = u & 7, row0 = c * 128;
        {
            const float mean = (float)ps0 * SSQ_INV * (1.0f / 2048.0f), rstd = rsqrtf((float)ps1 * SSQ_INV * (1.0f / 2048.0f) - mean * mean + 1e-5f);
            if (tid < 128) *(LAS f32x2*)(lds + STAT_OFF + tid * 8) = (f32x2){mean, rstd};
        }
        RW_BAR();
        {
            if (!ginv) { lg0 = *(const f32x4*)(I.sgu_ln_g + g * 256 + e0); lg1 = *(const f32x4*)(I.sgu_ln_g + g * 256 + e0 + 4);
                         lb0 = *(const f32x4*)(I.sgu_ln_b + g * 256 + e0); lb1 = *(const f32x4*)(I.sgu_ln_b + g * 256 + e0 + 4); }
#pragma unroll
            for (int i = 0; i < 8; ++i) {
                const int s = rg + 16 * i; const u32x4 v = pv[i]; const f32x2 mr = *(const LAS f32x2*)(lds + STAT_OFF + s * 8); const float mean = mr[0], rstd = mr[1];
                f32x4 y0 = {bf_lo(v.x), bf_hi(v.x), bf_lo(v.y), bf_hi(v.y)}, y1 = {bf_lo(v.z), bf_hi(v.z), bf_lo(v.w), bf_hi(v.w)};
                y0 = (y0 - mean) * rstd * lg0 + lb0; y1 = (y1 - mean) * rstd * lg1 + lb1;
                u32x4 w; w.x = pk2(y0[0], y0[1]); w.y = pk2(y0[2], y0[3]); w.z = pk2(y1[0], y1[1]); w.w = pk2(y1[2], y1[3]);
                *(LAS u32x4*)(lds + s * 528 + e0 * 2) = w;
            }
        }
        RW_BAR();
        bf16x8 af[2][4];
#pragma unroll
        for (int ks = 0; ks < 2; ++ks)
#pragma unroll
            for (int mt = 0; mt < 4; ++mt) af[ks][mt] = *(const bf16x8*)(wt + (size_t)g * 16384 + (64 * wr + 16 * mt + fr) * 128 + 32 * ks + 8 * g4);
        float bsv[4];
#pragma unroll
        for (int mt = 0; mt < 4; ++mt) bsv[mt] = I.sgu_bs[g * 128 + 64 * wr + 16 * mt + fr];
        f32x4 acc[4][4];
#pragma unroll
        for (int mt = 0; mt < 4; ++mt)
#pragma unroll
            for (int nt = 0; nt < 4; ++nt) acc[mt][nt] = (f32x4){0.f, 0.f, 0.f, 0.f};
#define SGU_KSTEP(ks, afk) do { \
                s16x4 b0[4], b1[4]; \
                const unsigned ad = tr_base + (unsigned)(32 * (ks) * 528); \
                asm volatile("ds_read_b64_tr_b16 %0, %8\n\tds_read_b64_tr_b16 %1, %8 offset:2112\n\t" \
                             "ds_read_b64_tr_b16 %2, %8 offset:32\n\tds_read_b64_tr_b16 %3, %8 offset:2144\n\t" \
                             "ds_read_b64_tr_b16 %4, %8 offset:64\n\tds_read_b64_tr_b16 %5, %8 offset:2176\n\t" \
                             "ds_read_b64_tr_b16 %6, %8 offset:96\n\tds_read_b64_tr_b16 %7, %8 offset:2208\n\ts_waitcnt lgkmcnt(0)" \
                             : "=&v"(b0[0]), "=&v"(b1[0]), "=&v"(b0[1]), "=&v"(b1[1]), "=&v"(b0[2]), "=&v"(b1[2]), "=&v"(b0[3]), "=&v"(b1[3]) : "v"(ad) : "memory"); \
                _Pragma("unroll") for (int nt = 0; nt < 4; ++nt) { \
                    const bf16x8 bf = __builtin_shufflevector(b0[nt], b1[nt], 0, 1, 2, 3, 4, 5, 6, 7); \
                    _Pragma("unroll") for (int mt = 0; mt < 4; ++mt) acc[mt][nt] = __builtin_amdgcn_mfma_f32_16x16x32_bf16(bf, afk[mt], acc[mt][nt], 0, 0, 0); } } while (0)
        SGU_KSTEP(0, af[0]); SGU_KSTEP(1, af[1]);
#pragma unroll
        for (int ks = 0; ks < 2; ++ks)
#pragma unroll
            for (int mt = 0; mt < 4; ++mt) af[ks][mt] = *(const bf16x8*)(wt + (size_t)g * 16384 + (64 * wr + 16 * mt + fr) * 128 + 32 * (ks + 2) + 8 * g4);
        {
            const int un = (u + F.G < nunits) ? u + F.G : u; const int cn = un >> 3, gn = un & 7, rn0 = cn * 128;
            ps0 = F.lns[2 * (size_t)(rn0 + (tid & 127))]; ps1 = F.lns[2 * (size_t)(rn0 + (tid & 127)) + 1];
#pragma unroll
            for (int i = 0; i < 8; ++i) { const int row = rn0 + rg + 16 * i; pv[i] = *(const u32x4*)(Z + (size_t)row * 4096 + 2048 + gn * 256 + e0); }
        }
        SGU_KSTEP(2, af[0]); SGU_KSTEP(3, af[1]);
        u32x2 uu[4][4];
#pragma unroll
        for (int mt = 0; mt < 4; ++mt)
#pragma unroll
            for (int nt = 0; nt < 4; ++nt) uu[mt][nt] = *(const u32x2*)(Z + (size_t)(row0 + 64 * wr + 16 * mt + fr) * 4096 + g * 256 + 64 * wc + 4 * g4 + 16 * nt);
#pragma unroll
        for (int mt = 0; mt < 4; ++mt) {
            const int t = 64 * wr + 16 * mt + fr;
            bf16_t* zr = Z + (size_t)(row0 + t) * 4096 + g * 256 + 64 * wc + 4 * g4;
#pragma unroll
            for (int nt = 0; nt < 4; ++nt) {
                const u32x2 u2 = uu[mt][nt];
                u32x2 w; w.x = pk2((acc[mt][nt][0] + bsv[mt]) * bf_lo(u2.x), (acc[mt][nt][1] + bsv[mt]) * bf_hi(u2.x)); w.y = pk2((acc[mt][nt][2] + bsv[mt]) * bf_lo(u2.y), (acc[mt][nt][3] + bsv[mt]) * bf_hi(u2.y));
                *(u32x2*)(zr + 16 * nt) = w;
            }
        }
        RW_BAR();
    }
    __syncthreads();
}
namespace pg8 {
struct EpiRope {
    static constexpr bool PERM = true;
    bf16_t* O; int ldc; const i64* ssq; const f32x4* rope; int row_off, rope_pn;
    __device__ __forceinline__ void operator()(const Acc& acc, const Unit& u, int wr, int wc, int fr, int fq) const {
        const int col0 = u.pn * BM + wc * 32 + 8 * fq;
#pragma unroll
        for (int ai = 0; ai < 2; ++ai)
#pragma unroll
            for (int m = 0; m < 4; ++m) {
                const int row = EPI_ROWS(u, wr, fr, ai, m), rg = row + row_off, t = rg & (T - 1);
                const float rs = rstd_from_ssq(ssq[rg], 1.0f / 1024.0f, 1e-6f);
                bf16_t* rowp = O + (size_t)row * ldc + col0;
#pragma unroll
                for (int bj = 0; bj < 2; ++bj) {
                    const int p0 = 64 * bj + 16 * wc + 4 * fq;
                    const f32x4 v0 = acc[ai][bj][m][0] * rs, v1 = acc[ai][bj][m][1] * rs;
                    u32x4 w;
                    if (u.pn < rope_pn) {
                        const f32x4 cs01 = rope[(size_t)t * 64 + (p0 >> 1)], cs23 = rope[(size_t)t * 64 + (p0 >> 1) + 1];
                        w.x = pk2(v0[0] * cs01[0] - v0[1] * cs01[1], v0[1] * cs01[0] + v0[0] * cs01[1]);
                        w.y = pk2(v0[2] * cs01[2] - v0[3] * cs01[3], v0[3] * cs01[2] + v0[2] * cs01[3]);
                        w.z = pk2(v1[0] * cs23[0] - v1[1] * cs23[1], v1[1] * cs23[0] + v1[0] * cs23[1]);
                        w.w = pk2(v1[2] * cs23[2] - v1[3] * cs23[3], v1[3] * cs23[2] + v1[2] * cs23[3]);
                    } else { w.x = pk2(v0[0], v0[1]); w.y = pk2(v0[2], v0[3]); w.z = pk2(v1[0], v1[1]); w.w = pk2(v1[2], v1[3]); }
                    *(u32x4*)(rowp + bj * HALF) = w;
                }
            }
    }
};
struct EpiBf16ColRstd {
    static constexpr bool PERM = true;
    bf16_t* O; int ldc; const i64* ssq; int col_off;
    __device__ __forceinline__ void operator()(const Acc& acc, const Unit& u, int wr, int wc, int fr, int fq) const {
        const int col0 = u.pn * BM + wc * 32 + 8 * fq;
        float cs[2][8];
#pragma unroll
        for (int bj = 0; bj < 2; ++bj)
#pragma unroll
            for (int j = 0; j < 8; ++j) cs[bj][j] = rstd_from_ssq(ssq[col_off + col0 + bj * HALF + j], 1.0f / 1024.0f, 1e-6f);
#pragma unroll
        for (int ai = 0; ai < 2; ++ai)
#pragma unroll
            for (int m = 0; m < 4; ++m) {
                const int row = EPI_ROWS(u, wr, fr, ai, m);
                bf16_t* rowp = O + (size_t)row * ldc + col0;
#pragma unroll
                for (int bj = 0; bj < 2; ++bj) {
                    const f32x4 v0 = acc[ai][bj][m][0], v1 = acc[ai][bj][m][1];
                    u32x4 w; w.x = pk2(v0[0] * cs[bj][0], v0[1] * cs[bj][1]); w.y = pk2(v0[2] * cs[bj][2], v0[3] * cs[bj][3]); w.z = pk2(v1[0] * cs[bj][4], v1[1] * cs[bj][5]); w.w = pk2(v1[2] * cs[bj][6], v1[3] * cs[bj][7]);
                    *(u32x4*)(rowp + bj * HALF) = w;
                }
            }
    }
};
struct EpiRetGate {
    static constexpr bool PERM = true;
    bf16_t* O; int ldc; const i64* ssq; const i64* oss; int row_off;
    __device__ __forceinline__ void operator()(const Acc& acc, const Unit& u, int wr, int wc, int fr, int fq) const {
        const int col0 = u.pn * BM + wc * 32 + 8 * fq, head = u.pn >> 1;
#pragma unroll
        for (int ai = 0; ai < 2; ++ai)
#pragma unroll
            for (int m = 0; m < 4; ++m) {
                const int row = EPI_ROWS(u, wr, fr, ai, m), rg = row + row_off;
                const float rs = rstd_from_ssq(ssq[rg], 1.0f / 1024.0f, 1e-6f);
                const float ro = rstd_from_ssq(oss[(size_t)rg * 4 + head], 1.0f / 512.0f, 1e-6f);
                bf16_t* rowp = O + (size_t)row * ldc + col0;
#pragma unroll
                for (int bj = 0; bj < 2; ++bj) {
                    const u32x4 ov = *(const u32x4*)(rowp + bj * HALF);
                    const float rsl = rs * 1.4426950408889634f, roi = ro * 0.6931471805599453f;
                    const unsigned ou[4] = {ov.x, ov.y, ov.z, ov.w};
                    unsigned wu[4];
#pragma unroll
                    for (int p2 = 0; p2 < 4; ++p2) {
                        const f32x2 t = (f32x2){acc[ai][bj][m][p2 >> 1][2 * (p2 & 1)], acc[ai][bj][m][p2 >> 1][2 * (p2 & 1) + 1]} * rsl;
                        const f32x2 uo = (f32x2){bf_lo(ou[p2]), bf_hi(ou[p2])} * roi;
                        const f32x2 d = (f32x2){__builtin_amdgcn_exp2f(-t[0]), __builtin_amdgcn_exp2f(-t[1])} + 1.0f;
                        const f32x2 r = {__builtin_amdgcn_rcpf(d[0]), __builtin_amdgcn_rcpf(d[1])};
                        const f32x2 res = (t * r) * uo;
                        wu[p2] = pk2(res[0], res[1]);
                    }
                    u32x4 w; w.x = wu[0]; w.y = wu[1]; w.z = wu[2]; w.w = wu[3];
                    *(u32x4*)(rowp + bj * HALF) = w;
                }
            }
    }
};
}

#ifndef RW_BAR
#define RW_BAR() do { asm volatile("s_waitcnt lgkmcnt(0)" ::: "memory"); __builtin_amdgcn_s_barrier(); asm volatile("" ::: "memory"); } while (0)
#endif
__device__ __forceinline__ void ret_chunk_phase(const Frame& F, bf16_t* QKV, i64* oss, int nseq) {
    int tid_ = threadIdx.x; asm volatile("" : "+v"(tid_));
    const int tid = tid_, lane = tid & 63, w = F.wave, fr = lane & 15, g4 = lane >> 4;
    LAS unsigned char* lds = F.lds;
    constexpr int KIMG = 0, VIMG = 128 * 528, RIMG = VIMG + 128 * 144;
    const unsigned lds_base = (unsigned)(size_t)lds;
    const int nunits = nseq * 4 * 8, tl = 16 * w + fr;
    for (int u = F.vcu; u < nunits; u += F.G) {
        const int sl = u & 7, h = (u >> 3) & 3, b = u >> 5;
        const float lg2u = __builtin_amdgcn_logf(1.0f - __builtin_amdgcn_exp2f(-5.0f - (float)h));
        f32x4 R[2][4];
#pragma unroll
        for (int dt = 0; dt < 2; ++dt)
#pragma unroll
            for (int et = 0; et < 4; ++et) R[dt][et] = (f32x4){0.f, 0.f, 0.f, 0.f};
        for (int i = tid; i < 64 * 528 / 16; i += NTHREADS) *(LAS u32x4*)(lds + RIMG + i * 16) = (u32x4){0u, 0u, 0u, 0u};
        const float cdec = __builtin_amdgcn_exp2f(lg2u * 128.0f), qdec = __builtin_amdgcn_exp2f(lg2u * (float)(tl + 1));
        float gi[8];
#pragma unroll
        for (int j = 0; j < 8; ++j) gi[j] = __uint_as_float(__builtin_amdgcn_readfirstlane(__float_as_uint(__builtin_amdgcn_exp2f(-lg2u * (float)j))));
        const float gi16 = __uint_as_float(__builtin_amdgcn_readfirstlane(__float_as_uint(__builtin_amdgcn_exp2f(-lg2u * 16.0f))));
        u32x4 pk[8], pv[2];
#pragma unroll
        for (int i = 0; i < 8; ++i) { const int cid = tid + 512 * i, row = cid >> 5, ch = cid & 31; pk[i] = *(const u32x4*)(QKV + (size_t)(b * T + row) * 4096 + 1024 + h * 256 + ch * 8); }
#pragma unroll
        for (int i = 0; i < 2; ++i) { const int cid = tid + 512 * i, row = cid >> 3, ch = cid & 7; pv[i] = *(const u32x4*)(QKV + (size_t)(b * T + row) * 4096 + 2048 + h * 512 + 64 * sl + ch * 8); }
        bf16x8 qf[8];
#pragma unroll
        for (int kk = 0; kk < 8; ++kk) qf[kk] = *(const bf16x8*)(QKV + (size_t)(b * T + tl) * 4096 + h * 256 + 32 * kk + 8 * g4);
#pragma unroll 1
        for (int n = 0; n < 16; ++n) {
            const int row_base = b * T + n * 128;
            float lg2 = lg2u; asm volatile("" : "+v"(lg2));
#pragma unroll
            for (int i = 0; i < 8; ++i) { const int cid = tid + 512 * i, row = cid >> 5, ch = cid & 31; *(LAS u32x4*)(lds + KIMG + row * 528 + ch * 16) = pk[i]; }
#pragma unroll
            for (int i = 0; i < 2; ++i) { const int cid = tid + 512 * i, row = cid >> 3, ch = cid & 7; *(LAS u32x4*)(lds + VIMG + row * 144 + ch * 16) = pv[i]; }
            RW_BAR();
            {
                const int rbn = b * T + (n < 15 ? n + 1 : 15) * 128;
#pragma unroll
                for (int i = 0; i < 8; ++i) { const int cid = tid + 512 * i, row = cid >> 5, ch = cid & 31; pk[i] = *(const u32x4*)(QKV + (size_t)(rbn + row) * 4096 + 1024 + h * 256 + ch * 8); }
#pragma unroll
                for (int i = 0; i < 2; ++i) { const int cid = tid + 512 * i, row = cid >> 3, ch = cid & 7; pv[i] = *(const u32x4*)(QKV + (size_t)(rbn + row) * 4096 + 2048 + h * 512 + 64 * sl + ch * 8); }
            }
            bf16x8 pf[4];
#pragma unroll
            for (int kk2 = 0; kk2 < 4; ++kk2) {
                f32x4 X0 = {0.f, 0.f, 0.f, 0.f}, X1 = {0.f, 0.f, 0.f, 0.f};
                if (2 * kk2 <= w) {
                    bf16x8 kfr[8];
#pragma unroll
                    for (int kk = 0; kk < 8; ++kk) kfr[kk] = *(const LAS bf16x8*)(lds + KIMG + (32 * kk2 + fr) * 528 + (32 * kk + 8 * g4) * 2);
#pragma unroll
                    for (int kk = 0; kk < 8; ++kk) X0 = __builtin_amdgcn_mfma_f32_16x16x32_bf16(kfr[kk], qf[kk], X0, 0, 0, 0);
                    if (2 * kk2 + 1 <= w) {
#pragma unroll
                        for (int kk = 0; kk < 8; ++kk) kfr[kk] = *(const LAS bf16x8*)(lds + KIMG + (32 * kk2 + 16 + fr) * 528 + (32 * kk + 8 * g4) * 2);
#pragma unroll
                        for (int kk = 0; kk < 8; ++kk) X1 = __builtin_amdgcn_mfma_f32_16x16x32_bf16(kfr[kk], qf[kk], X1, 0, 0, 0);
                    }
                    const float e0 = __builtin_amdgcn_exp2f(lg2 * (float)(tl - 4 * g4 - 32 * kk2)), e1 = e0 * gi16;
#pragma unroll
                    for (int i = 0; i < 4; ++i) {
                        const int s0 = 32 * kk2 + 4 * g4 + i, s1 = s0 + 16;
                        X0[i] = (tl >= s0) ? X0[i] * (e0 * gi[i]) : 0.f;
                        X1[i] = (tl >= s1) ? X1[i] * (e1 * gi[i]) : 0.f;
                    }
                }
                u32x4 pw; pw.x = pk2(X0[0], X0[1]); pw.y = pk2(X0[2], X0[3]); pw.z = pk2(X1[0], X1[1]); pw.w = pk2(X1[2], X1[3]);
                pf[kk2] = __builtin_bit_cast(bf16x8, pw);
                __builtin_amdgcn_sched_barrier(0);
            }
            f32x4 oa[4];
#pragma unroll
            for (int et = 0; et < 4; ++et) {
                oa[et] = (f32x4){0.f, 0.f, 0.f, 0.f};
                bf16x8 rfr[8];
#pragma unroll
                for (int kk = 0; kk < 8; ++kk) rfr[kk] = *(const LAS bf16x8*)(lds + RIMG + (16 * et + fr) * 528 + (32 * kk + 8 * g4) * 2);
#pragma unroll
                for (int kk = 0; kk < 8; ++kk) oa[et] = __builtin_amdgcn_mfma_f32_16x16x32_bf16(rfr[kk], qf[kk], oa[et], 0, 0, 0);
                oa[et] *= qdec;
                __builtin_amdgcn_sched_barrier(0);
            }
#pragma unroll
            for (int kk2 = 0; kk2 < 4; ++kk2) {
                if (2 * kk2 <= w) {
                    s16x4 v0[4], v1[4];
                    const unsigned ad = lds_base + VIMG + (unsigned)((32 * kk2 + 4 * g4 + (fr >> 2)) * 144 + 8 * (fr & 3));
                    asm volatile("ds_read_b64_tr_b16 %0, %8 offset:0\n\tds_read_b64_tr_b16 %1, %8 offset:2304\n\tds_read_b64_tr_b16 %2, %8 offset:32\n\tds_read_b64_tr_b16 %3, %8 offset:2336\n\t"
                                 "ds_read_b64_tr_b16 %4, %8 offset:64\n\tds_read_b64_tr_b16 %5, %8 offset:2368\n\tds_read_b64_tr_b16 %6, %8 offset:96\n\tds_read_b64_tr_b16 %7, %8 offset:2400\n\ts_waitcnt lgkmcnt(0)"
                                 : "=&v"(v0[0]), "=&v"(v1[0]), "=&v"(v0[1]), "=&v"(v1[1]), "=&v"(v0[2]), "=&v"(v1[2]), "=&v"(v0[3]), "=&v"(v1[3]) : "v"(ad) : "memory");
#pragma unroll
                    for (int et = 0; et < 4; ++et) oa[et] = __builtin_amdgcn_mfma_f32_16x16x32_bf16(__builtin_shufflevector(v0[et], v1[et], 0, 1, 2, 3, 4, 5, 6, 7), pf[kk2], oa[et], 0, 0, 0);
                }
            }
            {
                float ss = 0.f;
                bf16_t* op = QKV + (size_t)(row_base + tl) * 4096 + 2048 + h * 512 + 64 * sl + 4 * g4;
#pragma unroll
                for (int et = 0; et < 4; ++et) {
                    u32x2 wv; wv.x = pk2(oa[et][0], oa[et][1]); wv.y = pk2(oa[et][2], oa[et][3]);
                    *(u32x2*)(op + 16 * et) = wv;
                    ss += (oa[et][0] * oa[et][0] + oa[et][1] * oa[et][1]) + (oa[et][2] * oa[et][2] + oa[et][3] * oa[et][3]);
                }
                ss += __shfl_xor(ss, 16); ss += __shfl_xor(ss, 32);
                if (g4 == 0) atomic_add_i64(oss + (size_t)(row_base + tl) * 4 + h, (i64)(ss * SSQ_SCALE + 0.5f));
            }
            __builtin_amdgcn_sched_barrier(0);
            {
                const int rbq = b * T + (n < 15 ? n + 1 : 15) * 128;
#pragma unroll
                for (int kk = 0; kk < 8; ++kk) qf[kk] = *(const bf16x8*)(QKV + (size_t)(rbq + tl) * 4096 + h * 256 + 32 * kk + 8 * g4);
            }
            __builtin_amdgcn_sched_barrier(0);
            bf16x8 kt[2][4];
            {
                s16x4 r0[2][4], r1[2][4];
                const unsigned ad = lds_base + KIMG + (unsigned)((8 * g4 + (fr >> 2)) * 528 + (32 * w + 4 * (fr & 3)) * 2);
                asm volatile(
                    "ds_read_b64_tr_b16 %0, %16 offset:0\n\tds_read_b64_tr_b16 %1, %16 offset:2112\n\t"
                    "ds_read_b64_tr_b16 %2, %16 offset:16896\n\tds_read_b64_tr_b16 %3, %16 offset:19008\n\t"
                    "ds_read_b64_tr_b16 %4, %16 offset:33792\n\tds_read_b64_tr_b16 %5, %16 offset:35904\n\t"
                    "ds_read_b64_tr_b16 %6, %16 offset:50688\n\tds_read_b64_tr_b16 %7, %16 offset:52800\n\t"
                    "ds_read_b64_tr_b16 %8, %16 offset:32\n\tds_read_b64_tr_b16 %9, %16 offset:2144\n\t"
                    "ds_read_b64_tr_b16 %10, %16 offset:16928\n\tds_read_b64_tr_b16 %11, %16 offset:19040\n\t"
                    "ds_read_b64_tr_b16 %12, %16 offset:33824\n\tds_read_b64_tr_b16 %13, %16 offset:35936\n\t"
                    "ds_read_b64_tr_b16 %14, %16 offset:50720\n\tds_read_b64_tr_b16 %15, %16 offset:52832\n\ts_waitcnt lgkmcnt(0)"
                    : "=&v"(r0[0][0]), "=&v"(r1[0][0]), "=&v"(r0[0][1]), "=&v"(r1[0][1]), "=&v"(r0[0][2]), "=&v"(r1[0][2]), "=&v"(r0[0][3]), "=&v"(r1[0][3]),
                      "=&v"(r0[1][0]), "=&v"(r1[1][0]), "=&v"(r0[1][1]), "=&v"(r1[1][1]), "=&v"(r0[1][2]), "=&v"(r1[1][2]), "=&v"(r0[1][3]), "=&v"(r1[1][3])
                    : "v"(ad) : "memory");
#pragma unroll
                for (int kk2 = 0; kk2 < 4; ++kk2) {
                    float f[8];
                    const float fb = __builtin_amdgcn_exp2f(lg2 * (float)(127 - 32 * kk2 - 8 * g4));
#pragma unroll
                    for (int j = 0; j < 8; ++j) f[j] = fb * gi[j];
#pragma unroll
                    for (int dt = 0; dt < 2; ++dt) {
                        const u32x2 a = __builtin_bit_cast(u32x2, r0[dt][kk2]), c = __builtin_bit_cast(u32x2, r1[dt][kk2]);
                        u32x4 o; o.x = pk2(bf_lo(a.x) * f[0], bf_hi(a.x) * f[1]); o.y = pk2(bf_lo(a.y) * f[2], bf_hi(a.y) * f[3]);
                        o.z = pk2(bf_lo(c.x) * f[4], bf_hi(c.x) * f[5]); o.w = pk2(bf_lo(c.y) * f[6], bf_hi(c.y) * f[7]);
                        kt[dt][kk2] = __builtin_bit_cast(bf16x8, o);
                    }
                }
            }
#pragma unroll
            for (int dt = 0; dt < 2; ++dt)
#pragma unroll
                for (int et = 0; et < 4; ++et) R[dt][et] *= cdec;
#pragma unroll
            for (int kk2 = 0; kk2 < 4; ++kk2) {
                s16x4 v0[4], v1[4];
                const unsigned ad = lds_base + VIMG + (unsigned)((32 * kk2 + 8 * g4 + (fr >> 2)) * 144 + 8 * (fr & 3));
                asm volatile("ds_read_b64_tr_b16 %0, %8 offset:0\n\tds_read_b64_tr_b16 %1, %8 offset:576\n\tds_read_b64_tr_b16 %2, %8 offset:32\n\tds_read_b64_tr_b16 %3, %8 offset:608\n\t"
                             "ds_read_b64_tr_b16 %4, %8 offset:64\n\tds_read_b64_tr_b16 %5, %8 offset:640\n\tds_read_b64_tr_b16 %6, %8 offset:96\n\tds_read_b64_tr_b16 %7, %8 offset:672\n\ts_waitcnt lgkmcnt(0)"
                             : "=&v"(v0[0]), "=&v"(v1[0]), "=&v"(v0[1]), "=&v"(v1[1]), "=&v"(v0[2]), "=&v"(v1[2]), "=&v"(v0[3]), "=&v"(v1[3]) : "v"(ad) : "memory");
#pragma unroll
                for (int et = 0; et < 4; ++et) {
                    const bf16x8 vf = __builtin_shufflevector(v0[et], v1[et], 0, 1, 2, 3, 4, 5, 6, 7);
#pragma unroll
                    for (int dt = 0; dt < 2; ++dt) R[dt][et] = __builtin_amdgcn_mfma_f32_16x16x32_bf16(kt[dt][kk2], vf, R[dt][et], 0, 0, 0);
                }
            }
            RW_BAR();
#pragma unroll
            for (int dt = 0; dt < 2; ++dt)
#pragma unroll
                for (int et = 0; et < 4; ++et) { u32x2 wv; wv.x = pk2(R[dt][et][0], R[dt][et][1]); wv.y = pk2(R[dt][et][2], R[dt][et][3]);
                    *(LAS u32x2*)(lds + RIMG + (16 * et + fr) * 528 + (32 * w + 16 * dt + 4 * g4) * 2) = wv; }
        }
        __syncthreads();
    }
}
namespace pg8 {
struct EpiLora1 {
    static constexpr bool PERM = true;
    bf16_t* O; int ldc;
    __device__ __forceinline__ void operator()(const Acc& acc, const Unit& u, int wr, int wc, int fr, int fq) const {
        const int col0 = u.pn * BM + wc * 32 + 8 * fq;
#pragma unroll
        for (int ai = 0; ai < 2; ++ai)
#pragma unroll
            for (int m = 0; m < 4; ++m) {
                const int row = EPI_ROWS(u, wr, fr, ai, m);
                bf16_t* rowp = O + (size_t)row * ldc + col0;
#pragma unroll
                for (int bj = 0; bj < 2; ++bj) {
                    const int grp = (u.pn * BM + bj * HALF + wc * 32) >> 5;
                    float v[8];
#pragma unroll
                    for (int j = 0; j < 4; ++j) { v[j] = acc[ai][bj][m][0][j]; v[4 + j] = acc[ai][bj][m][1][j]; }
                    if (grp < 2) {
#pragma unroll
                        for (int j = 0; j < 8; ++j) { const float x = fminf(fmaxf(v[j], -10.f), 10.f), e = __builtin_amdgcn_exp2f(2.8853900817779268f * x); v[j] = (e - 1.0f) * __builtin_amdgcn_rcpf(e + 1.0f); }
                    } else if (grp >= 4 && grp < 9) {
#pragma unroll
                        for (int j = 0; j < 8; ++j) v[j] = fast_sigmoid(v[j]);
                    }
                    u32x4 w; w.x = pk2(v[0], v[1]); w.y = pk2(v[2], v[3]); w.z = pk2(v[4], v[5]); w.w = pk2(v[6], v[7]);
                    *(u32x4*)(rowp + bj * HALF) = w;
                }
            }
    }
};
template <int MODE> struct EpiRwkvAct {
    static constexpr bool PERM = true;
    bf16_t* O; int ldc; const float* c0;
    __device__ __forceinline__ void operator()(const Acc& acc, const Unit& u, int wr, int wc, int fr, int fq) const {
        const int col0 = u.pn * BM + wc * 32 + 8 * fq;
        f32x4 cv[2][2];
#pragma unroll
        for (int bj = 0; bj < 2; ++bj) { cv[bj][0] = *(const f32x4*)(c0 + col0 + bj * HALF); cv[bj][1] = *(const f32x4*)(c0 + col0 + bj * HALF + 4); }
#pragma unroll
        for (int ai = 0; ai < 2; ++ai)
#pragma unroll
            for (int m = 0; m < 4; ++m) {
                const int row = EPI_ROWS(u, wr, fr, ai, m);
                bf16_t* rowp = O + (size_t)row * ldc + col0;
#pragma unroll
                for (int bj = 0; bj < 2; ++bj) {
                    float v[8];
#pragma unroll
                    for (int j = 0; j < 4; ++j) { v[j] = acc[ai][bj][m][0][j] + cv[bj][0][j]; v[4 + j] = acc[ai][bj][m][1][j] + cv[bj][1][j]; }
#pragma unroll
                    for (int j = 0; j < 8; ++j) {
                        if (MODE == 0) { const float xw = -v[j];
                            const float sp = xw > 20.f ? xw : 0.6931471805599453f * __builtin_amdgcn_logf(1.0f + __builtin_amdgcn_exp2f(1.4426950408889634f * xw));
                            v[j] = -1.4426950408889634f * __builtin_amdgcn_exp2f(1.4426950408889634f * (-sp - 0.5f)); }
                        else v[j] = fast_sigmoid(v[j]);
                    }
                    u32x4 w; w.x = pk2(v[0], v[1]); w.y = pk2(v[2], v[3]); w.z = pk2(v[4], v[5]); w.w = pk2(v[6], v[7]);
                    *(u32x4*)(rowp + bj * HALF) = w;
                }
            }
    }
};
}

__device__ __forceinline__ void unpack8(const u32x4 u, float* o) { o[0] = bf_lo(u.x); o[1] = bf_hi(u.x); o[2] = bf_lo(u.y); o[3] = bf_hi(u.y); o[4] = bf_lo(u.z); o[5] = bf_hi(u.z); o[6] = bf_lo(u.w); o[7] = bf_hi(u.w); }
__device__ __forceinline__ u32x4 pack8(const float* v) { u32x4 w; w.x = pk2(v[0], v[1]); w.y = pk2(v[2], v[3]); w.z = pk2(v[4], v[5]); w.w = pk2(v[6], v[7]); return w; }
__device__ __forceinline__ void rwkv_mix_phase(const Frame& F, const Inputs& I, const bf16_t* X, const i64* ssq, int rb, int Mh, bf16_t* hn_pad, bf16_t* xs  ) {
    const int lane = opaque_tid() & 63;
    f32x4 g[4], mr[4], mk[4], mv[4];
#pragma unroll
    for (int j = 0; j < 4; ++j) { g[j] = ((const f32x4*)I.mix_norm_g)[256 + lane + 64 * j]; mr[j] = ((const f32x4*)I.rwkv_mix)[lane + 64 * j]; mk[j] = ((const f32x4*)I.rwkv_mix)[512 + lane + 64 * j]; mv[j] = ((const f32x4*)I.rwkv_mix)[768 + lane + 64 * j]; }
    for (int r = F.gw; r < Mh; r += F.NGW) {
        const int rg = rb + r, t = r & (T - 1);
        const float rs = rstd_from_ssq(ssq[rg], 1.0f / D, 1e-6f), rp = t ? rstd_from_ssq(ssq[rg - 1], 1.0f / D, 1e-6f) : 0.f;
        const u32x2* xr = (const u32x2*)(X + (size_t)rg * D) + lane; const u32x2* xp = (const u32x2*)(X + (size_t)(t ? rg - 1 : rg) * D) + lane;
        const size_t prow = (size_t)r + (r >> 11) + 1;
        u32x2* hp = (u32x2*)(hn_pad + prow * D) + lane;
        u32x2* o0 = (u32x2*)(xs + (size_t)r * D) + lane; u32x2* o1 = (u32x2*)(xs + ((size_t)Mh + r) * D) + lane; u32x2* o2 = (u32x2*)(xs + (2 * (size_t)Mh + r) * D) + lane;
#pragma unroll
        for (int j = 0; j < 4; ++j) {
            const u32x2 ur = xr[64 * j], up = xp[64 * j];
            const f32x4 h = (f32x4){bf_lo(ur.x), bf_hi(ur.x), bf_lo(ur.y), bf_hi(ur.y)} * rs * g[j], p = (f32x4){bf_lo(up.x), bf_hi(up.x), bf_lo(up.y), bf_hi(up.y)} * rp * g[j], d = p - h;
            u32x2 w; w.x = pk2(h[0], h[1]); w.y = pk2(h[2], h[3]); hp[64 * j] = w;
            const f32x4 a = h + d * mr[j], b = h + d * mk[j], c = h + d * mv[j];
            w.x = pk2(a[0], a[1]); w.y = pk2(a[2], a[3]); o0[64 * j] = w;
            w.x = pk2(b[0], b[1]); w.y = pk2(b[2], b[3]); o1[64 * j] = w;
            w.x = pk2(c[0], c[1]); w.y = pk2(c[2], c[3]); o2[64 * j] = w;
            if (t == 0) (hp - 256)[64 * j] = (u32x2){0u, 0u};
        }
    }
}

__device__ __forceinline__ void rwkv_scan_phase(const Frame& F, const Inputs& I, const bf16_t* rr, const bf16_t* kk_, const bf16_t* vv, const bf16_t* wraw, const bf16_t* araw, bf16_t* y, int nseq) {
    const int tid = opaque_tid(), lane = tid & 63, w = F.wave, r4 = lane >> 4, cg = lane & 15;
    LAS unsigned char* lds = F.lds;
    constexpr int TS = 32, VEC = TS * 64 * 4, BUF = 5 * VEC + TS * 32 * 4 + TS * 32 * 4;
    const int nitems = nseq * 32;
    const int pt = tid >> 4, pj = 4 * (tid & 15);
    for (int it = F.vcu; it < nitems; it += F.G) {
        const int rh = it & 1, h = (it >> 1) & 15, b = it >> 5;
        const int ch = h * 64;
        const f32x4 w0 = *(const f32x4*)(I.rwkv_w0 + ch + pj), a0 = *(const f32x4*)(I.rwkv_a0 + ch + pj), kkc = *(const f32x4*)(I.rwkv_k_k + ch + pj), kac = *(const f32x4*)(I.rwkv_k_a + ch + pj);
        f32x4 S = {0.f, 0.f, 0.f, 0.f};
        u32x2 nr, nk, nw, na; unsigned nv = 0u;
        {   const size_t o = (size_t)(b * T + pt) * D + ch + pj;
            nr = *(const u32x2*)(rr + o); nk = *(const u32x2*)(kk_ + o); nw = *(const u32x2*)(wraw + o); na = *(const u32x2*)(araw + o);
            nv = *(const unsigned*)(vv + (size_t)(b * T + pt) * D + ch + 32 * rh + 2 * (tid & 15)); }
#pragma unroll 1
        for (int blk = 0; blk < T / TS; ++blk) {
            LAS unsigned char* bufp = lds + (blk & 1) * BUF;
            {
                const f32x4 kr = {bf_lo(nk.x), bf_hi(nk.x), bf_lo(nk.y), bf_hi(nk.y)}, rv = {bf_lo(nr.x), bf_hi(nr.x), bf_lo(nr.y), bf_hi(nr.y)};
                const f32x4 wr_ = {bf_lo(nw.x), bf_hi(nw.x), bf_lo(nw.y), bf_hi(nw.y)}, ar = {bf_lo(na.x), bf_hi(na.x), bf_lo(na.y), bf_hi(na.y)};
                f32x4 dec, av, kkv, km;
                const f32x4 kq = kr * kkc;
                float n2 = (kq[0] * kq[0] + kq[1] * kq[1]) + (kq[2] * kq[2] + kq[3] * kq[3]);
                n2 = dpp_sum16(n2);
                const float inv = 1.0f / fmaxf(sqrtf(n2), 1e-12f);
#pragma unroll
                for (int c = 0; c < 4; ++c) {
                    const float xw = -(w0[c] + wr_[c]);
                    const float sp = xw > 20.f ? xw : 0.6931471805599453f * __builtin_amdgcn_logf(1.0f + __builtin_amdgcn_exp2f(1.4426950408889634f * xw));
                    const float ww = -sp - 0.5f;
                    dec[c] = __builtin_amdgcn_exp2f(-1.4426950408889634f * __builtin_amdgcn_exp2f(1.4426950408889634f * ww));
                    av[c] = fast_sigmoid(a0[c] + ar[c]);
                    kkv[c] = kq[c] * inv;
                    km[c] = kr[c] * (1.0f + (av[c] - 1.0f) * kac[c]);
                }
                *(LAS f32x4*)(bufp + 0 * VEC + (pt * 64 + pj) * 4) = -kkv;
                *(LAS f32x4*)(bufp + 1 * VEC + (pt * 64 + pj) * 4) = dec;
                *(LAS f32x4*)(bufp + 2 * VEC + (pt * 64 + pj) * 4) = kkv * av;
                *(LAS f32x4*)(bufp + 3 * VEC + (pt * 64 + pj) * 4) = km;
                *(LAS f32x4*)(bufp + 4 * VEC + (pt * 64 + pj) * 4) = rv;
                *(LAS f32x2*)(bufp + 5 * VEC + (pt * 32 + 2 * (tid & 15)) * 4) = (f32x2){bf_lo(nv), bf_hi(nv)};
            }
            __syncthreads();
            if (blk > 0) {
                const LAS unsigned char* pb = lds + ((blk - 1) & 1) * BUF + 5 * VEC + TS * 32 * 4;
                const f32x2 yv = *(const LAS f32x2*)(pb + (pt * 32 + 2 * (tid & 15)) * 4);
                *(unsigned*)(y + (size_t)(b * T + (blk - 1) * TS + pt) * D + ch + 32 * rh + 2 * (tid & 15)) = pk2(yv[0], yv[1]);
            }
            if (blk + 1 < T / TS) {
                const size_t o = (size_t)(b * T + (blk + 1) * TS + pt) * D + ch + pj;
                nr = *(const u32x2*)(rr + o); nk = *(const u32x2*)(kk_ + o); nw = *(const u32x2*)(wraw + o); na = *(const u32x2*)(araw + o);
                nv = *(const unsigned*)(vv + (size_t)(b * T + (blk + 1) * TS + pt) * D + ch + 32 * rh + 2 * (tid & 15));
            }
            const LAS unsigned char* va = bufp + 16 * cg;
            LAS float* yb = (LAS float*)(bufp + 5 * VEC + TS * 32 * 4);
#pragma unroll 4
            for (int s = 0; s < TS; ++s) {
                const f32x4 ah = *(const LAS f32x4*)(va + 0 * VEC + s * 256), wd = *(const LAS f32x4*)(va + 1 * VEC + s * 256), bb = *(const LAS f32x4*)(va + 2 * VEC + s * 256);
                const f32x4 kv = *(const LAS f32x4*)(va + 3 * VEC + s * 256), rv = *(const LAS f32x4*)(va + 4 * VEC + s * 256);
                const float vi = *(const LAS float*)(bufp + 5 * VEC + (s * 32 + 4 * w + r4) * 4);
                float sa = (S[0] * ah[0] + S[1] * ah[1]) + (S[2] * ah[2] + S[3] * ah[3]);
                sa = dpp_sum16(sa);
                S = S * wd + sa * bb + vi * kv;
                float yv = (S[0] * rv[0] + S[1] * rv[1]) + (S[2] * rv[2] + S[3] * rv[3]);
                yv = dpp_sum16(yv);
                if (cg == 0) yb[s * 32 + 4 * w + r4] = yv;
            }
        }
        __syncthreads();
        {
            const LAS unsigned char* pb = lds + ((T / TS - 1) & 1) * BUF + 5 * VEC + TS * 32 * 4;
            const f32x2 yv = *(const LAS f32x2*)(pb + (pt * 32 + 2 * (tid & 15)) * 4);
            *(unsigned*)(y + (size_t)(b * T + (T / TS - 1) * TS + pt) * D + ch + 32 * rh + 2 * (tid & 15)) = pk2(yv[0], yv[1]);
        }
        __syncthreads();
    }
}
__device__ __forceinline__ float dpp_sum8(float v) {
    v += __int_as_float(__builtin_amdgcn_update_dpp(0, __float_as_int(v), 0xB1, 0xF, 0xF, true));
    v += __int_as_float(__builtin_amdgcn_update_dpp(0, __float_as_int(v), 0x4E, 0xF, 0xF, true));
    v += __int_as_float(__builtin_amdgcn_update_dpp(0, __float_as_int(v), 0x141, 0xF, 0xF, true));
    return v;
}
__device__ __forceinline__ void rwkv_post_phase(const Frame& F, const Inputs& I, const bf16_t* y, const bf16_t* rr, const bf16_t* kk_, const bf16_t* vv, const bf16_t* araw, const bf16_t* gg, bf16_t* out, int Mh) {
    const int lane = opaque_tid() & 63;
    const int ntask = Mh * 2;
    for (int task = F.gw; task < ntask; task += F.NGW) {
        const int row = task >> 1, c0 = (task & 1) * 512 + 8 * lane; const size_t o = (size_t)row * D + c0;
        const u32x4 yu = *(const u32x4*)(y + o), ru = *(const u32x4*)(rr + o), ku = *(const u32x4*)(kk_ + o), vu = *(const u32x4*)(vv + o), au = *(const u32x4*)(araw + o), gu = *(const u32x4*)(gg + o);
        float yv[8], rv[8], kv[8], v8[8], av[8], gv[8], kac[8], rk[8], gg8[8], gb8[8];
        unpack8(yu, yv); unpack8(ru, rv); unpack8(ku, kv); unpack8(vu, v8); unpack8(au, av); unpack8(gu, gv);
#pragma unroll
        for (int e4 = 0; e4 < 2; ++e4) { const f32x4 a = *(const f32x4*)(I.rwkv_k_a + c0 + 4 * e4), b = *(const f32x4*)(I.rwkv_r_k + c0 + 4 * e4), c = *(const f32x4*)(I.rwkv_gn_g + c0 + 4 * e4), d = *(const f32x4*)(I.rwkv_gn_b + c0 + 4 * e4);
#pragma unroll
            for (int e = 0; e < 4; ++e) { kac[4 * e4 + e] = a[e]; rk[4 * e4 + e] = b[e]; gg8[4 * e4 + e] = c[e]; gb8[4 * e4 + e] = d[e]; } }
        float s1 = 0.f;
#pragma unroll
        for (int e = 0; e < 8; ++e) s1 += yv[e];
        const float mean = dpp_sum8(s1) * (1.0f / 64.0f);
        float s2 = 0.f, s3 = 0.f;
#pragma unroll
        for (int e = 0; e < 8; ++e) { const float d = yv[e] - mean; yv[e] = d; s2 = fmaf(d, d, s2); s3 = fmaf(rv[e] * rk[e], kv[e] * (1.0f + (av[e] - 1.0f) * kac[e]), s3); }
        const float rstd = rsqrtf(dpp_sum8(s2) * (1.0f / 64.0f) + 64e-5f), bonus = dpp_sum8(s3);
        float res[8];
#pragma unroll
        for (int e = 0; e < 8; ++e) res[e] = (yv[e] * rstd * gg8[e] + gb8[e] + bonus * v8[e]) * gv[e];
        *(u32x4*)(out + o) = pack8(res);
    }
}
#define MF16(a, b, c) __builtin_amdgcn_mfma_f32_16x16x32_bf16((a), (b), (c), 0, 0, 0)
#define WAVE_SYNC() asm volatile("s_waitcnt lgkmcnt(0)" ::: "memory")
__device__ __forceinline__ bf16x8 frag_lo(const f32x4 x) { u32x4 w; w.x = pk2(x[0], x[1]); w.y = pk2(x[2], x[3]); w.z = 0u; w.w = 0u; return __builtin_bit_cast(bf16x8, w); }
__device__ __forceinline__ bf16x8 frag_pair(const f32x4 lo, const f32x4 hi) { u32x4 w; w.x = pk2(lo[0], lo[1]); w.y = pk2(lo[2], lo[3]); w.z = pk2(hi[0], hi[1]); w.w = pk2(hi[2], hi[3]); return __builtin_bit_cast(bf16x8, w); }

__device__ __forceinline__ void rwkv_chunk_phase(const Frame& F, const Inputs& I, const bf16_t* rr, const bf16_t* kk_, const bf16_t* vv, const bf16_t* ldp, const bf16_t* ap, bf16_t* y, int nseq) {
    const int tid = opaque_tid(), lane = tid & 63, w = F.wave, fr = lane & 15, g = lane >> 4;
    if (w >= 2) return;
    constexpr int IMG_A = 0, IMG_B = 2304, IMG_K = 4608, IMG_R = 6912, IMG_S = 9216, IMG_V = 11520, SCR = 12288, WLO = 16640, WAVE_LDS = 17408;
    LAS unsigned char* L = F.lds + w * WAVE_LDS;
    const unsigned Lb = (unsigned)(size_t)L;
    const int tq = lane >> 2, jq = lane & 3;
    const int nitems = nseq * 64;
    const f32x4 zero4 = {0.f, 0.f, 0.f, 0.f};
    for (int item = 2 * F.vcu + w; item < nitems; item += 2 * F.G) {
        const int it = item & 3, h = (item >> 2) & 15, b = item >> 6, ch = h * 64, i0 = 16 * it;
        float kkc[16], kac[16];
#pragma unroll
        for (int c = 0; c < 16; ++c) { kkc[c] = I.rwkv_k_k[ch + 16 * jq + c]; kac[c] = I.rwkv_k_a[ch + 16 * jq + c]; }
        f32x4 Sm[4] = {zero4, zero4, zero4, zero4};
        for (int i = lane; i < 2304 / 16; i += 64) *(LAS u32x4*)(L + IMG_S + i * 16) = (u32x4){0u, 0u, 0u, 0u};
        u32x4 nk[2], na[2], nl[2], nr[2]; u32x2 nv;
        {   const size_t o = (size_t)(b * T + tq) * D + ch + 16 * jq;
            nk[0] = *(const u32x4*)(kk_ + o); nk[1] = *(const u32x4*)(kk_ + o + 8); na[0] = *(const u32x4*)(ap + o); na[1] = *(const u32x4*)(ap + o + 8);
            nl[0] = *(const u32x4*)(ldp + o); nl[1] = *(const u32x4*)(ldp + o + 8); nr[0] = *(const u32x4*)(rr + o); nr[1] = *(const u32x4*)(rr + o + 8);
            nv = *(const u32x2*)(vv + (size_t)(b * T + tq) * D + ch + i0 + 4 * jq); }
#pragma unroll 1
        for (int n = 0; n < T / 16; ++n) {
            const int row0 = b * T + 16 * n;
            float kf[16], af[16], rf[16];
            {
                float lf[16];
                unpack8(nl[0], lf); unpack8(nl[1], lf + 8); unpack8(nk[0], kf); unpack8(nk[1], kf + 8); unpack8(na[0], af); unpack8(na[1], af + 8); unpack8(nr[0], rf); unpack8(nr[1], rf + 8);
#pragma unroll
                for (int c = 0; c < 4; ++c) *(LAS f32x4*)(L + SCR + tq * 272 + (16 * jq + 4 * c) * 4) = (f32x4){lf[4 * c], lf[4 * c + 1], lf[4 * c + 2], lf[4 * c + 3]};
                *(LAS bf16_t*)(L + IMG_V + (4 * jq + 0) * 48 + tq * 2) = (bf16_t)(nv.x & 0xffffu); *(LAS bf16_t*)(L + IMG_V + (4 * jq + 1) * 48 + tq * 2) = (bf16_t)(nv.x >> 16);
                *(LAS bf16_t*)(L + IMG_V + (4 * jq + 2) * 48 + tq * 2) = (bf16_t)(nv.y & 0xffffu); *(LAS bf16_t*)(L + IMG_V + (4 * jq + 3) * 48 + tq * 2) = (bf16_t)(nv.y >> 16);
            }
            if (n + 1 < T / 16) {
                const size_t o = (size_t)(row0 + 16 + tq) * D + ch + 16 * jq;
                nk[0] = *(const u32x4*)(kk_ + o); nk[1] = *(const u32x4*)(kk_ + o + 8); na[0] = *(const u32x4*)(ap + o); na[1] = *(const u32x4*)(ap + o + 8);
                nl[0] = *(const u32x4*)(ldp + o); nl[1] = *(const u32x4*)(ldp + o + 8); nr[0] = *(const u32x4*)(rr + o); nr[1] = *(const u32x4*)(rr + o + 8);
                nv = *(const u32x2*)(vv + (size_t)(row0 + 16 + tq) * D + ch + i0 + 4 * jq);
            }
            WAVE_SYNC();
            {
                float cs = 0.f;
#pragma unroll
                for (int t = 0; t < 16; ++t) { cs += *(const LAS float*)(L + SCR + t * 272 + lane * 4); *(LAS float*)(L + SCR + t * 272 + lane * 4) = cs; }
                *(LAS float*)(L + WLO + lane * 4) = __builtin_amdgcn_exp2f(cs);
            }
            WAVE_SYNC();
            {
                float kq[16], n2 = 0.f;
#pragma unroll
                for (int c = 0; c < 16; ++c) { kq[c] = kf[c] * kkc[c]; n2 = fmaf(kq[c], kq[c], n2); }
                n2 += __int_as_float(__builtin_amdgcn_update_dpp(0, __float_as_int(n2), 0xB1, 0xF, 0xF, true));
                n2 += __int_as_float(__builtin_amdgcn_update_dpp(0, __float_as_int(n2), 0x4E, 0xF, 0xF, true));
                const float inv = 1.0f / fmaxf(sqrtf(n2), 1e-12f);
#pragma unroll
                for (int hh = 0; hh < 2; ++hh) {
                    float ci[8], cp[8], oa[8], ob[8], ok[8], orr[8];
#pragma unroll
                    for (int c = 0; c < 2; ++c) { const f32x4 x = *(const LAS f32x4*)(L + SCR + tq * 272 + (16 * jq + 8 * hh + 4 * c) * 4);
                        const f32x4 p = tq ? *(const LAS f32x4*)(L + SCR + (tq - 1) * 272 + (16 * jq + 8 * hh + 4 * c) * 4) : zero4;
#pragma unroll
                        for (int e = 0; e < 4; ++e) { ci[4 * c + e] = x[e]; cp[4 * c + e] = p[e]; } }
#pragma unroll
                    for (int c = 0; c < 8; ++c) {
                        const int cc = 8 * hh + c;
                        const float Wt = __builtin_amdgcn_exp2f(ci[c]), Wi = __builtin_amdgcn_exp2f(-ci[c]), Wp = __builtin_amdgcn_exp2f(cp[c]);
                        const float kkv = kq[cc] * inv, av = af[cc];
                        oa[c] = -kkv * Wp; ob[c] = kkv * av * Wi; ok[c] = kf[cc] * (1.0f + (av - 1.0f) * kac[cc]) * Wi; orr[c] = rf[cc] * Wt;
                    }
                    const int off = tq * 144 + (16 * jq + 8 * hh) * 2;
                    *(LAS u32x4*)(L + IMG_A + off) = pack8(oa); *(LAS u32x4*)(L + IMG_B + off) = pack8(ob); *(LAS u32x4*)(L + IMG_K + off) = pack8(ok); *(LAS u32x4*)(L + IMG_R + off) = pack8(orr);
                }
            }
            WAVE_SYNC();
            bf16x8 fa[2], fb[2], fk[2], fq[2], fs[2];
#pragma unroll
            for (int ks = 0; ks < 2; ++ks) { const int off = fr * 144 + (32 * ks + 8 * g) * 2;
                fa[ks] = *(const LAS bf16x8*)(L + IMG_A + off); fb[ks] = *(const LAS bf16x8*)(L + IMG_B + off); fk[ks] = *(const LAS bf16x8*)(L + IMG_K + off);
                fq[ks] = *(const LAS bf16x8*)(L + IMG_R + off); fs[ks] = *(const LAS bf16x8*)(L + IMG_S + off); }
            f32x4 N = MF16(fb[0], fa[0], zero4); N = MF16(fb[1], fa[1], N);
            f32x4 NT = MF16(fa[0], fb[0], zero4); NT = MF16(fa[1], fb[1], NT);
            f32x4 Mk = MF16(fk[0], fa[0], zero4); Mk = MF16(fk[1], fa[1], Mk);
            f32x4 Tb = MF16(fb[0], fq[0], zero4); Tb = MF16(fb[1], fq[1], Tb);
            f32x4 Tk = MF16(fk[0], fq[0], zero4); Tk = MF16(fk[1], fq[1], Tk);
            f32x4 P, PT;
#pragma unroll
            for (int e = 0; e < 4; ++e) { const int rw = 4 * g + e;
                N[e] = (rw < fr) ? N[e] : 0.f; Mk[e] = (rw < fr) ? Mk[e] : 0.f; NT[e] = (fr < rw) ? NT[e] : 0.f;
                Tb[e] = (rw <= fr) ? Tb[e] : 0.f; Tk[e] = (rw <= fr) ? Tk[e] : 0.f;
                P[e] = N[e] + ((rw == fr) ? 1.0f : 0.f); PT[e] = NT[e] + ((rw == fr) ? 1.0f : 0.f); }
            {
                f32x4 X = N, XT = NT;
#pragma unroll
                for (int lv = 0; lv < 3; ++lv) {
                    const bf16x8 xf = frag_lo(X), xtf = frag_lo(XT);
                    const f32x4 X2 = MF16(xtf, xf, zero4);
                    f32x4 X2T = zero4; if (lv < 2) X2T = MF16(xf, xtf, zero4);
                    const bf16x8 x2f = frag_lo(X2), ptf = frag_lo(PT);
                    P = MF16(ptf, x2f, P);
                    if (lv < 2) PT = MF16(x2f, ptf, PT);
                    X = X2; XT = X2T;
                }
            }
            const s16x4 v4 = *(const LAS s16x4*)(L + IMG_V + fr * 48 + 8 * g);
            const s16x4 z4 = {0, 0, 0, 0};
            f32x4 GT = MF16(fa[0], fs[0], zero4); GT = MF16(fa[1], fs[1], GT);
            GT = MF16(frag_lo(Mk), __builtin_shufflevector(v4, z4, 0, 1, 2, 3, 4, 5, 6, 7), GT);
            const f32x4 UT = MF16(frag_lo(P), frag_lo(GT), zero4);
            u32x4 auw; auw.x = pk2(UT[0], UT[1]); auw.y = pk2(UT[2], UT[3]); { const u32x2 vv2 = __builtin_bit_cast(u32x2, v4); auw.z = vv2.x; auw.w = vv2.y; }
            const bf16x8 auv = __builtin_bit_cast(bf16x8, auw);
            f32x4 Y = MF16(fs[0], fq[0], zero4); Y = MF16(fs[1], fq[1], Y);
            Y = MF16(auv, frag_pair(Tb, Tk), Y);
            { u32x2 wv; wv.x = pk2(Y[0], Y[1]); wv.y = pk2(Y[2], Y[3]); *(u32x2*)(y + (size_t)(row0 + fr) * D + ch + i0 + 4 * g) = wv; }
            {
                s16x4 tb[4], tk[4];
                const unsigned ad = Lb + IMG_B + (unsigned)((4 * g + (fr >> 2)) * 144 + 8 * (fr & 3));
                asm volatile("ds_read_b64_tr_b16 %0, %8 offset:0\n\tds_read_b64_tr_b16 %1, %8 offset:32\n\tds_read_b64_tr_b16 %2, %8 offset:64\n\tds_read_b64_tr_b16 %3, %8 offset:96\n\t"
                             "ds_read_b64_tr_b16 %4, %8 offset:2304\n\tds_read_b64_tr_b16 %5, %8 offset:2336\n\tds_read_b64_tr_b16 %6, %8 offset:2368\n\tds_read_b64_tr_b16 %7, %8 offset:2400\n\ts_waitcnt lgkmcnt(0)"
                             : "=&v"(tb[0]), "=&v"(tb[1]), "=&v"(tb[2]), "=&v"(tb[3]), "=&v"(tk[0]), "=&v"(tk[1]), "=&v"(tk[2]), "=&v"(tk[3]) : "v"(ad) : "memory");
#pragma unroll
                for (int jt = 0; jt < 4; ++jt) {
                    Sm[jt] = MF16(auv, __builtin_shufflevector(tb[jt], tk[jt], 0, 1, 2, 3, 4, 5, 6, 7), Sm[jt]);
                    Sm[jt] *= *(const LAS float*)(L + WLO + (16 * jt + fr) * 4);
#pragma unroll
                    for (int e = 0; e < 4; ++e) *(LAS bf16_t*)(L + IMG_S + (4 * g + e) * 144 + (16 * jt + fr) * 2) = (bf16_t)(pk2(Sm[jt][e], 0.f) & 0xffffu);
                }
            }
            WAVE_SYNC();
        }
    }
}

#ifndef RW_BAR
#define RW_BAR() do { asm volatile("s_waitcnt lgkmcnt(0)" ::: "memory"); __builtin_amdgcn_s_barrier(); asm volatile("" ::: "memory"); } while (0)
#endif
__device__ __forceinline__ void rwkv_chunk_pipe_phase(const Frame& F, const Inputs& I, const bf16_t* rr, const bf16_t* kk_, const bf16_t* vv, const bf16_t* ldp, const bf16_t* ap, bf16_t* y, int nseq, unsigned long long& pr_acc) {
#ifndef RWS
#define RWS (-1)
#endif
#define RWS_T0(k) unsigned long long rws_t0 = 0ull; if (RWS == (k)) rws_t0 = __builtin_amdgcn_s_memrealtime()
#define RWS_T1(k) do { if (RWS == (k)) { asm volatile("s_waitcnt lgkmcnt(0)" ::: "memory"); pr_acc += __builtin_amdgcn_s_memrealtime() - rws_t0; } } while (0)
    const int tid = opaque_tid(), lane = tid & 63, w = F.wave, fr = lane & 15, g = lane >> 4;
    const int q = w >> 2, st = (w + q) & 3;
    constexpr int SCRSZ = 2 * 4352, SCR0 = 0, WL0 = 2 * SCRSZ, IMG0 = WL0 + 1024, IMGSZ = 9984, SM0 = IMG0 + 3 * IMGSZ, IMGS = SM0 + 8192, KC0 = IMGS + 2304, SLOT = KC0 + 512;
    constexpr int IA = 0, IB = 2304, IK = 4608, IR = 6912, IV = 9216;
    LAS unsigned char* L = F.lds + q * SLOT;
    const unsigned Lb = (unsigned)(size_t)L;
    const int tq = lane >> 2, jq = lane & 3;
    const int nitems = nseq * 64, NCH = T / 16;
    const f32x4 zero4 = {0.f, 0.f, 0.f, 0.f};
    const int trips = (nitems - 2 * F.vcu + 2 * F.G - 1) / (2 * F.G);
    for (int trip = 0; trip < trips; ++trip) {
        const int item = 2 * F.vcu + q + trip * 2 * F.G;
        const int it = item & 3, h = (item >> 2) & 15, b = item >> 6, ch = h * 64, i0 = 16 * it;
        const size_t gbase = (size_t)(b * T + tq) * D + ch + 16 * jq;
        if (st == 0) {
            u32x4 p0[2], p1[2];
            p0[0] = *(const u32x4*)(ldp + gbase); p0[1] = *(const u32x4*)(ldp + gbase + 8);
            p1[0] = *(const u32x4*)(ldp + gbase + (size_t)16 * D); p1[1] = *(const u32x4*)(ldp + gbase + (size_t)16 * D + 8);
#pragma unroll 1
            for (int c0 = 0; c0 < NCH; c0 += 2) {
#pragma unroll
                for (int sub = 0; sub < 2; ++sub) {
                    const int c = c0 + sub;
                    RWS_T0(0);
                    LAS unsigned char* scr = L + SCR0 + (c & 1) * SCRSZ;
                    float lf[16]; if (sub == 0) { unpack8(p0[0], lf); unpack8(p0[1], lf + 8); } else { unpack8(p1[0], lf); unpack8(p1[1], lf + 8); }
                    { const int cn = (c + 2 < NCH) ? c + 2 : NCH - 1; const size_t o = gbase + (size_t)cn * 16 * D;
                      if (sub == 0) { p0[0] = *(const u32x4*)(ldp + o); p0[1] = *(const u32x4*)(ldp + o + 8); } else { p1[0] = *(const u32x4*)(ldp + o); p1[1] = *(const u32x4*)(ldp + o + 8); } }
#pragma unroll
                    for (int e = 0; e < 4; ++e) *(LAS f32x4*)(scr + tq * 272 + (16 * jq + 4 * e) * 4) = (f32x4){lf[4 * e], lf[4 * e + 1], lf[4 * e + 2], lf[4 * e + 3]};
                    WAVE_SYNC();
                    float lcol[16], cs = 0.f, wt = 1.f;
#pragma unroll
                    for (int t = 0; t < 16; ++t) lcol[t] = *(const LAS float*)(scr + t * 272 + lane * 4);
#pragma unroll
                    for (int t = 0; t < 16; ++t) { cs += lcol[t]; wt = __builtin_amdgcn_exp2f(cs);
                        *(LAS float*)(scr + t * 272 + lane * 4) = wt; *(LAS float*)(scr + 4352 + t * 272 + lane * 4) = __builtin_amdgcn_exp2f(-cs); }
                    *(LAS float*)(L + WL0 + (c & 3) * 256 + lane * 4) = wt;
                    RWS_T1(0);
                    RW_BAR();
                }
            }
            RW_BAR(); RW_BAR(); RW_BAR(); RW_BAR();
        } else if (st == 1) {
            *(LAS float*)(L + KC0 + lane * 4) = I.rwkv_k_k[ch + lane]; *(LAS float*)(L + KC0 + 256 + lane * 4) = I.rwkv_k_a[ch + lane];
            const size_t vbase = (size_t)(b * T + tq) * D + ch + i0 + 4 * jq;
            u32x4 k0[2], a0[2], r0[2], k1[2], a1[2], r1[2]; u32x2 v0, v1;
            k0[0] = *(const u32x4*)(kk_ + gbase); k0[1] = *(const u32x4*)(kk_ + gbase + 8); a0[0] = *(const u32x4*)(ap + gbase); a0[1] = *(const u32x4*)(ap + gbase + 8);
            r0[0] = *(const u32x4*)(rr + gbase); r0[1] = *(const u32x4*)(rr + gbase + 8); v0 = *(const u32x2*)(vv + vbase);
            { const size_t o = gbase + (size_t)16 * D;
              k1[0] = *(const u32x4*)(kk_ + o); k1[1] = *(const u32x4*)(kk_ + o + 8); a1[0] = *(const u32x4*)(ap + o); a1[1] = *(const u32x4*)(ap + o + 8);
              r1[0] = *(const u32x4*)(rr + o); r1[1] = *(const u32x4*)(rr + o + 8); v1 = *(const u32x2*)(vv + vbase + (size_t)16 * D); }
            RW_BAR();
#pragma unroll 1
            for (int c0 = 0; c0 < NCH; c0 += 2) {
#pragma unroll
                for (int sub = 0; sub < 2; ++sub) {
                    const int c = c0 + sub;
                    RWS_T0(1);
                    const LAS unsigned char* scr = L + SCR0 + (c & 1) * SCRSZ;
                    LAS unsigned char* img = L + IMG0 + (c % 3) * IMGSZ;
                    u32x4 ck[2], ca[2], cr[2]; u32x2 cv;
                    if (sub == 0) { ck[0] = k0[0]; ck[1] = k0[1]; ca[0] = a0[0]; ca[1] = a0[1]; cr[0] = r0[0]; cr[1] = r0[1]; cv = v0; }
                    else { ck[0] = k1[0]; ck[1] = k1[1]; ca[0] = a1[0]; ca[1] = a1[1]; cr[0] = r1[0]; cr[1] = r1[1]; cv = v1; }
                    { const int cn = (c + 2 < NCH) ? c + 2 : NCH - 1; const size_t o = gbase + (size_t)cn * 16 * D, ov = vbase + (size_t)cn * 16 * D;
                      if (sub == 0) { k0[0] = *(const u32x4*)(kk_ + o); k0[1] = *(const u32x4*)(kk_ + o + 8); a0[0] = *(const u32x4*)(ap + o); a0[1] = *(const u32x4*)(ap + o + 8); r0[0] = *(const u32x4*)(rr + o); r0[1] = *(const u32x4*)(rr + o + 8); v0 = *(const u32x2*)(vv + ov); }
                      else { k1[0] = *(const u32x4*)(kk_ + o); k1[1] = *(const u32x4*)(kk_ + o + 8); a1[0] = *(const u32x4*)(ap + o); a1[1] = *(const u32x4*)(ap + o + 8); r1[0] = *(const u32x4*)(rr + o); r1[1] = *(const u32x4*)(rr + o + 8); v1 = *(const u32x2*)(vv + ov); } }
                    *(LAS bf16_t*)(img + IV + (4 * jq + 0) * 48 + tq * 2) = (bf16_t)(cv.x & 0xffffu); *(LAS bf16_t*)(img + IV + (4 * jq + 1) * 48 + tq * 2) = (bf16_t)(cv.x >> 16);
                    *(LAS bf16_t*)(img + IV + (4 * jq + 2) * 48 + tq * 2) = (bf16_t)(cv.y & 0xffffu); *(LAS bf16_t*)(img + IV + (4 * jq + 3) * 48 + tq * 2) = (bf16_t)(cv.y >> 16);
                    float n2 = 0.f;
#pragma unroll
                    for (int hh = 0; hh < 2; ++hh) { float kf[8]; unpack8(ck[hh], kf);
#pragma unroll
                        for (int e4 = 0; e4 < 2; ++e4) { const f32x4 kc = *(const LAS f32x4*)(L + KC0 + (16 * jq + 8 * hh + 4 * e4) * 4);
#pragma unroll
                            for (int e = 0; e < 4; ++e) { const float x = kf[4 * e4 + e] * kc[e]; n2 = fmaf(x, x, n2); } } }
                    n2 += __int_as_float(__builtin_amdgcn_update_dpp(0, __float_as_int(n2), 0xB1, 0xF, 0xF, true));
                    n2 += __int_as_float(__builtin_amdgcn_update_dpp(0, __float_as_int(n2), 0x4E, 0xF, 0xF, true));
                    const float inv = 1.0f / fmaxf(sqrtf(n2), 1e-12f);
#pragma unroll
                    for (int hh = 0; hh < 2; ++hh) {
                        float kf[8], af[8], rf[8], kac[8], kkc8[8], ci[8], cp[8], oa[8], ob[8], ok[8], orr[8];
                        unpack8(ck[hh], kf); unpack8(ca[hh], af); unpack8(cr[hh], rf);
#pragma unroll
                        for (int e2 = 0; e2 < 2; ++e2) { const int so = (16 * jq + 8 * hh + 4 * e2) * 4;
                            const f32x4 x = *(const LAS f32x4*)(scr + tq * 272 + so), xi = *(const LAS f32x4*)(scr + 4352 + tq * 272 + so);
                            const f32x4 p = tq ? *(const LAS f32x4*)(scr + (tq - 1) * 272 + so) : (f32x4){1.f, 1.f, 1.f, 1.f};
                            const f32x4 ka = *(const LAS f32x4*)(L + KC0 + 256 + so), kc = *(const LAS f32x4*)(L + KC0 + so);
#pragma unroll
                            for (int e = 0; e < 4; ++e) { ci[4 * e2 + e] = x[e]; cp[4 * e2 + e] = p[e]; oa[4 * e2 + e] = xi[e]; kac[4 * e2 + e] = ka[e]; kkc8[4 * e2 + e] = kc[e]; } }
#pragma unroll
                        for (int e = 0; e < 8; ++e) {
                            const float Wt = ci[e], Wi = oa[e], Wp = cp[e];
                            const float kkv = kf[e] * kkc8[e] * inv, av = af[e];
                            oa[e] = -kkv * Wp; ob[e] = kkv * av * Wi; ok[e] = kf[e] * (1.0f + (av - 1.0f) * kac[e]) * Wi; orr[e] = rf[e] * Wt;
                        }
                        const int off = tq * 144 + (16 * jq + 8 * hh) * 2;
                        *(LAS u32x4*)(img + IA + off) = pack8(oa); *(LAS u32x4*)(img + IB + off) = pack8(ob); *(LAS u32x4*)(img + IK + off) = pack8(ok); *(LAS u32x4*)(img + IR + off) = pack8(orr);
                    }
                    RWS_T1(1);
                    RW_BAR();
                }
            }
            RW_BAR(); RW_BAR(); RW_BAR();
        } else if (st == 2) {
            RW_BAR(); RW_BAR();
#pragma unroll 1
            for (int c = 0; c < NCH; ++c) {
                RWS_T0(2);
                const LAS unsigned char* img = L + IMG0 + (c % 3) * IMGSZ;
                LAS unsigned char* sm = L + SM0 + (c & 1) * 4096;
                bf16x8 fa[2], fb[2], fk[2], fq[2];
#pragma unroll
                for (int ks = 0; ks < 2; ++ks) { const int off = fr * 144 + (32 * ks + 8 * g) * 2;
                    fa[ks] = *(const LAS bf16x8*)(img + IA + off); fb[ks] = *(const LAS bf16x8*)(img + IB + off); fk[ks] = *(const LAS bf16x8*)(img + IK + off); fq[ks] = *(const LAS bf16x8*)(img + IR + off); }
                f32x4 N = MF16(fb[0], fa[0], zero4); N = MF16(fb[1], fa[1], N);
                f32x4 NT = MF16(fa[0], fb[0], zero4); NT = MF16(fa[1], fb[1], NT);
                f32x4 Mk = MF16(fk[0], fa[0], zero4); Mk = MF16(fk[1], fa[1], Mk);
                f32x4 Tb = MF16(fb[0], fq[0], zero4); Tb = MF16(fb[1], fq[1], Tb);
                f32x4 Tk = MF16(fk[0], fq[0], zero4); Tk = MF16(fk[1], fq[1], Tk);
                f32x4 P, PT;
#pragma unroll
                for (int e = 0; e < 4; ++e) { const int rw = 4 * g + e;
                    N[e] = (rw < fr) ? N[e] : 0.f; Mk[e] = (rw < fr) ? Mk[e] : 0.f; NT[e] = (fr < rw) ? NT[e] : 0.f;
                    Tb[e] = (rw <= fr) ? Tb[e] : 0.f; Tk[e] = (rw <= fr) ? Tk[e] : 0.f;
                    P[e] = N[e] + ((rw == fr) ? 1.0f : 0.f); PT[e] = NT[e] + ((rw == fr) ? 1.0f : 0.f); }
                f32x4 X = N, XT = NT;
#pragma unroll
                for (int lv = 0; lv < 3; ++lv) {
                    const bf16x8 xf = frag_lo(X), xtf = frag_lo(XT);
                    const f32x4 X2 = MF16(xtf, xf, zero4);
                    f32x4 X2T = zero4; if (lv < 2) X2T = MF16(xf, xtf, zero4);
                    const bf16x8 x2f = frag_lo(X2), ptf = frag_lo(PT);
                    P = MF16(ptf, x2f, P);
                    if (lv < 2) PT = MF16(x2f, ptf, PT);
                    X = X2; XT = X2T;
                }
                *(LAS f32x4*)(sm + 0 * 1024 + lane * 16) = Mk; *(LAS f32x4*)(sm + 1 * 1024 + lane * 16) = Tb; *(LAS f32x4*)(sm + 2 * 1024 + lane * 16) = Tk; *(LAS f32x4*)(sm + 3 * 1024 + lane * 16) = P;
                RWS_T1(2);
                RW_BAR();
            }
            RW_BAR(); RW_BAR();
        } else {
            f32x4 Sm[4] = {zero4, zero4, zero4, zero4};
            for (int i = lane; i < 2304 / 16; i += 64) *(LAS u32x4*)(L + IMGS + i * 16) = (u32x4){0u, 0u, 0u, 0u};
            RW_BAR(); RW_BAR(); RW_BAR();
#pragma unroll 1
            for (int c = 0; c < NCH; ++c) {
                RWS_T0(3);
                const int row0 = b * T + 16 * c;
                const LAS unsigned char* img = L + IMG0 + (c % 3) * IMGSZ;
                const LAS unsigned char* sm = L + SM0 + (c & 1) * 4096;
                bf16x8 fa[2], fq[2], fs[2];
#pragma unroll
                for (int ks = 0; ks < 2; ++ks) { const int off = fr * 144 + (32 * ks + 8 * g) * 2;
                    fa[ks] = *(const LAS bf16x8*)(img + IA + off); fq[ks] = *(const LAS bf16x8*)(img + IR + off); fs[ks] = *(const LAS bf16x8*)(L + IMGS + off); }
                const f32x4 Mk = *(const LAS f32x4*)(sm + 0 * 1024 + lane * 16), Tb = *(const LAS f32x4*)(sm + 1 * 1024 + lane * 16), Tk = *(const LAS f32x4*)(sm + 2 * 1024 + lane * 16), P = *(const LAS f32x4*)(sm + 3 * 1024 + lane * 16);
                const s16x4 v4 = *(const LAS s16x4*)(img + IV + fr * 48 + 8 * g);
                const s16x4 z4 = {0, 0, 0, 0};
                f32x4 GT = MF16(fa[0], fs[0], zero4); GT = MF16(fa[1], fs[1], GT);
                GT = MF16(frag_lo(Mk), __builtin_shufflevector(v4, z4, 0, 1, 2, 3, 4, 5, 6, 7), GT);
                const f32x4 UT = MF16(frag_lo(P), frag_lo(GT), zero4);
                u32x4 auw; auw.x = pk2(UT[0], UT[1]); auw.y = pk2(UT[2], UT[3]); { const u32x2 vv2 = __builtin_bit_cast(u32x2, v4); auw.z = vv2.x; auw.w = vv2.y; }
                const bf16x8 auv = __builtin_bit_cast(bf16x8, auw);
                f32x4 Y = MF16(fs[0], fq[0], zero4); Y = MF16(fs[1], fq[1], Y);
                Y = MF16(auv, frag_pair(Tb, Tk), Y);
                { u32x2 wv; wv.x = pk2(Y[0], Y[1]); wv.y = pk2(Y[2], Y[3]); *(u32x2*)(y + (size_t)(row0 + fr) * D + ch + i0 + 4 * g) = wv; }
                s16x4 tb[4], tk[4];
                const unsigned ad = Lb + IMG0 + (unsigned)((c % 3) * IMGSZ) + IB + (unsigned)((4 * g + (fr >> 2)) * 144 + 8 * (fr & 3));
                asm volatile("ds_read_b64_tr_b16 %0, %8 offset:0\n\tds_read_b64_tr_b16 %1, %8 offset:32\n\tds_read_b64_tr_b16 %2, %8 offset:64\n\tds_read_b64_tr_b16 %3, %8 offset:96\n\t"
                             "ds_read_b64_tr_b16 %4, %8 offset:2304\n\tds_read_b64_tr_b16 %5, %8 offset:2336\n\tds_read_b64_tr_b16 %6, %8 offset:2368\n\tds_read_b64_tr_b16 %7, %8 offset:2400\n\ts_waitcnt lgkmcnt(0)"
                             : "=&v"(tb[0]), "=&v"(tb[1]), "=&v"(tb[2]), "=&v"(tb[3]), "=&v"(tk[0]), "=&v"(tk[1]), "=&v"(tk[2]), "=&v"(tk[3]) : "v"(ad) : "memory");
#pragma unroll
                for (int jt = 0; jt < 4; ++jt) {
                    Sm[jt] = MF16(auv, __builtin_shufflevector(tb[jt], tk[jt], 0, 1, 2, 3, 4, 5, 6, 7), Sm[jt]);
                    Sm[jt] *= *(const LAS float*)(L + WL0 + (c & 3) * 256 + (16 * jt + fr) * 4);
#pragma unroll
                    for (int e = 0; e < 4; ++e) *(LAS bf16_t*)(L + IMGS + (4 * g + e) * 144 + (16 * jt + fr) * 2) = (bf16_t)(pk2(Sm[jt][e], 0.f) & 0xffffu);
                }
                RWS_T1(3);
                RW_BAR();
            }
            RW_BAR();
        }
        __syncthreads();
    }
}
#define MIXER_CONV \
        if (L == 0) { \
            bf16_t* const Ub = (bf16_t*)act; bf16_t* const Sb = (bf16_t*)act + (size_t)M * D; \
            if (IN(base + 0)) {        \
                zero_i64(F, ssq_m_out, M); \
                pg8::Gemm g = pg8::make_gemm(F.Xb, D, (const bf16_t*)(wb + WB_CONV_IN), D, M, 2 * D, D); \
                pg8::StaticOrder S; S.init(g.M, g.N, F.G, (int)blockIdx.x); \
                pg8::EpiGated<1> E{Ub, D, ssq_m_in, I.conv_b_in, I.conv_b_in + D}; \
                pg8::gemm_phase(F.lds, g, S, E); \
                SEAM(base + 0, 2); \
            } \
            if (IN(base + 1)) { conv_ln_phase(F, I, Ub, Sb); SEAM(base + 1, 3); } \
            if (IN(base + 2)) {        \
                pg8::Gemm g = pg8::make_gemm(Sb, D, (const bf16_t*)(wb + WB_CONV_OUT), D, M, D, D); \
                pg8::StaticOrder S; S.init(g.M, g.N, F.G, (int)blockIdx.x); \
                pg8::EpiResid E{F.Xb, ssq_m_out, I.conv_b_out, 0}; \
                pg8::gemm_phase(F.lds, g, S, E); \
                SEAM(base + 2, 4); \
            } \
        }
#define MIXER_SGU \
        if (L == 2) { \
            bf16_t* const Zb = (bf16_t*)act; \
            if (IN(base + 0)) {        \
                zero_i64(F, ssq_m_out, M); \
                pg8::Gemm g = pg8::make_gemm(F.Xb, D, (const bf16_t*)(wb + WB_SGU_IN), D, M, 4096, D); \
                pg8::StaticOrder S; S.init(g.M, g.N, F.G, (int)blockIdx.x); \
                pg8::EpiGeluStats E{Zb, 4096, ssq_m_in, I.sgu_b_in, F.lns, 8}; \
                pg8::gemm_phase(F.lds, g, S, E); \
                SEAM(base + 0, 11); \
            } \
            if (IN(base + 1)) { sgu_spatial_phase(F, I, Zb); SEAM(base + 1, 12); } \
            if (IN(base + 2)) {        \
                pg8::Gemm g = pg8::make_gemm(Zb, 4096, (const bf16_t*)(wb + WB_SGU_OUT), 2048, M, D, 2048); \
                pg8::StaticOrder S; S.init(g.M, g.N, F.G, (int)blockIdx.x); \
                pg8::EpiResid E{F.Xb, ssq_m_out, nullptr, 0}; \
                pg8::gemm_phase(F.lds, g, S, E); \
                SEAM(base + 2, 13); \
            } \
        }
#define MIXER_RET \
        if (L == 3) { \
            bf16_t* const QKVb = (bf16_t*)act;          \
            if (IN(base + 0)) {        \
                zero_i64(F, ssq_m_out, M); \
                pg8::Gemm g = pg8::make_gemm(F.Xb, D, (const bf16_t*)(wb + WB_RET_QKV), D, M, 4096, D); \
                pg8::StaticOrder S; S.init(g.M, g.N, F.G, (int)blockIdx.x); \
                pg8::EpiRope E{QKVb, 4096, ssq_m_in, (const f32x4*)(a.ws + F.wm.rope), 0, 8}; \
                pg8::gemm_phase(F.lds, g, S, E); \
                SEAM(base + 0, 14); \
            } \
            if (IN(base + 1)) { ret_chunk_phase(F, QKVb, F.oss, F.NB); SEAM(base + 1, 15); } \
            if (IN(base + 2)) {        \
                pg8::Gemm g = pg8::make_gemm(F.Xb, D, (const bf16_t*)(wb + WB_RET_G), D, M, 2048, D); \
                pg8::StaticOrder S; S.init(g.M, g.N, F.G, (int)blockIdx.x); \
                pg8::EpiRetGate E{QKVb + 2048, 4096, ssq_m_in, F.oss, 0}; \
                pg8::gemm_phase(F.lds, g, S, E); \
                SEAM(base + 2, 16); \
            } \
            if (IN(base + 3)) {        \
                pg8::Gemm g = pg8::make_gemm(QKVb + 2048, 4096, (const bf16_t*)(wb + WB_RET_OUT), 2048, M, D, 2048); \
                pg8::StaticOrder S; S.init(g.M, g.N, F.G, (int)blockIdx.x); \
                pg8::EpiResid E{F.Xb, ssq_m_out, nullptr, 0}; \
                pg8::gemm_phase(F.lds, g, S, E); \
                SEAM(base + 3, 17); \
            } \
        }
#define MIXER_RWKV \
        if (L == 1) { \
            const int Mh = M / 2; const size_t MD = (size_t)Mh * D; \
            bf16_t* const hnp = (bf16_t*)act; bf16_t* const xsb = hnp + MD + (size_t)64 * D; bf16_t* const rkv = xsb + 3 * MD; bf16_t* const l1b = rkv + 3 * MD; \
            bf16_t* const wagb = xsb; bf16_t* const yb = hnp; bf16_t* const Ob = xsb; \
            for (int hf = 0; hf < 2; ++hf) { \
                const int rb = hf * Mh, pb = base + 6 * hf; \
                if (IN(pb + 0)) { if (hf == 0) zero_i64(F, ssq_m_out, M); rwkv_mix_phase(F, I, F.Xb, ssq_m_in, rb, Mh, hnp, xsb); SEAM(pb + 0, 5); } \
                if (IN(pb + 1)) {        \
                    const int Gh = F.G / 2; \
                    if ((int)blockIdx.x < Gh) { \
                      pg8::Gemm g = pg8::make_gemm(hnp, D, (const bf16_t*)(wb + WB_RW_L1), 2 * D, Mh, 512, 2 * D); g.seq_pad = 1; g.ksplit = 16; g.ajump = -(D * 2 + 16 * 128); \
                      pg8::StaticOrder S; S.init(g.M, g.N, Gh, (int)blockIdx.x); \
                      pg8::EpiLora1 E{l1b, 512}; \
                      pg8::gemm_phase(F.lds, g, S, E); \
                    } else { \
                      pg8::Gemm g = pg8::make_gemm(xsb, D, (const bf16_t*)(wb + WB_RW_RKV), D, Mh, D, D); \
                      pg8::StaticOrder S; S.init(g.M, g.N, F.G - Gh, (int)blockIdx.x - Gh); \
                      pg8::EpiBf16 E{rkv, D, nullptr, nullptr, nullptr, 0}; \
                      pg8::gemm_phase(F.lds, g, S, E); \
                    } \
                    for (int i = 1; i < 3; ++i) { \
                      pg8::Gemm g = pg8::make_gemm(xsb + i * MD, D, (const bf16_t*)(wb + WB_RW_RKV) + (size_t)i * D * D, D, Mh, D, D); \
                      pg8::StaticOrder S; S.init(g.M, g.N, F.G, (int)blockIdx.x); \
                      pg8::EpiBf16 E{rkv + i * MD, D, nullptr, nullptr, nullptr, 0}; \
                      pg8::gemm_phase(F.lds, g, S, E); } \
                    SEAM(pb + 1, 6); \
                } \
                if (IN(pb + 2)) {        \
                    { pg8::Gemm g = pg8::make_gemm(l1b, 512, (const bf16_t*)(wb + WB_RW_W2), 256, Mh, D, 256); \
                      pg8::StaticOrder S; S.init(g.M, g.N, F.G, (int)blockIdx.x); \
                      pg8::EpiRwkvAct<0> E{wagb, D, I.rwkv_w0}; \
                      pg8::gemm_phase(F.lds, g, S, E); } \
                    { pg8::Gemm g = pg8::make_gemm(l1b, 512, (const bf16_t*)(wb + WB_RW_A2), 256, Mh, D, 256); \
                      pg8::StaticOrder S; S.init(g.M, g.N, F.G, (int)blockIdx.x); \
                      pg8::EpiRwkvAct<1> E{wagb + MD, D, I.rwkv_a0}; \
                      pg8::gemm_phase(F.lds, g, S, E); } \
                    { pg8::Gemm g = pg8::make_gemm(l1b + 128, 512, (const bf16_t*)(wb + WB_RW_G2), 256, Mh, D, 256); \
                      pg8::StaticOrder S; S.init(g.M, g.N, F.G, (int)blockIdx.x); \
                      pg8::EpiBf16 E{wagb + 2 * MD, D, nullptr, nullptr, nullptr, 0}; \
                      pg8::gemm_phase(F.lds, g, S, E); } \
                    SEAM(pb + 2, 7); \
                } \
                if (IN(pb + 3)) { rwkv_chunk_pipe_phase(F, I, rkv, rkv + MD, rkv + 2 * MD, wagb, wagb + MD, yb, F.NB / 2, pr_sum); SEAM(pb + 3, 8); } \
                if (IN(pb + 4)) { rwkv_post_phase(F, I, yb, rkv, rkv + MD, rkv + 2 * MD, wagb + MD, wagb + 2 * MD, Ob, Mh); SEAM(pb + 4, 9); } \
                if (IN(pb + 5)) {        \
                    pg8::Gemm g = pg8::make_gemm(Ob, D, (const bf16_t*)(wb + WB_RW_WO), D, Mh, D, D); \
                    pg8::StaticOrder S; S.init(g.M, g.N, F.G, (int)blockIdx.x); \
                    pg8::EpiResid E{F.Xb, ssq_m_out, nullptr, rb}; \
                    pg8::gemm_phase(F.lds, g, S, E); \
                    SEAM(pb + 5, 10); \
                } \
            } \
        }
#define MIXER_PHASES MIXER_CONV MIXER_RWKV MIXER_SGU MIXER_RET
constexpr int PH_LAYER0 = 2, PH_PER_LAYER = 17, PH_XATTN = 12, PH_FFN = 15, PH_FINAL = PH_LAYER0 + 4 * PH_PER_LAYER, PH_END = PH_FINAL + 1;

__global__ void __launch_bounds__(NTHREADS, 2) mega(Args a) {
    extern __shared__ __attribute__((aligned(16))) unsigned char lds_raw[];
    Frame F;
    F.lds = (LAS unsigned char*)lds_raw;
    F.wave = __builtin_amdgcn_readfirstlane((int)threadIdx.x >> 6);
    F.G = gridDim.x; { const int bx = blockIdx.x; F.vcu = (F.G % 8 == 0) ? (bx % 8) * (F.G / 8) + bx / 8 : bx; }
    F.gw = F.vcu * NWAVES + F.wave; F.NGW = F.G * NWAVES; F.conv_rot = 0;
    F.NB = a.NB; F.M = a.NB * T; F.ws = a.ws; F.wm = make_wsmap(a.NB);
    F.Xb = (bf16_t*)(a.ws + F.wm.xb); F.ssq = (i64*)(a.ws + F.wm.ssq); F.lns = (i64*)(a.ws + F.wm.lns); F.oss = (i64*)(a.ws + F.wm.oss);
    const Inputs& I = a.in;
    const int M = F.M;
    volatile LAS unsigned* lctl = (volatile LAS unsigned*)(F.lds + LDSCTL_OFF);
    if (threadIdx.x < 64) lctl[threadIdx.x] = 0u;
    __syncthreads();
    XcdBarrier bar; bar.bar = (unsigned*)(a.ws + F.wm.ctl) + 4096; bar.x = 0; bar.st = lctl;
    if (a.use_bar) bar = xcd_barrier_post((unsigned*)(a.ws + F.wm.ctl) + 4096, lctl);
    const int lo = a.ph_lo, hi = a.ph_hi;
#define IN(k) (lo <= (k) && (k) < hi)
#ifndef PROBE_MASK
#define PROBE_MASK 0ull
#endif
#ifndef PROBE_MULT
#define PROBE_MULT 4
#endif
    unsigned long long pr_last = 0ull, pr_sum = 0ull;
    if (PROBE_MASK) pr_last = __builtin_amdgcn_s_memrealtime();
#ifndef BAR_PROBE
#define BAR_PROBE 0
#endif
#define SEAM(k, site) do { unsigned long long bt0_ = 0ull; if (BAR_PROBE) bt0_ = __builtin_amdgcn_s_memrealtime(); \
        if (a.use_bar && (k) + 1 < hi) xcd_barrier(bar); else __syncthreads(); \
        if (BAR_PROBE) pr_sum += __builtin_amdgcn_s_memrealtime() - bt0_; \
        if (PROBE_MASK) { const unsigned long long now_ = __builtin_amdgcn_s_memrealtime(); if ((PROBE_MASK >> (site)) & 1ull) pr_sum += now_ - pr_last; pr_last = now_; } } while (0)
    unsigned char* const wbuf0 = a.ws + F.wm.wb0; unsigned char* const wbuf1 = a.ws + F.wm.wb1;
#define WBUF(i) (((i) & 1) ? wbuf1 : wbuf0)
    unsigned char* const act = a.ws + F.wm.act;

    if (a.conv_layer_p1) convert_layer_weights(F, I, a.conv_layer_p1 - 1, WBUF(a.conv_layer_p1 - 1));
    if (a.dump_xb) dump_rows(F, F.Xb, a.out, M);
    if (a.load_src) { load_rows(F, a.load_src, nullptr, F.Xb, F.ssq + (size_t)a.load_slot * M, M); zero_i64(F, F.ssq + (size_t)(a.load_slot ^ 1) * M, M); }

    if (IN(0)) {
        load_rows(F, I.x, nullptr, F.Xb, F.ssq, M);
        load_mem_rows(F, I.mem, (bf16_t*)(a.ws + F.wm.mem_b), (float*)(a.ws + F.wm.rstd_mem), F.NB * NMEM);
        make_tables(F, I);
        for (int L = 0; L < 4; ++L) {
            { WConv w = wconv(I.xattn_wkv + (size_t)L * D * 2 * D, 2 * D, D, (bf16_t*)(a.ws + F.wm.wk_all) + (size_t)L * D * D, D, D); w.kvec = I.mem_norm_g + L * D; w.sa = 0.f; w.sb = 1.f; convert_w(F, w); }
            { WConv w = wconv(I.xattn_wkv + (size_t)L * D * 2 * D, 2 * D, D, (bf16_t*)(a.ws + F.wm.wv_all) + (size_t)L * D * D, D, D); w.col0 = D; w.kvec = I.mem_norm_g + L * D; w.sa = 0.f; w.sb = 1.f; convert_w(F, w); }
        }
        convert_layer_weights(F, I, 0, wbuf0);
        SEAM(0, 0);
    }
    if (IN(1)) {
        { pg8::Gemm g = pg8::make_gemm((const bf16_t*)(a.ws + F.wm.mem_b), D, (const bf16_t*)(a.ws + F.wm.wk_all), D, F.NB * NMEM, 4096, D);
          pg8::StaticOrder S; S.init(g.M, g.N, F.G, (int)blockIdx.x);
          pg8::EpiBf16 E{(bf16_t*)(a.ws + F.wm.kall), 4096, nullptr, (const float*)(a.ws + F.wm.rstd_mem), nullptr, 0, 1, F.NB};
          pg8::gemm_phase(F.lds, g, S, E); }
        { pg8::Gemm g = pg8::make_gemm((const bf16_t*)(a.ws + F.wm.wv_all), D, (const bf16_t*)(a.ws + F.wm.mem_b), D, 4096, F.NB * NMEM, D);
          pg8::StaticOrder S; S.init(g.M, g.N, F.G, (int)blockIdx.x);
          pg8::EpiBf16ColScale E{(bf16_t*)(a.ws + F.wm.vtall), F.NB * NMEM, (const float*)(a.ws + F.wm.rstd_mem), F.NB, 1};
          pg8::gemm_phase(F.lds, g, S, E); }
        __syncthreads();
    }
    for (int L = 0; L < 4; ++L) {
        const int base = PH_LAYER0 + L * PH_PER_LAYER;
        if (hi <= base || lo >= base + PH_PER_LAYER) continue;
        unsigned char* const wb = WBUF(L);
        i64* const ssq_m_in = F.ssq + (size_t)((3 * L) & 1) * M, * const ssq_m_out = F.ssq + (size_t)((3 * L + 1) & 1) * M;
        i64* const ssq_a_in = ssq_m_out, * const ssq_a_out = ssq_m_in;
        i64* const ssq_f_in = ssq_m_in, * const ssq_f_out = ssq_m_out;
MIXER_PHASES
        if (IN(base + PH_XATTN + 0)) {
            zero_i64(F, ssq_a_out, M);
            pg8::Gemm g = pg8::make_gemm(F.Xb, D, (const bf16_t*)(wb + WB_WQ), D, M, D, D);
            pg8::StaticOrder S; S.init(g.M, g.N, F.G, (int)blockIdx.x);
            pg8::EpiBf16 E{(bf16_t*)act, D, ssq_a_in, nullptr, nullptr, 0};
            pg8::gemm_phase(F.lds, g, S, E);
            SEAM(base + PH_XATTN + 0, 18);
        }
        if (IN(base + PH_XATTN + 1)) {
            attn_phase(F, (bf16_t*)act, (const bf16_t*)(a.ws + F.wm.kall), (const bf16_t*)(a.ws + F.wm.vtall), L, pr_sum);
            SEAM(base + PH_XATTN + 1, 19);
        }
        if (IN(base + PH_XATTN + 2)) {
            pg8::Gemm g = pg8::make_gemm((const bf16_t*)act, D, (const bf16_t*)(wb + WB_WO), D, M, D, D);
            pg8::StaticOrder S; S.init(g.M, g.N, F.G, (int)blockIdx.x);
            pg8::EpiResid E{F.Xb, ssq_a_out, nullptr, 0};
            pg8::gemm_phase(F.lds, g, S, E);
            SEAM(base + PH_XATTN + 2, 20);
        }
        if (IN(base + PH_FFN + 0)) {
            zero_i64(F, ssq_f_out, M);
            pg8::Gemm g = pg8::make_gemm(F.Xb, D, (const bf16_t*)(wb + WB_GU), D, M, 2 * FF, D);
            pg8::StaticOrder S; S.init(g.M, g.N, F.G, (int)blockIdx.x);
            pg8::EpiGated<0> E{(bf16_t*)act, FF, ssq_f_in, nullptr, nullptr};
            pg8::gemm_phase(F.lds, g, S, E);
            SEAM(base + PH_FFN + 0, 21);
        }
        if (IN(base + PH_FFN + 1)) {
            if (L < 3) { convert_layer_weights(F, I, L + 1, WBUF(L + 1)); __syncthreads(); }
            pg8::Gemm g = pg8::make_gemm((const bf16_t*)act, FF, (const bf16_t*)(wb + WB_DOWN), FF, M, D, FF);
            pg8::StaticOrder S; S.init(g.M, g.N, F.G, (int)blockIdx.x);
            pg8::EpiResid E{F.Xb, ssq_f_out, nullptr, 0};
            pg8::gemm_phase(F.lds, g, S, E);
            SEAM(base + PH_FFN + 1, 22);
        }
    }
#ifdef EXTRA_BARS
    if (a.use_bar) for (int i = 0; i < EXTRA_BARS; ++i) xcd_barrier(bar);
#endif
    if (IN(PH_FINAL)) final_norm(F, F.Xb, a.out, F.ssq + (size_t)(12 & 1) * M, I.final_norm_g, M);
    if (PROBE_MASK || RWS >= 0 || AT_PROBE || BAR_PROBE) {
        if ((PROBE_MASK >> 23) & 1ull) pr_sum += __builtin_amdgcn_s_memrealtime() - pr_last;
        if (blockIdx.x == 0) { const unsigned long long t0 = __builtin_amdgcn_s_memrealtime(); while (__builtin_amdgcn_s_memrealtime() - t0 < (unsigned long long)PROBE_MULT * pr_sum) __builtin_amdgcn_s_sleep(32); }
    }
#undef IN
#undef SEAM
}

struct Launcher {
    int grid = 0; bool ok = false;
    void init() {
        if (grid) return;
        int dev = 0, cus = 0, per_cu = 0;
        if (hipGetDevice(&dev) != hipSuccess || hipDeviceGetAttribute(&cus, hipDeviceAttributeMultiprocessorCount, dev) != hipSuccess) { grid = -1; return; }
        if (hipFuncSetAttribute((const void*)mega, hipFuncAttributeMaxDynamicSharedMemorySize, LDS_BYTES) != hipSuccess) { fprintf(stderr, "hipFuncSetAttribute failed\n"); grid = -1; return; }
        if (hipOccupancyMaxActiveBlocksPerMultiprocessor(&per_cu, (const void*)mega, NTHREADS, LDS_BYTES) != hipSuccess || per_cu < 1) fprintf(stderr, "occupancy query: %d\n", per_cu);
        (void)hipGetLastError();
        grid = cus; ok = true;
    }
};
static Launcher g_launcher;
static Inputs make_inputs(void* const* d_in) { Inputs I; const float** p = (const float**)&I; for (int i = 0; i < 45; ++i) p[i] = (const float*)d_in[i]; return I; }
static void launch_phases(hipStream_t st, const Inputs& I, float* out, void* ws, int NB, int lo, int hi, int use_bar, const float* load_src, int load_slot, int conv_layer_p1, int dump_xb = 0) {
    Args a{}; a.in = I; a.out = out; a.ws = (unsigned char*)ws; a.load_src = load_src; a.NB = NB; a.ph_lo = lo; a.ph_hi = hi; a.use_bar = use_bar; a.load_slot = load_slot; a.conv_layer_p1 = conv_layer_p1; a.dump_xb = dump_xb; a.pad = 0;
    hipLaunchKernelGGL(mega, dim3(g_launcher.grid), dim3(NTHREADS), LDS_BYTES, st, a);
}
}
#ifndef ONE_LAUNCH
#define ONE_LAUNCH 1
#endif
extern "C" void kernel_launch(void* const* d_in, const int* in_sizes, int n_in, void* d_out, int out_size, void* d_ws, size_t ws_size, hipStream_t stream) {
    (void)in_sizes; (void)n_in; (void)out_size;
    constexpr int NB = 16;
    const fp::WsMap wm = fp::make_wsmap(NB);
    fp::g_launcher.init();
    if (ws_size < wm.end || fp::g_launcher.grid <= 0) { fprintf(stderr, "kernel_launch: workspace too small (%zu < %zu) or launcher init failed; nothing launched\n", ws_size, wm.end); return; }
    const fp::Inputs I = fp::make_inputs(d_in);
    (void)hipMemsetAsync(d_ws, 0, wm.rope, stream);
    if (ONE_LAUNCH) fp::launch_phases(stream, I, (float*)d_out, d_ws, NB, 0, fp::PH_END, 1, nullptr, 0, 0);
    else for (int p = 0; p < fp::PH_END; ++p) fp::launch_phases(stream, I, (float*)d_out, d_ws, NB, p, p + 1, 0, nullptr, 0, 0);
}
```
